# Optimizing an MI355X kernel written in HIP

```python
import jax, jax.numpy as jnp
from jax import lax
import numpy as np

D_MODEL = 1024
BATCH = 32
SEQ = 2048
DEPTH = 1

HEAD_DIM = 64
MOBA_HEADS = 8
MOBA_BLOCK = 256
MOBA_TOPK = 3
DSA_HEADS = 8
DSA_MAX_TOPK = 256
IDX_HEADS = 8
IDX_DIM = 64
N_GROUPS = 4
EXPERTS_PER_GROUP = 8
N_EXPERTS = N_GROUPS * EXPERTS_PER_GROUP
EXPERT_TOPK = 2
EXPERT_FF = 512
DISPATCH_BLOCK = 256
Q_CHUNK = 128
ROPE_THETA = 10000.0
RMS_EPS = 1e-6
NEG = -1e30

MOBA_WIDTH = MOBA_HEADS * HEAD_DIM
DSA_WIDTH = DSA_HEADS * HEAD_DIM
IDX_SCALE = (IDX_HEADS * IDX_DIM) ** -0.5
IN_SIZES = (MOBA_WIDTH,) * 3 + (DSA_WIDTH,) * 3 + (IDX_HEADS * IDX_DIM, IDX_DIM, IDX_HEADS, D_MODEL, D_MODEL)
IN_COLS = sum(IN_SIZES)
SPLIT_POINTS = tuple(int(v) for v in np.cumsum(IN_SIZES)[:-1])

kernel_name = "hybrid_moba_dsa_hier_moe_block"


def rms_norm(x, g):
    xf = x.astype(jnp.float32)
    y = xf * lax.rsqrt(jnp.mean(xf * xf, axis=-1, keepdims=True) + RMS_EPS)
    return (y * g.astype(jnp.float32)).astype(x.dtype)


def rope(x):
    s, d = x.shape[1], x.shape[-1]
    inv = jnp.power(ROPE_THETA, -jnp.arange(0, d, 2, dtype=jnp.float32) / d)
    ang = jnp.arange(s, dtype=jnp.float32)[:, None] * inv[None, :]
    ang = ang.reshape((s,) + (1,) * (x.ndim - 3) + (d // 2,))
    cos, sin = jnp.cos(ang), jnp.sin(ang)
    x1, x2 = jnp.split(x.astype(jnp.float32), 2, axis=-1)
    return jnp.concatenate([x1 * cos - x2 * sin, x1 * sin + x2 * cos], axis=-1).astype(x.dtype)


def masked_softmax(scores, mask):
    return jax.nn.softmax(jnp.where(mask, scores.astype(jnp.float32), NEG), axis=-1)


def moba_attend(q, k, v):
    h, s, d = q.shape
    nb = -(-s // MOBA_BLOCK)
    pad = nb * MOBA_BLOCK - s
    kb = jnp.pad(k, ((0, 0), (0, pad), (0, 0))).reshape(h, nb, MOBA_BLOCK, d)
    vb = jnp.pad(v, ((0, 0), (0, pad), (0, 0))).reshape(h, nb, MOBA_BLOCK, d)
    n_sel = max(1, min(MOBA_TOPK, nb - 1))
    own = jnp.arange(s) // MOBA_BLOCK
    k_mean = jnp.mean(kb.astype(jnp.float32), axis=2)
    gate = jnp.einsum('hsd,hnd->hsn', q.astype(jnp.float32), k_mean)
    past = jnp.arange(nb)[None, :] < own[:, None]
    gate = jnp.where(past[None], gate, NEG)
    _, sel = lax.top_k(gate, n_sel)
    sel_ok = sel < own[None, :, None]
    n_chunks = s // Q_CHUNK
    qc = q.reshape(h, n_chunks, Q_CHUNK, d).transpose(1, 0, 2, 3)
    selc = sel.reshape(h, n_chunks, Q_CHUNK, n_sel).transpose(1, 0, 2, 3)
    okc = sel_ok.reshape(h, n_chunks, Q_CHUNK, n_sel).transpose(1, 0, 2, 3)
    scale = d ** -0.5
    head_ix = jnp.arange(h)[:, None, None]

    def one_chunk(args):
        qi, si, oki, c = args
        q_pos = c * Q_CHUNK + jnp.arange(Q_CHUNK)
        blk = (c * Q_CHUNK) // MOBA_BLOCK
        k_sel = kb[head_ix, si]
        v_sel = vb[head_ix, si]
        k_own = lax.dynamic_index_in_dim(kb, blk, axis=1, keepdims=False)
        v_own = lax.dynamic_index_in_dim(vb, blk, axis=1, keepdims=False)
        s_sel = jnp.einsum('hqd,hqnkd->hqnk', qi, k_sel).reshape(h, Q_CHUNK, n_sel * MOBA_BLOCK) * scale
        s_own = jnp.einsum('hqd,hkd->hqk', qi, k_own) * scale
        m_sel = jnp.broadcast_to(oki[..., None], oki.shape + (MOBA_BLOCK,)).reshape(h, Q_CHUNK, n_sel * MOBA_BLOCK)
        k_pos = blk * MOBA_BLOCK + jnp.arange(MOBA_BLOCK)
        m_own = jnp.broadcast_to((k_pos[None, :] <= q_pos[:, None])[None], (h, Q_CHUNK, MOBA_BLOCK))
        p = masked_softmax(jnp.concatenate([s_sel, s_own], axis=-1),
                           jnp.concatenate([m_sel, m_own], axis=-1)).astype(v.dtype)
        p_sel = p[..., :n_sel * MOBA_BLOCK].reshape(h, Q_CHUNK, n_sel, MOBA_BLOCK)
        p_own = p[..., n_sel * MOBA_BLOCK:]
        return (jnp.einsum('hqnk,hqnkd->hqd', p_sel, v_sel)
                + jnp.einsum('hqk,hkd->hqd', p_own, v_own))

    out = lax.map(one_chunk, (qc, selc, okc, jnp.arange(n_chunks)))
    return out.transpose(1, 0, 2, 3).reshape(h, s, d)


def dsa_attend(q, k, v, q_idx, k_idx, w_idx):
    h, s, d = q.shape
    top = min(DSA_MAX_TOPK, s // 4)
    n_chunks = s // Q_CHUNK
    qc = q.reshape(h, n_chunks, Q_CHUNK, d).transpose(1, 0, 2, 3)
    qic = q_idx.reshape(n_chunks, Q_CHUNK, IDX_HEADS, IDX_DIM)
    wic = w_idx.reshape(n_chunks, Q_CHUNK, IDX_HEADS)
    k_pos = jnp.arange(s)
    kf = k_idx.astype(jnp.float32)
    scale = d ** -0.5

    def one_chunk(args):
        qi, qii, wi, c = args
        q_pos = c * Q_CHUNK + jnp.arange(Q_CHUNK)
        logits = jnp.einsum('qhd,sd->qhs', qii.astype(jnp.float32), kf)
        score = jnp.einsum('qh,qhs->qs', wi.astype(jnp.float32), jax.nn.relu(logits))
        score = jnp.where(k_pos[None, :] <= q_pos[:, None], score, NEG)
        _, idx = lax.top_k(score, top)
        ok = idx <= q_pos[:, None]
        k_sel = k[:, idx]
        v_sel = v[:, idx]
        sc = jnp.einsum('hqd,hqkd->hqk', qi, k_sel) * scale
        p = masked_softmax(sc, ok[None]).astype(v.dtype)
        return jnp.einsum('hqk,hqkd->hqd', p, v_sel)

    out = lax.map(one_chunk, (qc, qic, wic, jnp.arange(n_chunks)))
    return out.transpose(1, 0, 2, 3).reshape(h, s, d)


def hier_moe(h, w_group, b_group, w_expert, b_expert, w1, w3, w2):
    b, s, d = h.shape
    t = b * s
    xt = h.reshape(t, d)
    g_logit = (xt @ w_group + b_group).astype(jnp.float32)
    g_prob = jax.nn.softmax(g_logit, axis=-1)
    g_sel = jnp.argmax(g_logit, axis=-1)
    g_w = jnp.take_along_axis(g_prob, g_sel[:, None], axis=1)
    e_logit = (xt @ w_expert + b_expert).astype(jnp.float32).reshape(t, N_GROUPS, EXPERTS_PER_GROUP)
    e_logit = jnp.take_along_axis(e_logit, g_sel[:, None, None], axis=1)[:, 0]
    top_p, top_i = lax.top_k(jax.nn.softmax(e_logit, axis=-1), EXPERT_TOPK)
    gate = g_w * top_p / jnp.sum(top_p, axis=-1, keepdims=True)
    expert = g_sel[:, None] * EXPERTS_PER_GROUP + top_i
    n_asg = t * EXPERT_TOPK
    e_flat = expert.reshape(-1)
    order = jnp.argsort(e_flat)
    e_sorted = e_flat[order]
    tok_sorted = order // EXPERT_TOPK
    gate_sorted = gate.reshape(-1)[order].astype(h.dtype)
    counts = jnp.bincount(e_flat, length=N_EXPERTS)
    padded = (counts + DISPATCH_BLOCK - 1) // DISPATCH_BLOCK * DISPATCH_BLOCK
    ends = jnp.cumsum(padded)
    starts_pad = ends - padded
    starts = jnp.cumsum(counts) - counts
    dest = starts_pad[e_sorted] + jnp.arange(n_asg) - starts[e_sorted]
    n_blocks = -(-n_asg // DISPATCH_BLOCK) + N_EXPERTS
    xs = jnp.zeros((n_blocks * DISPATCH_BLOCK, d), h.dtype).at[dest].set(xt[tok_sorted])
    block_expert = jnp.minimum(
        jnp.searchsorted(ends, jnp.arange(n_blocks) * DISPATCH_BLOCK, side='right'), N_EXPERTS - 1)

    def expert_block(args):
        xb, e = args
        hid = jax.nn.silu(xb @ w1[e]) * (xb @ w3[e])
        return hid @ w2[e]

    ys = lax.map(expert_block, (xs.reshape(n_blocks, DISPATCH_BLOCK, d), block_expert)).reshape(-1, d)
    out = jax.ops.segment_sum(ys[dest] * gate_sorted[:, None], tok_sorted, num_segments=t)
    return out.reshape(b, s, d)


def hybrid_layer(x, g_mix, w_in, w_proj_a, w_proj_b, w_out, g_ffn,
                 w_group, b_group, w_expert, b_expert, w1, w3, w2):
    b, s, _ = x.shape
    h = rms_norm(x, g_mix)
    qa, ka, va, qb, kb, vb, qi, ki, wi, ga, gb = jnp.split(h @ w_in, SPLIT_POINTS, axis=-1)

    def heads(t, n):
        return t.reshape(b, s, n, HEAD_DIM)

    qa = rope(heads(qa, MOBA_HEADS)).transpose(0, 2, 1, 3)
    ka = rope(heads(ka, MOBA_HEADS)).transpose(0, 2, 1, 3)
    va = heads(va, MOBA_HEADS).transpose(0, 2, 1, 3)
    qb = rope(heads(qb, DSA_HEADS)).transpose(0, 2, 1, 3)
    kb = rope(heads(kb, DSA_HEADS)).transpose(0, 2, 1, 3)
    vb = heads(vb, DSA_HEADS).transpose(0, 2, 1, 3)
    qi = rope(qi.reshape(b, s, IDX_HEADS, IDX_DIM))
    ki = rope(ki)
    wi = wi * IDX_SCALE
    o_a = lax.map(lambda a: moba_attend(*a), (qa, ka, va))
    o_b = lax.map(lambda a: dsa_attend(*a), (qb, kb, vb, qi, ki, wi))
    o_a = o_a.transpose(0, 2, 1, 3).reshape(b, s, MOBA_WIDTH)
    o_b = o_b.transpose(0, 2, 1, 3).reshape(b, s, DSA_WIDTH)
    mixed = jax.nn.sigmoid(ga) * (o_a @ w_proj_a) + jax.nn.sigmoid(gb) * (o_b @ w_proj_b)
    x = x + mixed @ w_out
    x = x + hier_moe(rms_norm(x, g_ffn), w_group, b_group, w_expert, b_expert, w1, w3, w2)
    return x


def setup_inputs(seed: int = 0) -> dict:
    key = jax.random.key(seed)
    ks = jax.random.split(key, 16)
    nrm = jax.random.normal
    f32 = jnp.float32
    return {
        "x": nrm(ks[0], (BATCH, SEQ, D_MODEL), f32),
        "g_mix": 1.0 + 0.02 * nrm(ks[1], (DEPTH, D_MODEL), f32),
        "w_in": nrm(ks[2], (DEPTH, D_MODEL, IN_COLS), f32) * D_MODEL ** -0.5,
        "w_proj_a": nrm(ks[3], (DEPTH, MOBA_WIDTH, D_MODEL), f32) * MOBA_WIDTH ** -0.5,
        "w_proj_b": nrm(ks[4], (DEPTH, DSA_WIDTH, D_MODEL), f32) * DSA_WIDTH ** -0.5,
        "w_out": nrm(ks[5], (DEPTH, D_MODEL, D_MODEL), f32) * D_MODEL ** -0.5,
        "g_ffn": 1.0 + 0.02 * nrm(ks[6], (DEPTH, D_MODEL), f32),
        "w_group": nrm(ks[7], (DEPTH, D_MODEL, N_GROUPS), f32) * D_MODEL ** -0.5,
        "b_group": 0.01 * nrm(ks[8], (DEPTH, N_GROUPS), f32),
        "w_expert": nrm(ks[9], (DEPTH, D_MODEL, N_EXPERTS), f32) * D_MODEL ** -0.5,
        "b_expert": 0.01 * nrm(ks[10], (DEPTH, N_EXPERTS), f32),
        "w1": nrm(ks[11], (DEPTH, N_EXPERTS, D_MODEL, EXPERT_FF), f32) * D_MODEL ** -0.5,
        "w3": nrm(ks[12], (DEPTH, N_EXPERTS, D_MODEL, EXPERT_FF), f32) * D_MODEL ** -0.5,
        "w2": nrm(ks[13], (DEPTH, N_EXPERTS, EXPERT_FF, D_MODEL), f32) * EXPERT_FF ** -0.5,
        "g_final": 1.0 + 0.02 * nrm(ks[14], (D_MODEL,), f32),
    }


def reference(x, g_mix, w_in, w_proj_a, w_proj_b, w_out, g_ffn,
              w_group, b_group, w_expert, b_expert, w1, w3, w2, g_final):
    for l in range(DEPTH):
        x = hybrid_layer(x, g_mix[l], w_in[l], w_proj_a[l], w_proj_b[l], w_out[l], g_ffn[l],
                         w_group[l], b_group[l], w_expert[l], b_expert[l], w1[l], w3[l], w2[l])
    return rms_norm(x, g_final)
```

```cpp
#include <hip/hip_runtime.h>
#include <hip/hip_cooperative_groups.h>
#include <hip/hip_bf16.h>
#include <cstdio>
#include <cstdint>
#include <cstddef>
#include <cmath>
namespace cg = cooperative_groups;

#ifndef MK_N_LAUNCHES
#define MK_N_LAUNCHES 1
#endif

constexpr int NBATCH = 32, SEQ = 2048, DMODEL = 1024, T = NBATCH * SEQ;
constexpr int NHEAD = 8, HD = 64, HW = NHEAD * HD;
constexpr int IN_COLS = 5704, NINA = 768, NINB = 5120;
constexpr int NEXP = 32, EFF = 512;
constexpr float RMS_EPS = 1e-6f;
constexpr float IDX_SCALE = 0.044194173824159216f;
constexpr float C2 = 0.125f * 1.4426950408889634f;
constexpr int HID_ROWS = 131072 + 8192;

namespace pg8 {
#define PG8_LAS __attribute__((address_space(3)))
typedef unsigned short bf16_t;
typedef short bf16x8 __attribute__((ext_vector_type(8)));
typedef float f32x4 __attribute__((ext_vector_type(4)));
typedef unsigned u32x4 __attribute__((ext_vector_type(4)));
typedef unsigned u32x2 __attribute__((ext_vector_type(2)));
constexpr int BM = 256, BK = 64, HALF = 128, HTB = HALF * BK * 2, STAGE_BYTES = 8 * HTB, NXCD = 8, WGM = 8;

__host__ __device__ __forceinline__ int lds_byte(int r, int c) { const int st = (r >> 4) * 2 + (c >> 5), rr = r & 15, cc = c & 31, ob = rr * 64 + cc * 2; return st * 1024 + (ob ^ (((ob >> 9) & 1) << 5)); }
__host__ __device__ __forceinline__ void stage_rc(int b, int& R, int& C) { const int st = b / 1024, sb = b % 1024, swz = sb ^ (((sb >> 9) & 1) << 5); R = (st >> 1) * 16 + swz / 64; C = (st & 1) * 32 + (swz % 64) / 2; }
__host__ __device__ __forceinline__ int perm32(int rho) { const int n = rho >> 4, i = rho & 15; return 8 * (i >> 2) + 4 * n + (i & 3); }

typedef int v8i __attribute__((ext_vector_type(8)));
__host__ __device__ __forceinline__ int swz8(int r) { return (((r >> 1) & 3) << 5) ^ (((r >> 3) & 1) << 4); }
__host__ __device__ __forceinline__ int lds_byte8(int r, int cb) { return r * 128 + (cb ^ swz8(r)); }
__host__ __device__ __forceinline__ void stage_rc8(int b, int& R, int& Cb) { R = b >> 7; Cb = (b & 127) ^ swz8(R); }
constexpr int F8_SCALE1 = 0x7f7f7f7f;
__host__ __device__ __forceinline__ int perm16(int s) { return 64 * ((s >> 5) & 3) + 16 * ((s >> 2) & 3) + 8 * (s >> 7) + 4 * ((s >> 4) & 1) + (s & 3); }
struct Unit { int pm, pn, e, lt, cnt; };

struct StaticOrder {
    int nM, nN, nwg, G, c;
    __device__ void init(int M, int N, int G_, int c_) { nM = M / BM; nN = N / BM; nwg = nM * nN; G = G_; c = c_; }
    __device__ bool next(int i, Unit& u) const {
        const long L = (long)i * G + c; if (L >= nwg) return false;
        int wgid = (int)L; { const int q = nwg / NXCD, r = nwg % NXCD, xcd = wgid % NXCD, off = wgid / NXCD; wgid = (xcd < r ? xcd * (q + 1) : r * (q + 1) + (xcd - r) * q) + off; }
        const int nig = WGM * nN, gid = wgid / nig, fm = gid * WGM, gsz = (nM - fm) < WGM ? (nM - fm) : WGM;
        u.pm = fm + ((wgid % nig) % gsz); u.pn = (wgid % nig) / gsz; u.e = 0; u.lt = 0; u.cnt = 0; return true;
    }
};
struct MoeOrder {
    const PG8_LAS int* tstart; const PG8_LAS int* cnt; int nN, G, c;
    __device__ bool next(int i, Unit& u) const {
        const long L = (long)i * G + c; const int ntiles = tstart[NEXP];
        if (L >= (long)ntiles * nN) return false;
        const int pm = (int)(L / nN); u.pm = pm; u.pn = (int)(L % nN);
        int e = 0;
#pragma unroll 1
        for (int j = 1; j < NEXP; ++j) e = (tstart[j] <= pm) ? j : e;
        u.e = e; u.lt = pm - tstart[e]; u.cnt = cnt[e]; return true;
    }
};

__device__ __forceinline__ unsigned cvt_pk_bf16(float lo, float hi) { typedef float f2 __attribute__((ext_vector_type(2))); typedef __bf16 b2 __attribute__((ext_vector_type(2))); f2 v = {lo, hi}; b2 b = __builtin_convertvector(v, b2); return __builtin_bit_cast(unsigned, b); }
__device__ __forceinline__ float bf2f(unsigned short s) { return __uint_as_float((unsigned)s << 16); }

struct GmPlain {
    static constexpr bool FP8 = false;
    const char* A; const char* Bt; int K;
    __device__ __forceinline__ const char* abase() const { return A; }
    __device__ __forceinline__ void offs(const Unit& u, const int (&R)[2], const int (&C)[2], unsigned (&o)[2][2]) const {
#pragma unroll
        for (int h = 0; h < 2; ++h)
#pragma unroll
            for (int i = 0; i < 2; ++i) o[h][i] = (unsigned)(((u.pm * 256 + h * 128 + R[i]) * K + C[i]) * 2);
    }
    __device__ __forceinline__ const char* bptr(const Unit& u) const { return Bt + (size_t)u.pn * 256 * K * 2; }
};
struct GmMoe1 {
    static constexpr bool FP8 = false;
    const char* A; const char* Bt; const int* tok; int K;
    __device__ __forceinline__ const char* abase() const { return A; }
    __device__ __forceinline__ void offs(const Unit& u, const int (&R)[2], const int (&C)[2], unsigned (&o)[2][2]) const {
#pragma unroll
        for (int h = 0; h < 2; ++h)
#pragma unroll
            for (int i = 0; i < 2; ++i) { int r = u.lt * 256 + h * 128 + R[i]; r = r < u.cnt ? r : u.cnt - 1; const int ts = tok[(size_t)u.e * 65536 + r]; o[h][i] = (unsigned)((((ts >> 1)) * K + C[i]) * 2); }
    }
    __device__ __forceinline__ const char* bptr(const Unit& u) const { return Bt + ((size_t)u.e * 1024 + (size_t)u.pn * 256) * K * 2; }
};
struct GmMoe2 {
    static constexpr bool FP8 = false;
    const char* A; const char* Bt; int K;
    __device__ __forceinline__ const char* abase() const { return A; }
    __device__ __forceinline__ void offs(const Unit& u, const int (&R)[2], const int (&C)[2], unsigned (&o)[2][2]) const {
#pragma unroll
        for (int h = 0; h < 2; ++h)
#pragma unroll
            for (int i = 0; i < 2; ++i) o[h][i] = (unsigned)(((u.pm * 256 + h * 128 + R[i]) * K + C[i]) * 2);
    }
    __device__ __forceinline__ const char* bptr(const Unit& u) const { return Bt + ((size_t)u.e * 1024 + (size_t)u.pn * 256) * K * 2; }
};

struct GmMoe1F8 {
    static constexpr bool FP8 = true;
    const char* A; const char* Bt; const int* tok; int K;
    __device__ __forceinline__ const char* abase() const { return A; }
    __device__ __forceinline__ void offs(const Unit& u, const int (&R)[2], const int (&C)[2], unsigned (&o)[2][2]) const {
#pragma unroll
        for (int h = 0; h < 2; ++h)
#pragma unroll
            for (int i = 0; i < 2; ++i) { int r = u.lt * 256 + h * 128 + R[i]; r = r < u.cnt ? r : u.cnt - 1; const int ts = tok[(size_t)u.e * 65536 + r]; o[h][i] = (unsigned)((ts >> 1) * K + C[i]); }
    }
    __device__ __forceinline__ const char* bptr(const Unit& u) const { return Bt + ((size_t)u.e * 1024 + (size_t)u.pn * 256) * K; }
};
struct GmPlainF8 {
    static constexpr bool FP8 = true;
    const char* A; const char* Bt; int K;
    __device__ __forceinline__ const char* abase() const { return A; }
    __device__ __forceinline__ void offs(const Unit& u, const int (&R)[2], const int (&C)[2], unsigned (&o)[2][2]) const {
#pragma unroll
        for (int h = 0; h < 2; ++h)
#pragma unroll
            for (int i = 0; i < 2; ++i) o[h][i] = (unsigned)((u.pm * 256 + h * 128 + R[i]) * K + C[i]);
    }
    __device__ __forceinline__ const char* bptr(const Unit& u) const { return Bt + (size_t)u.pn * 256 * K; }
};
struct GmMoe2F8 {
    static constexpr bool FP8 = true;
    const char* A; const char* Bt; int K;
    __device__ __forceinline__ const char* abase() const { return A; }
    __device__ __forceinline__ void offs(const Unit& u, const int (&R)[2], const int (&C)[2], unsigned (&o)[2][2]) const {
#pragma unroll
        for (int h = 0; h < 2; ++h)
#pragma unroll
            for (int i = 0; i < 2; ++i) o[h][i] = (unsigned)((u.pm * 256 + h * 128 + R[i]) * K + C[i]);
    }
    __device__ __forceinline__ const char* bptr(const Unit& u) const { return Bt + ((size_t)u.e * 1024 + (size_t)u.pn * 256) * K; }
};
__device__ __forceinline__ unsigned cvt4_fp8(float a, float b, float c, float d) { int w = 0; w = __builtin_amdgcn_cvt_pk_fp8_f32(a, b, w, false); w = __builtin_amdgcn_cvt_pk_fp8_f32(c, d, w, true); return (unsigned)w; }


__host__ __device__ __forceinline__ int in_tile_of(int part, int p) { return part == 0 ? (p < 2 ? 12 + p : 14) : (p < 12 ? p : p + 3); }
__device__ __forceinline__ size_t pairaddr(int row, int col) { return ((size_t)(row >> 1) << 11) + (size_t)(((col >> 6) << 7) + ((row & 1) << 6) + (col & 63)); }
template <int PART> struct EpiIn {
    bf16_t *qa, *ka, *va, *qb, *kb, *vb, *qi, *ki; float* wi; unsigned char *sga, *sgb;
    static constexpr float ASCALE = PART == 0 ? 1.0f : (1.0f / 32.0f);
    __device__ __forceinline__ void rope_rows(const f32x4 (&acc)[2][2][4][2], bf16_t* dst, int pitch, int rowb, int fq, float sc) const {
        constexpr float B8[8] = {0.15915494309189535f, 0.11934937021124886f, 0.08949940160889101f, 0.06711508300522726f, 0.050329212104487035f, 0.03774158471741977f, 0.0283021958306234f, 0.02122365276477766f};
        const float dec = fq == 0 ? 1.0f : fq == 1 ? 0.1f : fq == 2 ? 0.01f : 0.001f; const int j0 = 8 * fq;
        f32x4 c4[2][2], s4[2][2], cr[2], sr[2];
        const float p0 = (float)(rowb & (SEQ - 1)), p1 = (float)((rowb + HALF) & (SEQ - 1));
#pragma unroll
        for (int n = 0; n < 2; ++n)
#pragma unroll
            for (int k = 0; k < 4; ++k) { const float w = dec * B8[4 * n + k];
                const float r16 = __builtin_amdgcn_fractf(16.0f * w); cr[n][k] = __builtin_amdgcn_cosf(r16); sr[n][k] = __builtin_amdgcn_sinf(r16);
                const float ra = __builtin_amdgcn_fractf(p0 * w); c4[0][n][k] = __builtin_amdgcn_cosf(ra); s4[0][n][k] = __builtin_amdgcn_sinf(ra);
                const float rb = __builtin_amdgcn_fractf(p1 * w); c4[1][n][k] = __builtin_amdgcn_cosf(rb); s4[1][n][k] = __builtin_amdgcn_sinf(rb); }
#pragma unroll
        for (int ai = 0; ai < 2; ++ai) {
#pragma unroll
            for (int m = 0; m < 4; ++m) { const int row = rowb + ai * HALF + m * 16;
                u32x4 a, b;
#pragma unroll
                for (int n = 0; n < 2; ++n) { const f32x4 c = c4[ai][n], sn = s4[ai][n];
                    const f32x4 x1 = acc[ai][0][m][n] * sc, x2 = acc[ai][1][m][n] * sc; const f32x4 o1 = x1 * c - x2 * sn, o2 = x1 * sn + x2 * c;
                    a[2 * n] = cvt_pk_bf16(o1[0], o1[1]); a[2 * n + 1] = cvt_pk_bf16(o1[2], o1[3]); b[2 * n] = cvt_pk_bf16(o2[0], o2[1]); b[2 * n + 1] = cvt_pk_bf16(o2[2], o2[3]);
                    c4[ai][n] = c * cr[n] - sn * sr[n]; s4[ai][n] = sn * cr[n] + c * sr[n]; }
                bf16_t* p = dst + (size_t)row * pitch + j0; *(u32x4*)p = a; *(u32x4*)(p + 32) = b; } }
    }
    __device__ __forceinline__ void operator()(const f32x4 (&acc)[2][2][4][2], const Unit& u, int wr, int wc, int fr, int fq) const {
        const int pn = in_tile_of(PART, u.pn); const int rowb = u.pm * BM + wr * 64 + fr;
        if (pn < 14) {
            const int seg = pn >> 1;
            if (seg == 2 || seg == 5) {
                bf16_t* dst = (seg == 2) ? va : vb; const int colb = (pn & 1) * 256 + wc * 64 + 16 * fq;
#pragma unroll
                for (int ai = 0; ai < 2; ++ai) {
#pragma unroll
                    for (int m = 0; m < 4; ++m) { const int row = rowb + ai * HALF + m * 16; const float r = ASCALE;
#pragma unroll
                        for (int bj = 0; bj < 2; ++bj) { const f32x4 v0 = acc[ai][bj][m][0] * r, v1 = acc[ai][bj][m][1] * r; u32x4 w;
                            w.x = cvt_pk_bf16(v0[0], v0[1]); w.y = cvt_pk_bf16(v0[2], v0[3]); w.z = cvt_pk_bf16(v1[0], v1[1]); w.w = cvt_pk_bf16(v1[2], v1[3]);
                            *(u32x4*)(dst + (size_t)row * HW + colb + bj * 8) = w; } } }
            } else {
                bf16_t* dst = (seg == 0) ? qa : (seg == 1) ? ka : (seg == 3) ? qb : (seg == 4) ? kb : qi;
                const float sc = ((seg == 0 || seg == 3) ? C2 : 1.0f) * ASCALE; const int head = 4 * (pn & 1) + wc;
                rope_rows(acc, dst + head * 64, HW, rowb, fq, sc);
            }
        } else if (pn == 14) {
            if (wc == 0) rope_rows(acc, ki, 64, rowb, fq, 1.0f);
            else if (wc == 1 && fq < 2) {
#pragma unroll
                for (int ai = 0; ai < 2; ++ai)
#pragma unroll
                    for (int m = 0; m < 4; ++m) { const int row = rowb + ai * HALF + m * 16; const float r = IDX_SCALE;
                        *(f32x4*)(wi + (size_t)row * 8 + 4 * fq) = acc[ai][0][m][0] * r; }
            }
        } else {
            const int gi = pn - 15; unsigned char* dst = (gi < 4) ? sga : sgb; const int colb = (gi & 3) * 256 + wc * 64 + 16 * fq;
#pragma unroll
            for (int ai = 0; ai < 2; ++ai) {
#pragma unroll
                for (int m = 0; m < 4; ++m) { const int row = rowb + ai * HALF + m * 16; const float r = -1.4426950408889634f * ASCALE; u32x4 w;
#pragma unroll
                    for (int bj = 0; bj < 2; ++bj)
#pragma unroll
                        for (int n = 0; n < 2; ++n) { f32x4 v = acc[ai][bj][m][n] * r;
#pragma unroll
                            for (int k = 0; k < 4; ++k) v[k] = 256.0f * __builtin_amdgcn_rcpf(1.0f + __builtin_amdgcn_exp2f(v[k]));
                            w[2 * bj + n] = cvt4_fp8(v[0], v[1], v[2], v[3]); }
                    *(u32x4*)(dst + pairaddr(row, colb)) = w; } }
        }
    }
};
template <bool FIRST> struct EpiGate {
    const unsigned char* sg; unsigned char* tmp; unsigned char* out8;
    __device__ __forceinline__ void operator()(const f32x4 (&acc)[2][2][4][2], const Unit& u, int wr, int wc, int fr, int fq) const {
        typedef float v2f_ __attribute__((ext_vector_type(2)));
        const int rowb = u.pm * BM + wr * 64 + fr, colb = u.pn * BM + wc * 64 + 16 * fq;
#pragma unroll
        for (int ai = 0; ai < 2; ++ai) { u32x4 g[4], pv[4];
#pragma unroll
            for (int m = 0; m < 4; ++m) { const size_t off = pairaddr(rowb + ai * HALF + m * 16, colb);
                g[m] = *(const u32x4*)(sg + off); if (!FIRST) pv[m] = *(const u32x4*)(tmp + off); else pv[m] = (u32x4){0u, 0u, 0u, 0u}; }
#pragma unroll
            for (int m = 0; m < 4; ++m) { const int row = rowb + ai * HALF + m * 16; const size_t off = FIRST ? pairaddr(row, colb) : (size_t)row * DMODEL + colb; u32x4 w;
#pragma unroll
                for (int bj = 0; bj < 2; ++bj)
#pragma unroll
                    for (int n = 0; n < 2; ++n) { const f32x4 a = acc[ai][bj][m][n] * (32.0f / 65536.0f); const int q = 2 * bj + n;
                        const v2f_ g0 = __builtin_amdgcn_cvt_pk_f32_fp8((int)g[m][q], false), g1 = __builtin_amdgcn_cvt_pk_f32_fp8((int)g[m][q], true);
                        const v2f_ p0 = __builtin_amdgcn_cvt_pk_f32_fp8((int)pv[m][q], false), p1 = __builtin_amdgcn_cvt_pk_f32_fp8((int)pv[m][q], true);
                        w[q] = cvt4_fp8(a[0] * g0.x + p0.x, a[1] * g0.y + p0.y, a[2] * g1.x + p1.x, a[3] * g1.y + p1.y); }
                *(u32x4*)((FIRST ? tmp : out8) + off) = w; } }
    }
};
struct EpiRes {
    const bf16_t* xb; const float* irstd; bf16_t* xh; unsigned char* xl; unsigned char* xq;
    __device__ __forceinline__ void operator()(const f32x4 (&acc)[2][2][4][2], const Unit& u, int wr, int wc, int fr, int fq) const {
        const int rowb = u.pm * BM + wr * 64 + fr, colb = u.pn * BM + wc * 64 + 16 * fq;
#pragma unroll
        for (int ai = 0; ai < 2; ++ai) { u32x4 bs[4][2]; float ir[4];
#pragma unroll
            for (int m = 0; m < 4; ++m) { const int row = rowb + ai * HALF + m * 16; const size_t off = (size_t)row * DMODEL + colb; ir[m] = irstd[row];
#pragma unroll
                for (int bj = 0; bj < 2; ++bj) bs[m][bj] = *(const u32x4*)(xb + off + bj * 8); }
#pragma unroll
            for (int m = 0; m < 4; ++m) { const size_t off = (size_t)(rowb + ai * HALF + m * 16) * DMODEL + colb; u32x4 hw[2], lw, qw;
#pragma unroll
                for (int bj = 0; bj < 2; ++bj)
#pragma unroll
                    for (int n = 0; n < 2; ++n) { float qv[4], lo[4];
#pragma unroll
                        for (int q = 0; q < 2; ++q) { const unsigned xw = bs[m][bj][2 * n + q];
                            const float v0 = __uint_as_float(xw << 16) * ir[m] + acc[ai][bj][m][n][2 * q] * (1.0f / 1024.0f), v1 = __uint_as_float(xw & 0xffff0000u) * ir[m] + acc[ai][bj][m][n][2 * q + 1] * (1.0f / 1024.0f);
                            const unsigned h = cvt_pk_bf16(v0, v1); qv[2 * q] = v0; qv[2 * q + 1] = v1; hw[bj][2 * n + q] = h;
                            lo[2 * q] = (v0 - __uint_as_float(h << 16)) * 512.0f; lo[2 * q + 1] = (v1 - __uint_as_float(h & 0xffff0000u)) * 512.0f; }
                        qw[2 * bj + n] = cvt4_fp8(qv[0], qv[1], qv[2], qv[3]); lw[2 * bj + n] = cvt4_fp8(lo[0], lo[1], lo[2], lo[3]); }
                *(u32x4*)(xh + off) = hw[0]; *(u32x4*)(xh + off + 8) = hw[1]; *(u32x4*)(xl + off) = lw; *(u32x4*)(xq + off) = qw; } }
    }
};
struct EpiSwiGlu {
    const float* rsort; unsigned char* hid;
    __device__ __forceinline__ void operator()(const f32x4 (&acc)[2][2][4][2], const Unit& u, int wr, int wc, int fr, int fq) const {
        float rr[2][4];
#pragma unroll
        for (int ai = 0; ai < 2; ++ai)
#pragma unroll
            for (int m = 0; m < 4; ++m) { int er = u.lt * 256 + ai * HALF + wr * 64 + m * 16 + fr; er = er < u.cnt ? er : u.cnt - 1; rr[ai][m] = rsort[(size_t)u.e * 65536 + er] * (1.0f / 32.0f); }
#pragma unroll
        for (int ai = 0; ai < 2; ++ai)
#pragma unroll
            for (int m = 0; m < 4; ++m) { const int lr = ai * HALF + wr * 64 + m * 16 + fr; const int er = u.lt * 256 + lr;
                if (er < u.cnt) { const float r = rr[ai][m]; float o[8];
#pragma unroll
                    for (int n = 0; n < 2; ++n) { const f32x4 a = acc[ai][0][m][n] * r, b = acc[ai][1][m][n] * r;
#pragma unroll
                        for (int k = 0; k < 4; ++k) { const float sg = __builtin_amdgcn_rcpf(1.0f + __builtin_amdgcn_exp2f(a[k] * (-1.4426950408889634f))); o[4 * n + k] = 2.0f * a[k] * sg * b[k]; } }
                    u32x2 w; w.x = cvt4_fp8(o[0], o[1], o[2], o[3]); w.y = cvt4_fp8(o[4], o[5], o[6], o[7]);
                    *(u32x2*)(hid + (size_t)(u.pm * 256 + lr) * EFF + 128 * u.pn + 32 * wc + 8 * fq) = w; } }
    }
};
struct EpiDown {
    const int* tok; const float* gsort; unsigned char* ys;
    __device__ __forceinline__ void operator()(const f32x4 (&acc)[2][2][4][2], const Unit& u, int wr, int wc, int fr, int fq) const {
        const int colb = u.pn * BM + wc * 64 + 16 * fq;
        int ts[2][4]; float gg[2][4];
#pragma unroll
        for (int ai = 0; ai < 2; ++ai)
#pragma unroll
            for (int m = 0; m < 4; ++m) { int er = u.lt * 256 + ai * HALF + wr * 64 + m * 16 + fr; er = er < u.cnt ? er : u.cnt - 1; ts[ai][m] = tok[(size_t)u.e * 65536 + er]; gg[ai][m] = gsort[(size_t)u.e * 65536 + er]; }
#pragma unroll
        for (int ai = 0; ai < 2; ++ai)
#pragma unroll
            for (int m = 0; m < 4; ++m) { const int er = u.lt * 256 + ai * HALF + wr * 64 + m * 16 + fr;
                if (er < u.cnt) { const float g = gg[ai][m] * (16.0f / 32.0f); const int t_ = ts[ai][m]; u32x4 w;
#pragma unroll
                    for (int bj = 0; bj < 2; ++bj)
#pragma unroll
                        for (int n = 0; n < 2; ++n) { const f32x4 v = acc[ai][bj][m][n] * g; w[2 * bj + n] = cvt4_fp8(v[0], v[1], v[2], v[3]); }
                    *(u32x4*)(ys + (size_t)t_ * DMODEL + colb) = w; } }
    }
};

template <class GM, class Epi, class Sched>
__device__ __forceinline__ void gemm_phase(PG8_LAS unsigned char* lds, const GM g, const Sched& S, const Epi& E, const int tid) {
    const int wid = __builtin_amdgcn_readfirstlane(tid >> 6), lane = tid & 63, wr = wid >> 2, wc = wid & 3, fr = lane & 15, fq = lane >> 4;
    constexpr bool FP8 = GM::FP8;
    const int K = g.K, nt = FP8 ? K / 128 : K / BK;
    int sR[2], sC[2]; unsigned voffB[2];
#pragma unroll
    for (int i = 0; i < 2; ++i) { int R, C; if constexpr (FP8) { stage_rc8(tid * 16 + i * 8192, R, C); voffB[i] = (unsigned)(R * K + C); } else { stage_rc(tid * 16 + i * 8192, R, C); voffB[i] = (unsigned)(R * K + C) * 2u; }
        sR[i] = R; sC[i] = C; }
    const size_t kstep = (size_t)(BK * 2);
    const size_t hstep = FP8 ? (size_t)HALF * K : (size_t)HALF * K * 2;
    const unsigned ldsw = (unsigned)wid * 1024u;
    const int aoff = FP8 ? lds_byte8(wr * 64 + fr, fq * 32) : lds_byte(wr * 64 + fr, fq * 8), boff = FP8 ? lds_byte8(wc * 32 + fr, fq * 32) : lds_byte(wc * 32 + fr, fq * 8);
    const int aoff1 = aoff ^ 16, boff1 = boff ^ 16;
    const char* const abase = g.abase();
#define PG8_SA(b, h) (((b) * 2 + (h)) * HTB)
#define PG8_SB(b, h) ((4 + (b) * 2 + (h)) * HTB)
#define PG8_STAGE(bufoff, gbase, voff) do { _Pragma("unroll") for (int _i = 0; _i < 2; ++_i) \
        __builtin_amdgcn_global_load_lds((const unsigned*)((const char*)(gbase) + (voff)[_i]), (PG8_LAS unsigned*)(lds + (bufoff) + ldsw + _i * 8192), 16, 0, 0); } while (0)
#define PG8_STAGEA(bufoff, OFF, h, kb) do { const char* ub_ = abase + (kb);   _Pragma("unroll") for (int _i = 0; _i < 2; ++_i) \
        __builtin_amdgcn_global_load_lds((const unsigned*)(ub_ + (OFF)[h][_i]), (PG8_LAS unsigned*)(lds + (bufoff) + ldsw + _i * 8192), 16, 0, 0); } while (0)
#define PG8_LD8(off0_, off1_, cst_) ({ typedef int v4i_ __attribute__((ext_vector_type(4))); const v4i_ lo_ = *(const PG8_LAS v4i_*)(lds + (cst_) + (off0_)); const v4i_ hi_ = *(const PG8_LAS v4i_*)(lds + (cst_) + (off1_)); __builtin_shufflevector(lo_, hi_, 0, 1, 2, 3, 4, 5, 6, 7); })
#define PG8_LDA(dst, b, h) do { if constexpr (FP8) { _Pragma("unroll") for (int m = 0; m < 4; ++m) dst##8[m] = PG8_LD8(aoff, aoff1, PG8_SA(b, h) + m * 2048); } \
        else { _Pragma("unroll") for (int m = 0; m < 4; ++m) _Pragma("unroll") for (int k = 0; k < 2; ++k) dst[m][k] = *(const PG8_LAS bf16x8*)(lds + PG8_SA(b, h) + aoff + m * 2048 + k * 1024); } } while (0)
#define PG8_LDB(dst, b, h) do { if constexpr (FP8) { _Pragma("unroll") for (int n = 0; n < 2; ++n) dst##8[n] = PG8_LD8(boff, boff1, PG8_SB(b, h) + n * 2048); } \
        else { _Pragma("unroll") for (int n = 0; n < 2; ++n) _Pragma("unroll") for (int k = 0; k < 2; ++k) dst[n][k] = *(const PG8_LAS bf16x8*)(lds + PG8_SB(b, h) + boff + n * 2048 + k * 1024); } } while (0)
#define PG8_MMA(ai, bj, At, Bt) do { __builtin_amdgcn_s_setprio(1); if constexpr (FP8) { _Pragma("unroll") for (int m = 0; m < 4; ++m) _Pragma("unroll") for (int n = 0; n < 2; ++n) \
        asm volatile("v_mfma_scale_f32_16x16x128_f8f6f4 %0, %1, %2, %0, %3, %3 op_sel_hi:[0,0,0]" : "+v"(acc[ai][bj][m][n]) : "v"(Bt##8[n]), "v"(At##8[m]), "v"(f8sc)); } \
        else { _Pragma("unroll") for (int m = 0; m < 4; ++m) _Pragma("unroll") for (int n = 0; n < 2; ++n) _Pragma("unroll") for (int k = 0; k < 2; ++k) \
        acc[ai][bj][m][n] = __builtin_amdgcn_mfma_f32_16x16x32_bf16(Bt[n][k], At[m][k], acc[ai][bj][m][n], 0, 0, 0); } __builtin_amdgcn_s_setprio(0); } while (0)
#define PG8_WAIT_V(n) asm volatile("s_waitcnt vmcnt(" #n ")" ::: "memory")
#define PG8_WAIT_L(n) asm volatile("s_waitcnt lgkmcnt(" #n ")" ::: "memory")
#define PG8_BAR __builtin_amdgcn_s_barrier()
#define PG8_SCHED __builtin_amdgcn_sched_barrier(0)
    Unit cur, nxt; int ui = 0;
    if (!S.next(0, cur)) return;
    f32x4 acc[2][2][4][2];
#pragma unroll
    for (int a = 0; a < 2; ++a)
#pragma unroll
        for (int b = 0; b < 2; ++b)
#pragma unroll
            for (int m = 0; m < 4; ++m)
#pragma unroll
                for (int n = 0; n < 2; ++n) acc[a][b][m][n] = (f32x4){0.f, 0.f, 0.f, 0.f};
    bf16x8 At[4][2], B0[2][2], B1[2][2]; v8i At8[4], B08[2], B18[2];
    const int f8sc = F8_SCALE1;
    unsigned cOff[2][2], nOff[2][2];
    g.offs(cur, sR, sC, cOff);
    const char* cB = g.bptr(cur);
    PG8_STAGE(PG8_SB(0, 0), cB, voffB); PG8_STAGE(PG8_SB(0, 1), cB + hstep, voffB); PG8_STAGEA(PG8_SA(0, 0), cOff, 0, (size_t)0); PG8_STAGEA(PG8_SA(0, 1), cOff, 1, (size_t)0);
    if (wr == 1) PG8_BAR;
    PG8_WAIT_V(2); PG8_BAR;
    PG8_STAGE(PG8_SB(1, 0), cB + kstep, voffB); PG8_STAGEA(PG8_SA(1, 0), cOff, 0, kstep); PG8_STAGE(PG8_SB(1, 1), cB + hstep + kstep, voffB);
    PG8_WAIT_V(6); PG8_BAR;
    for (;;) {
        const bool has_next = S.next(ui + 1, nxt);
        const char* nB = cB;
        if (has_next) { g.offs(nxt, sR, sC, nOff); nB = g.bptr(nxt); }
        else {
#pragma unroll
            for (int h = 0; h < 2; ++h)
#pragma unroll
                for (int i = 0; i < 2; ++i) nOff[h][i] = cOff[h][i];
        }
#pragma unroll 1
        for (int t = 0; t < nt; t += 2) {
            const bool last = (t == nt - 2);
            const size_t kb1 = (size_t)(t + 1) * kstep;
            const size_t kb2 = last ? (size_t)0 : (size_t)(t + 2) * kstep, kb3 = kb2 + kstep;
            unsigned o2[2][2];
#pragma unroll
            for (int h = 0; h < 2; ++h)
#pragma unroll
                for (int i = 0; i < 2; ++i) o2[h][i] = last ? nOff[h][i] : cOff[h][i];
            const char* b2 = last ? nB : cB + (size_t)(t + 2) * kstep; const char* b3 = b2 + kstep;
            PG8_LDB(B0, 0, 0); PG8_LDB(B1, 0, 1); PG8_SCHED; PG8_LDA(At, 0, 0); PG8_STAGEA(PG8_SA(1, 1), cOff, 1, kb1);
            PG8_WAIT_V(8); PG8_WAIT_L(0); PG8_BAR; PG8_MMA(0, 0, At, B0); PG8_MMA(0, 1, At, B1); PG8_BAR; PG8_SCHED;
            PG8_LDA(At, 0, 1); PG8_STAGE(PG8_SB(0, 0), b2, voffB); PG8_STAGE(PG8_SB(0, 1), b2 + hstep, voffB); PG8_STAGEA(PG8_SA(0, 0), o2, 0, kb2);
            PG8_WAIT_V(8); PG8_WAIT_L(0); PG8_BAR; PG8_MMA(1, 0, At, B0); PG8_MMA(1, 1, At, B1); PG8_BAR; PG8_SCHED;
            PG8_LDB(B0, 1, 0); PG8_LDB(B1, 1, 1); PG8_SCHED; PG8_LDA(At, 1, 0); PG8_STAGEA(PG8_SA(0, 1), o2, 1, kb2);
            PG8_WAIT_V(8); PG8_WAIT_L(0); PG8_BAR; PG8_MMA(0, 0, At, B0); PG8_MMA(0, 1, At, B1); PG8_BAR; PG8_SCHED;
            PG8_LDA(At, 1, 1); PG8_STAGE(PG8_SB(1, 0), b3, voffB); PG8_STAGE(PG8_SB(1, 1), b3 + hstep, voffB); PG8_STAGEA(PG8_SA(1, 0), o2, 0, kb3);
            PG8_WAIT_V(8); PG8_WAIT_L(0); PG8_BAR; PG8_MMA(1, 0, At, B0); PG8_MMA(1, 1, At, B1); PG8_BAR; PG8_SCHED;
        }
        if constexpr (FP8) asm volatile("s_nop 15\n\ts_nop 15" ::: "memory");
        if (wr == 0) PG8_BAR;
        { int fr_ = fr, fq_ = fq; asm volatile("" : "+v"(fr_), "+v"(fq_));
          E(acc, cur, wr, wc, fr_, fq_); }
        if (!has_next) break;
#pragma unroll
        for (int a = 0; a < 2; ++a)
#pragma unroll
            for (int b = 0; b < 2; ++b)
#pragma unroll
                for (int m = 0; m < 4; ++m)
#pragma unroll
                    for (int n = 0; n < 2; ++n) acc[a][b][m][n] = (f32x4){0.f, 0.f, 0.f, 0.f};
        cur = nxt; cB = nB; ++ui;
#pragma unroll
        for (int h = 0; h < 2; ++h)
#pragma unroll
            for (int i = 0; i < 2; ++i) cOff[h][i] = nOff[h][i];
        if (wr == 1) PG8_BAR;
    }
    PG8_WAIT_V(0);
    PG8_BAR;
#undef PG8_SA
#undef PG8_SB
#undef PG8_STAGE
#undef PG8_STAGEA
#undef PG8_LDA
#undef PG8_LD8
#undef PG8_LDB
#undef PG8_MMA
#undef PG8_WAIT_V
#undef PG8_WAIT_L
#undef PG8_BAR
#undef PG8_SCHED
}
}

namespace attn_body {
using bf16=__hip_bfloat16;
using bf16x8=__attribute__((ext_vector_type(8)))short;
using s16x4=__attribute__((ext_vector_type(4)))short;
using f32x16=__attribute__((ext_vector_type(16)))float;
using f32x4=__attribute__((ext_vector_type(4)))float;
using u32x4=__attribute__((ext_vector_type(4)))unsigned;
using u32x2=__attribute__((ext_vector_type(2)))unsigned;
constexpr int D=64,DM=HW;
constexpr int NW=8,QBLK=32,QB=QBLK*NW,KVBLK=64;
__device__ __forceinline__ int crow(int r,int hi){return (r&3)+8*(r>>2)+4*hi;}
#define SBAR() __builtin_amdgcn_sched_barrier(0)
__device__ __forceinline__ void cmask(f32x16&p0,f32x16&p1,int jb,int qrel,int hi){
  const float NEG=-INFINITY; const int d=qrel-64*jb-4*hi;
  #pragma unroll
  for(int r=0;r<16;++r){const int c=(r&3)+8*(r>>2); if(c>d)p0[r]=NEG; if(c+32>d)p1[r]=NEG;}
}
__device__ __forceinline__ void addmask(f32x16&p0,f32x16&p1,float addv){
  #pragma unroll
  for(int r=0;r<16;++r){p0[r]+=addv;p1[r]+=addv;}
}
typedef __attribute__((address_space(3))) const char* lds_cptr;
__device__ __forceinline__ float mselect(int m,float v){ return __uint_as_float((__float_as_uint(v)&(unsigned)m)|(0xff800000u&~(unsigned)m)); }
__device__ __forceinline__ void bitmask(f32x16&p0,f32x16&p1,lds_cptr mrow,int t,int hi){
  const u32x2 w=*(const __attribute__((address_space(3))) u32x2*)(mrow+((t>>2)&1)*1024+((t>>1)&1)*512+(t&1)*8);
  const int w0=(int)(w.x>>(4*hi)),w1=(int)(w.y>>(4*hi));
  #pragma unroll
  for(int r=0;r<16;++r){const int bpos=(r&3)+8*(r>>2); p0[r]=mselect(__builtin_amdgcn_sbfe(w0,bpos,1),p0[r]); p1[r]=mselect(__builtin_amdgcn_sbfe(w1,bpos,1),p1[r]);}
}

constexpr int NSLOT=3, SLOTB=8192;
constexpr int LDS_K=0, LDS_V=NSLOT*SLOTB, LDS_WS=2*NSLOT*SLOTB, LDS_OST=LDS_WS+NW*64*4, LDS_MSK=LDS_OST+NW*4096, LDS_BYTES=LDS_MSK+NW*2048;
__device__ __forceinline__ void glds16(const void*gsrc,unsigned lds_dst){unsigned keep;
  asm volatile("s_mov_b32 %0, m0\n\ts_mov_b32 m0, %2\n\ts_nop 0\n\tglobal_load_lds_dwordx4 %1, off\n\ts_mov_b32 m0, %0":"=&s"(keep):"v"(gsrc),"s"(lds_dst):"memory");}
__device__ __forceinline__ float max3f(float a,float b,float c){float r;asm("v_max3_f32 %0, %1, %2, %3":"=v"(r):"v"(a),"v"(b),"v"(c));return r;}
__device__ __forceinline__ float max2f(float a,float b){float r;asm("v_max_f32_e32 %0, %1, %2":"=v"(r):"v"(a),"v"(b));return r;}
__device__ __forceinline__ float fadd_s(float a,float b){float r;asm("v_add_f32_e32 %0, %1, %2":"=v"(r):"v"(a),"v"(b));return r;}
__device__ __forceinline__ float fsub_s(float a,float b){float r;asm("v_sub_f32_e32 %0, %1, %2":"=v"(r):"v"(a),"v"(b));return r;}
typedef float f32x2_t __attribute__((ext_vector_type(2))); typedef __bf16 bf16x2_t __attribute__((ext_vector_type(2)));
__device__ __forceinline__ unsigned cvtpk_s(float lo,float hi){f32x2_t v={lo,hi};bf16x2_t b=__builtin_convertvector(v,bf16x2_t);return __builtin_bit_cast(unsigned,b);}
#define WAIT_BAR(N) asm volatile("s_waitcnt vmcnt(" #N ") lgkmcnt(0)\n\ts_barrier":::"memory")

__device__ __forceinline__ void qkt(f32x16&p0,f32x16&p1,const char*Kslot,const bf16x8*qr,int r32,int hi){
  const f32x16 negm=f32x16{};
  const char*kb=Kslot+hi*1024+r32*16;
  #pragma unroll
  for(int d0=0;d0<4;++d0){
    const bf16x8 b0=*reinterpret_cast<const bf16x8*>(kb+d0*2048);
    const bf16x8 b1=*reinterpret_cast<const bf16x8*>(kb+d0*2048+512);
    if(d0==0){p0=__builtin_amdgcn_mfma_f32_32x32x16_bf16(b0,qr[0],negm,0,0,0);p1=__builtin_amdgcn_mfma_f32_32x32x16_bf16(b1,qr[0],negm,0,0,0);}
    else{p0=__builtin_amdgcn_mfma_f32_32x32x16_bf16(b0,qr[d0],p0,0,0,0);p1=__builtin_amdgcn_mfma_f32_32x32x16_bf16(b1,qr[d0],p1,0,0,0);}}
}
typedef short v4i16_t __attribute__((ext_vector_type(4)));
__device__ __forceinline__ void kload8(bf16x8*kf,lds_cptr kp){
  kf[0]=*(const __attribute__((address_space(3))) bf16x8*)(kp);      kf[1]=*(const __attribute__((address_space(3))) bf16x8*)(kp+512);
  kf[2]=*(const __attribute__((address_space(3))) bf16x8*)(kp+2048); kf[3]=*(const __attribute__((address_space(3))) bf16x8*)(kp+2560);
  kf[4]=*(const __attribute__((address_space(3))) bf16x8*)(kp+4096); kf[5]=*(const __attribute__((address_space(3))) bf16x8*)(kp+4608);
  kf[6]=*(const __attribute__((address_space(3))) bf16x8*)(kp+6144); kf[7]=*(const __attribute__((address_space(3))) bf16x8*)(kp+6656);
}
__device__ __forceinline__ void kload2(bf16x8*kf,lds_cptr kp,int j){ kf[2*j]=*(const __attribute__((address_space(3))) bf16x8*)(kp+j*2048); kf[2*j+1]=*(const __attribute__((address_space(3))) bf16x8*)(kp+j*2048+512); }
__device__ __forceinline__ s16x4 vtr(lds_cptr p){ return __builtin_bit_cast(s16x4,__builtin_amdgcn_ds_read_tr16_b64_v4i16((__attribute__((address_space(3))) v4i16_t*)p)); }
__device__ __forceinline__ float rowmax(const f32x16&p0,const f32x16&p1){
  float a=max3f(p0[0],p0[1],p1[0]),b=max3f(p0[2],p0[3],p1[1]);a=max3f(a,p1[2],p1[3]);
  #pragma unroll
  for(int r=4;r<16;r+=4){a=max3f(a,p0[r],p0[r+1]);b=max3f(b,p0[r+2],p0[r+3]);a=max3f(a,p1[r],p1[r+1]);b=max3f(b,p1[r+2],p1[r+3]);}
  const float m=max2f(a,b);
  auto rr=__builtin_amdgcn_permlane32_swap(__float_as_uint(m),__float_as_uint(m),false,false);
  return max2f(__uint_as_float(rr[0]),__uint_as_float(rr[1]));
}
__device__ __forceinline__ void pv(f32x16*o,int vb,bf16x8 pa0,bf16x8 pa1,bf16x8 pa2,bf16x8 pa3){
  #pragma unroll
  for(int d0=0;d0<2;++d0){s16x4 lo[4],hi[4];
    #pragma unroll
    for(int ks=0;ks<4;++ks){
      asm volatile("ds_read_b64_tr_b16 %0,%1 offset:%c2":"=&v"(lo[ks]):"v"(vb),"i"(d0*4096+ks*1024):"memory");
      asm volatile("ds_read_b64_tr_b16 %0,%1 offset:%c2":"=&v"(hi[ks]):"v"(vb),"i"(d0*4096+ks*1024+512):"memory");}
    asm volatile("s_waitcnt lgkmcnt(0)":::"memory");SBAR();
    #define PK(k) (bf16x8){lo[k][0],lo[k][1],lo[k][2],lo[k][3],hi[k][0],hi[k][1],hi[k][2],hi[k][3]}
    o[d0]=__builtin_amdgcn_mfma_f32_32x32x16_bf16(pa0,PK(0),o[d0],0,0,0);
    o[d0]=__builtin_amdgcn_mfma_f32_32x32x16_bf16(pa1,PK(1),o[d0],0,0,0);
    o[d0]=__builtin_amdgcn_mfma_f32_32x32x16_bf16(pa2,PK(2),o[d0],0,0,0);
    o[d0]=__builtin_amdgcn_mfma_f32_32x32x16_bf16(pa3,PK(3),o[d0],0,0,0);
    #undef PK
  }
}
#ifndef ATTN_STORE16
#define ATTN_STORE16(p,v) (*(u32x4*)(p)=(v))
#endif
__device__ __forceinline__ float bfs(short s){ return __uint_as_float(((unsigned)(unsigned short)s)<<16); }

template<int MODE,int THRL> __device__ __forceinline__ void attn_unit(int b,int h,int qb,const bf16*Q,const bf16*__restrict__ K,const bf16*__restrict__ V,unsigned char*O,char*shm,
                                                                      const float*kbsum,const unsigned long long*maskw,const int tid){
  const int lane=tid&63,r32=lane&31,hi=lane>>5; const int wid=__builtin_amdgcn_readfirstlane(tid>>6);
  const long rowbase=(long)b*SEQ; const int q0=qb*QB;
  const bf16*Qw=Q+(rowbase+q0+wid*QBLK)*DM+h*D;
  const bf16*Kh=K+rowbase*DM+h*D,*Vh=V+rowbase*DM+h*D;
  const unsigned lds0=(unsigned)(uintptr_t)shm;
  float*wsf=(float*)(shm+LDS_WS)+wid*64;
  const unsigned koff=(unsigned)((lane*DM+wid*8)*2);
  const unsigned voff=(unsigned)(((16*(wid&3)+(lane>>2))*DM+(wid>>2)*32+(lane&3)*8)*2);
  const unsigned kdst=lds0+LDS_K+wid*1024, vdst=lds0+LDS_V+wid*1024;
  #define DMA_K(t,slot) glds16((const char*)Kh+(size_t)(t)*(KVBLK*DM*2)+koff,(unsigned)__builtin_amdgcn_readfirstlane(kdst+(slot)))
  #define DMA_V(t,slot) glds16((const char*)Vh+(size_t)(t)*(KVBLK*DM*2)+voff,(unsigned)__builtin_amdgcn_readfirstlane(vdst+(slot)))
  const unsigned long long*mbase=maskw+(size_t)(rowbase+q0+wid*QBLK)*32;
  const unsigned moff=(unsigned)((r32*32+2*hi)*8);
  const unsigned mdst=lds0+LDS_MSK+wid*2048;
  #define DMA_M(tg) glds16((const char*)mbase+(size_t)(32*(tg))+moff,(unsigned)__builtin_amdgcn_readfirstlane(mdst+((tg)&1)*1024))
  const bool usebits=(MODE==1)&&(qb>0);
  const int vb0=(int)(lds0+LDS_V)+((lane>>4)&1)*32+(lane&3)*8+(4*hi+((lane&15)>>2))*64;
  const char*Kbase=shm+LDS_K; bf16x8 kf[8];
  const lds_cptr shm3=(lds_cptr)shm; const lds_cptr kp0=shm3+LDS_K+hi*1024+r32*16; const lds_cptr vp0=shm3+LDS_V+((lane>>4)&1)*32+(lane&3)*8+(4*hi+((lane&15)>>2))*64;
  const lds_cptr mrow=shm3+LDS_MSK+wid*2048+r32*16;
  const int NT=(q0+QB)/KVBLK;
  if(usebits){DMA_M(0);}
  DMA_K(0,0);DMA_V(0,0);DMA_K(1,SLOTB);
  bf16x8 qr[4];
  #pragma unroll
  for(int d0=0;d0<4;++d0)qr[d0]=*reinterpret_cast<const bf16x8*>(&Qw[(long)r32*DM+d0*16+hi*8]);
  unsigned selbits=(1u<<qb)-1u;
  if(MODE==0&&qb>3){
    float g[7];
    #pragma unroll
    for(int j=0;j<7;++j){ g[j]=0.f;
      if(j<qb){ const float*kbp=kbsum+((size_t)(b*NHEAD+h)*8+j)*64+hi*8; float s=0.f;
        #pragma unroll
        for(int d0=0;d0<4;++d0){ const f32x4 k0=*(const f32x4*)(kbp+d0*16),k1=*(const f32x4*)(kbp+d0*16+4);
          s+=bfs(qr[d0][0])*k0[0]+bfs(qr[d0][1])*k0[1]+bfs(qr[d0][2])*k0[2]+bfs(qr[d0][3])*k0[3]+bfs(qr[d0][4])*k1[0]+bfs(qr[d0][5])*k1[1]+bfs(qr[d0][6])*k1[2]+bfs(qr[d0][7])*k1[3]; }
        s+=__shfl_xor(s,32); g[j]=s; } }
    selbits=0u;
    #pragma unroll
    for(int j=0;j<7;++j){ if(j<qb){ int rank=0;
      #pragma unroll
      for(int i=0;i<7;++i){ if(i!=j&&i<qb){ rank+=(g[i]>g[j]||(g[i]==g[j]&&i<j))?1:0; } }
      if(rank<3)selbits|=(1u<<j); } }
  }
  float mhat=0.f,l_reg=0.f;f32x16 o[2];o[0]=f32x16{};o[1]=f32x16{};const f32x16 zero16=f32x16{};
  const int qrel=wid*QBLK+r32;
  #define AMASK_PEEL(P0,P1,t) do{ const int jb_=(t)-(NT-4); \
      if(usebits){ bitmask(P0,P1,mrow,(t),hi); } \
      else if(jb_>=0){ cmask(P0,P1,jb_,qrel,hi); } }while(0)
  #define ADDV_PEEL(t) ((MODE==0&&(t)<NT-4)?(((selbits>>((t)>>2))&1u)?0.f:-INFINITY):0.f)
  #define AMASK_STEADY(P0,P1,t) do{ if(MODE==1){ bitmask(P0,P1,mrow,(t),hi); } }while(0)
  #define ADDV_STEADY(t) ((MODE==0)?(((selbits>>((t)>>2))&1u)?0.f:-INFINITY):0.f)
  #define CMASK(P0,P1,t) AMASK_PEEL(P0,P1,t)
  #define ADDV(t) ADDV_PEEL(t)
  bool resc=false;
  #define START(P0,P1) do{ const float rm=rowmax(P0,P1); resc=false; \
    { const float dl=(rm<-1e30f)?0.f:rm; mhat=fadd_s(mhat,dl); \
      _Pragma("unroll") for(int r=0;r<16;++r){P0[r]=fsub_s(P0[r],dl);P1[r]=fsub_s(P1[r],dl);} } \
    _Pragma("unroll") for(int r=0;r<16;++r)P0[r]=__builtin_amdgcn_exp2f(P0[r]); }while(0)
  #define RESC() do{ if(resc){ asm volatile("s_waitcnt lgkmcnt(0)":::"memory"); \
      _Pragma("unroll") for(int d_=0;d_<2;++d_) _Pragma("unroll") for(int r=0;r<16;++r)o[d_][r]*=wsf[crow(r,hi)]; } }while(0)
  f32x16 pA0,pA1,pB0,pB1;
  int sl_prev=0,sl_cur=0,sl_next=SLOTB;
  #define ROT() do{sl_prev=sl_cur;sl_cur=sl_next;sl_next=(sl_next==(NSLOT-1)*SLOTB)?0:sl_next+SLOTB;}while(0)
  DMA_K(2,2*SLOTB);
  WAIT_BAR(3);
  qkt(pA0,pA1,Kbase,qr,r32,hi);asm volatile("s_nop 15\n\ts_nop 7":"+v"(pA0),"+v"(pA1));CMASK(pA0,pA1,0);
  if(MODE==0){ addmask(pA0,pA1,ADDV(0)); }
  asm volatile("s_nop 7":"+v"(pA0),"+v"(pA1));
  START(pA0,pA1);
  _Pragma("unroll") for(int r=0;r<16;++r)pA1[r]=__builtin_amdgcn_exp2f(pA1[r]);
  WAIT_BAR(0);
  if(usebits&&NT>4){DMA_M(1);}
  DMA_K(3,0);DMA_V(1,SLOTB);
  ROT();
  kload8(kf,kp0+sl_cur);
  WAIT_BAR(2);
  s16x4 vlo[8],vhi[8]; u32x4 pw0,pw1,pw2,pw3;
  #define PKW(P,B) cvtpk_s(P[B],P[B+1])
  #define PAF(k) __builtin_bit_cast(bf16x8,pw##k)
  #define VFR(i) (bf16x8){vlo[i][0],vlo[i][1],vlo[i][2],vlo[i][3],vhi[i][0],vhi[i][1],vhi[i][2],vhi[i][3]}
  #define PIN(x) asm volatile("":"+v"(x))
  #define MX3(a,b,c) __builtin_fmaxf(__builtin_fmaxf((a),(b)),(c))
  #define GAPA(MF,A0,A1,A2,A3,W0,W1,PW) do{ MF; sacc+=A0; sacc+=A1; sacc+=A2; sacc+=A3; PIN(sacc); W0; W1; PIN(PW); SBAR(); }while(0)
  #define EX(v) __builtin_amdgcn_exp2f(v)
  #define GAPB(MF,X,B) do{ MF; X[B]=EX(X[B]); X[B+1]=EX(X[B+1]); X[B+2]=EX(X[B+2]); X[B+3]=EX(X[B+3]); PIN(X); SBAR(); }while(0)
  #define VRD(i) do{ vlo[i]=vtr(vp_+(((i)>>2)*4096+((i)&3)*1024)); vhi[i]=vtr(vp_+(((i)>>2)*4096+((i)&3)*1024+512)); }while(0)
  #define KRD(G,j) do{ if(G){ kload2(kf,kp0+sl_next,j); SBAR(); } }while(0)
  #define STEP(C0,C1,P0,P1,t,GK,GV,GL,GM) do{ SBAR(); \
    const lds_cptr vp_=vp0+sl_prev; \
    VRD(0); SBAR(); float sacc=(P0[0]+P0[1]); \
    GAPA(C0=__builtin_amdgcn_mfma_f32_32x32x16_bf16(kf[0],qr[0],zero16,0,0,0), P0[2],P0[3],P0[4],P0[5],     pw0[0]=PKW(P0,0), pw0[1]=PKW(P0,2), pw0); \
    VRD(4); SBAR(); GAPA(C1=__builtin_amdgcn_mfma_f32_32x32x16_bf16(kf[1],qr[0],zero16,0,0,0), P0[6],P0[7],P0[8],P0[9],     pw0[2]=PKW(P0,4), pw0[3]=PKW(P0,6), pw0); \
    VRD(1); SBAR(); GAPA(C0=__builtin_amdgcn_mfma_f32_32x32x16_bf16(kf[2],qr[1],C0,0,0,0),   P0[10],P0[11],P0[12],P0[13], pw1[0]=PKW(P0,8), pw1[1]=PKW(P0,10), pw1); \
    VRD(5); SBAR(); GAPA(C1=__builtin_amdgcn_mfma_f32_32x32x16_bf16(kf[3],qr[1],C1,0,0,0),   P0[14],P0[15],P1[0],P1[1],   pw1[2]=PKW(P0,12),pw1[3]=PKW(P0,14), pw1); \
    VRD(2); SBAR(); GAPA(C0=__builtin_amdgcn_mfma_f32_32x32x16_bf16(kf[4],qr[2],C0,0,0,0),   P1[2],P1[3],P1[4],P1[5],     pw2[0]=PKW(P1,0), pw2[1]=PKW(P1,2), pw2); \
    VRD(6); SBAR(); GAPA(C1=__builtin_amdgcn_mfma_f32_32x32x16_bf16(kf[5],qr[2],C1,0,0,0),   P1[6],P1[7],P1[8],P1[9],     pw2[2]=PKW(P1,4), pw2[3]=PKW(P1,6), pw2); \
    VRD(3); SBAR(); GAPA(C0=__builtin_amdgcn_mfma_f32_32x32x16_bf16(kf[6],qr[3],C0,0,0,0),   P1[10],P1[11],P1[12],P1[13], pw3[0]=PKW(P1,8), pw3[1]=PKW(P1,10), pw3); \
    VRD(7); SBAR(); GAPA(C1=__builtin_amdgcn_mfma_f32_32x32x16_bf16(kf[7],qr[3],C1,0,0,0),   P1[14],P1[15],0.f,0.f,       pw3[2]=PKW(P1,12),pw3[3]=PKW(P1,14), pw3); \
    l_reg+=sacc; \
    if(GM){DMA_M(((t)>>2)+1);} \
    if(GK){DMA_K((t)+3,sl_cur);} if(GV){DMA_V((t)+1,sl_next);} \
    CMASK(C0,C1,t); \
    { float a=MX3(C0[0],C0[1],C1[0]),b=MX3(C0[2],C0[3],C1[1]); a=MX3(a,C1[2],C1[3]); \
      _Pragma("unroll") for(int r=4;r<16;r+=4){a=MX3(a,C0[r],C0[r+1]);b=MX3(b,C0[r+2],C0[r+3]);a=MX3(a,C1[r],C1[r+1]);b=MX3(b,C1[r+2],C1[r+3]);} \
      float rm=__builtin_fmaxf(a,b); { auto rr=__builtin_amdgcn_permlane32_swap(__float_as_uint(rm),__float_as_uint(rm),false,false); rm=__builtin_fmaxf(__uint_as_float(rr[0]),__uint_as_float(rr[1])); } \
      const float addv_=ADDV(t); rm=(rm+addv_)-mhat; \
      resc=false; \
      if(__builtin_expect(__any(rm>(float)THRL),0)){ const float dl=__builtin_fmaxf(rm,0.f); mhat+=dl; \
        const float f=__builtin_amdgcn_exp2f(-dl); l_reg*=f; if(hi==0)wsf[r32]=f; resc=true; } \
      const float sub_=mhat-addv_; \
      _Pragma("unroll") for(int r=0;r<16;++r){C0[r]-=sub_;C1[r]-=sub_;} } \
    SBAR(); \
    GAPB(o[0]=__builtin_amdgcn_mfma_f32_32x32x16_bf16(PAF(0),VFR(0),o[0],0,0,0), C0,0); \
    GAPB(o[1]=__builtin_amdgcn_mfma_f32_32x32x16_bf16(PAF(0),VFR(4),o[1],0,0,0), C0,4); \
    KRD(GL,0); GAPB(o[0]=__builtin_amdgcn_mfma_f32_32x32x16_bf16(PAF(1),VFR(1),o[0],0,0,0), C0,8); \
    KRD(GL,1); GAPB(o[1]=__builtin_amdgcn_mfma_f32_32x32x16_bf16(PAF(1),VFR(5),o[1],0,0,0), C0,12); \
    KRD(GL,2); GAPB(o[0]=__builtin_amdgcn_mfma_f32_32x32x16_bf16(PAF(2),VFR(2),o[0],0,0,0), C1,0); \
    KRD(GL,3); GAPB(o[1]=__builtin_amdgcn_mfma_f32_32x32x16_bf16(PAF(2),VFR(6),o[1],0,0,0), C1,4); \
    GAPB(o[0]=__builtin_amdgcn_mfma_f32_32x32x16_bf16(PAF(3),VFR(3),o[0],0,0,0), C1,8); \
    GAPB(o[1]=__builtin_amdgcn_mfma_f32_32x32x16_bf16(PAF(3),VFR(7),o[1],0,0,0), C1,12); \
    }while(0)
  int t=1;
  #undef CMASK
  #undef ADDV
  #define CMASK(P0,P1,t) AMASK_STEADY(P0,P1,t)
  #define ADDV(t) ADDV_STEADY(t)
  for(;t+5<NT;t+=2){
    STEP(pB0,pB1,pA0,pA1,t,true,true,true,false);     WAIT_BAR(2); RESC(); ROT();
    STEP(pA0,pA1,pB0,pB1,t+1,true,true,true,(MODE==1&&(((t+1)&3)==0)&&(t+5<NT)));   WAIT_BAR(2); RESC(); ROT();
  }
  #undef CMASK
  #undef ADDV
  #define CMASK(P0,P1,t) AMASK_PEEL(P0,P1,t)
  #define ADDV(t) ADDV_PEEL(t)
  #define ENDW(tt) do{ if((tt)+3<NT){WAIT_BAR(2);} else if((tt)+2<NT){WAIT_BAR(1);} else {WAIT_BAR(0);} }while(0)
  for(;t+1<NT;t+=2){
    STEP(pB0,pB1,pA0,pA1,t,(t+3<NT),(t+1<NT),(t+1<NT),false);       ENDW(t);   RESC(); ROT();
    STEP(pA0,pA1,pB0,pB1,t+1,(t+4<NT),(t+2<NT),(t+2<NT),false);     ENDW(t+1); RESC(); ROT();
  }
  STEP(pB0,pB1,pA0,pA1,NT-1,false,false,false,false); RESC();
  { float sacc=pB0[0]+pB0[1]; _Pragma("unroll") for(int r=2;r<16;++r)sacc+=pB0[r]; _Pragma("unroll") for(int r=0;r<16;++r)sacc+=pB1[r]; l_reg+=sacc;
    pw0=(u32x4){PKW(pB0,0),PKW(pB0,2),PKW(pB0,4),PKW(pB0,6)};pw1=(u32x4){PKW(pB0,8),PKW(pB0,10),PKW(pB0,12),PKW(pB0,14)};pw2=(u32x4){PKW(pB1,0),PKW(pB1,2),PKW(pB1,4),PKW(pB1,6)};pw3=(u32x4){PKW(pB1,8),PKW(pB1,10),PKW(pB1,12),PKW(pB1,14)};
    SBAR(); pv(o,vb0+sl_cur,PAF(0),PAF(1),PAF(2),PAF(3)); }
  #undef PKW
  #undef PAF
  #undef VFR
  #undef PIN
  #undef MX3
  #undef GAPA
  #undef GAPB
  #undef EX
  #undef VRD
  #undef KRD
  #undef STEP
  #undef ENDW
  {auto rr=__builtin_amdgcn_permlane32_swap(__float_as_uint(l_reg),__float_as_uint(l_reg),false,false);l_reg=__uint_as_float(rr[0])+__uint_as_float(rr[1]);}
  if(hi==0)wsf[32+r32]=l_reg;asm volatile("s_waitcnt lgkmcnt(0)":::"memory");
  float rli[16];
  #pragma unroll
  for(int r=0;r<16;++r)rli[r]=__builtin_amdgcn_rcpf(wsf[32+crow(r,hi)]);
  unsigned char*Ow=O+(rowbase+q0+wid*QBLK)*DM+h*D;
  { bf16*stg=(bf16*)(shm+LDS_OST)+wid*2048;
    #pragma unroll
    for(int r=0;r<16;++r){const int orow=crow(r,hi);
      #pragma unroll
      for(int d0=0;d0<2;++d0)stg[orow*64+d0*32+r32]=__float2bfloat16(o[d0][r]*rli[r]);}
    asm volatile("s_waitcnt lgkmcnt(0)":::"memory");
    #pragma unroll
    for(int i=0;i<4;++i){const int row=i*8+(lane>>3),ch=lane&7; const u32x4 v=*(const u32x4*)(stg+row*64+ch*8); u32x2 w;
      w.x=pg8::cvt4_fp8(16.f*__uint_as_float(v.x<<16),16.f*__uint_as_float(v.x&0xffff0000u),16.f*__uint_as_float(v.y<<16),16.f*__uint_as_float(v.y&0xffff0000u));
      w.y=pg8::cvt4_fp8(16.f*__uint_as_float(v.z<<16),16.f*__uint_as_float(v.z&0xffff0000u),16.f*__uint_as_float(v.w<<16),16.f*__uint_as_float(v.w&0xffff0000u));
      *(u32x2*)(Ow+(long)row*DM+ch*8)=w;} }
  asm volatile("s_waitcnt lgkmcnt(0)\n\ts_barrier":::"memory");
  #undef DMA_K
  #undef DMA_V
  #undef DMA_M
  #undef CMASK
  #undef AMASK_PEEL
  #undef AMASK_STEADY
  #undef ADDV
  #undef ADDV_PEEL
  #undef ADDV_STEADY
  #undef START
  #undef RESC
  #undef ROT
}
constexpr int ATTN_LDS_BYTES=LDS_BYTES;
#undef SBAR
#undef WAIT_BAR
}

constexpr int NWAVES = 8;
constexpr size_t MiB = 1u << 20;
constexpr size_t WS_CTL = 0, CTL_ZERO_BYTES = 1 * MiB;
constexpr size_t WS_WIN = 1 * MiB, WS_WA = 13 * MiB, WS_WB = 14 * MiB, WS_WOUT = 15 * MiB, WS_W13 = 17 * MiB, WS_W2 = 81 * MiB;
constexpr size_t WS_WR = 113 * MiB, WS_ROPE = 113 * MiB + 512 * 1024;
constexpr size_t WS_RSTD1 = 114 * MiB, WS_RSTD2 = 114 * MiB + 256 * 1024, WS_KBSUM = 114 * MiB + 512 * 1024;
constexpr size_t WS_KI = 115 * MiB, WS_WI = 123 * MiB, WS_MASK = 125 * MiB, WS_TOK = 141 * MiB, WS_GATE = 149 * MiB;
constexpr size_t WS_RSORT = WS_KI, WS_GSORT = WS_MASK;
constexpr size_t WS_QA = 152 * MiB, WS_KA = 216 * MiB, WS_VA = 280 * MiB, WS_QB = 344 * MiB, WS_KB = 408 * MiB, WS_VB = 472 * MiB, WS_QI = 536 * MiB;
constexpr size_t WS_XB = 600 * MiB, WS_OA = 928 * MiB, WS_OB = 960 * MiB, WS_MIX = 216 * MiB, WS_X1B = 728 * MiB, WS_HID = 856 * MiB, WS_YS = 152 * MiB, WS_END = 1024 * MiB;
constexpr size_t WS_WR8 = 113 * MiB + 256 * 1024;
constexpr size_t WS_X1H = 280 * MiB, WS_X1L = 408 * MiB;
static_assert(WS_HID + (size_t)HID_ROWS * EFF <= WS_OA, "ws map");
constexpr size_t WS_MIX8 = 152 * MiB;
constexpr size_t WS_WIN8 = WS_WIN + 6 * MiB, WS_X8 = 728 * MiB;
static_assert(WS_WIN + (size_t)NINA * DMODEL * 2 <= WS_WIN8 && WS_WIN8 + (size_t)NINB * DMODEL <= WS_WA, "ws map");
constexpr int CW_CNT = 64;
constexpr int CW_BAR = 4096;
constexpr int RING_BYTES = 131072, SCR_BYTES = 132096, MISC_OFF = SCR_BYTES, LDS_BYTES = 147456;
constexpr int SC_STRIDE = 2052;
static_assert(16 * SC_STRIDE * 4 <= SCR_BYTES && attn_body::ATTN_LDS_BYTES <= RING_BYTES, "lds map");

#define GAS __attribute__((address_space(1)))
#define LAS __attribute__((address_space(3)))
typedef unsigned short bf16;
typedef unsigned v4u __attribute__((ext_vector_type(4)));
typedef unsigned v2u __attribute__((ext_vector_type(2)));
typedef float f32x4 __attribute__((ext_vector_type(4)));
typedef short bf16x8 __attribute__((ext_vector_type(8)));
#define LDS_WAIT() asm volatile("s_waitcnt lgkmcnt(0)" ::: "memory")
__device__ __forceinline__ unsigned f2bf(float f) { unsigned u = __builtin_bit_cast(unsigned, f); return (u + 0x7fffu + ((u >> 16) & 1u)) >> 16; }
__device__ __forceinline__ unsigned pk2(float lo, float hi) { return f2bf(lo) | (f2bf(hi) << 16); }
__device__ __forceinline__ float bf2f(unsigned s) { return __uint_as_float(s << 16); }

#define XB_TMO      128
#define XB_XCNT(j)  (256  + 64 * (j))
#define XB_XSUB(j)  (1280 + 64 * (j))
#define XB_XGEN(j)  (2304 + 64 * (j))
#define XB_TOP      3328
#define XB_TOPGEN   3392
#define XCD_BAR_WORDS 3456
#define XB_SPIN_CAP (1u << 22)
__device__ __forceinline__ unsigned xb_ld(unsigned* p)              { return __hip_atomic_load(p, __ATOMIC_RELAXED, __HIP_MEMORY_SCOPE_AGENT); }
__device__ __forceinline__ unsigned xb_add(unsigned* p, unsigned v) { return __hip_atomic_fetch_add(p, v, __ATOMIC_RELAXED, __HIP_MEMORY_SCOPE_AGENT); }
__device__ __forceinline__ unsigned xb_xcc_id() { return (unsigned)__builtin_amdgcn_s_getreg((3 << 11) | 20) & 0xFu; }
#define XB_SPIN(cond, bar) do { unsigned _sp = 0; while (cond) { __builtin_amdgcn_s_sleep(1); \
    if ((++_sp & 255u) == 0u) { if (xb_ld(&(bar)[XB_TMO])) break; if (_sp > XB_SPIN_CAP) { atomicAdd(&(bar)[XB_TMO], 1u); break; } } } } while (0)
struct XcdBarrier { unsigned* bar; unsigned x; volatile LAS unsigned* st; };
__device__ __forceinline__ XcdBarrier xcd_barrier_post(unsigned* bar, volatile LAS unsigned* st, int tid) {
    XcdBarrier b; b.bar = bar; b.x = xb_xcc_id(); b.st = st;
    if (tid == 0) (void)xb_add(&bar[XB_XCNT(b.x)], 1u);
    return b;
}
__device__ __forceinline__ void xcd_barrier_complete(unsigned* bar, unsigned x, unsigned G, unsigned& nloc, unsigned& nx) {
    unsigned sum, cnt, mine, sp = 0u;
    for (;;) {
        sum = 0u; cnt = 0u; mine = 0u;
#pragma unroll
        for (unsigned j = 0; j < 16; ++j) { const unsigned c = xb_ld(&bar[XB_XCNT(j)]); sum += c; cnt += (c > 0u) ? 1u : 0u; mine = (j == x) ? c : mine; }
        if (sum == G) break;
        __builtin_amdgcn_s_sleep(1);
        if ((++sp & 255u) == 0u) { if (xb_ld(&bar[XB_TMO])) break; if (sp > XB_SPIN_CAP) { atomicAdd(&bar[XB_TMO], 1u); break; } }
    }
    nloc = mine > 0u ? mine : 1u; nx = cnt > 0u ? cnt : 1u;
}
__device__ __forceinline__ void xcd_barrier(const XcdBarrier& b, int tid, unsigned G) {
    asm volatile("s_waitcnt vmcnt(0)" ::: "memory");
    __syncthreads();
    if (tid == 0) {
        unsigned* bar = b.bar;
        __builtin_amdgcn_s_waitcnt(0);
        unsigned nloc = b.st[0], nx = b.st[1];
        if (nloc == 0u) { xcd_barrier_complete(bar, b.x, G, nloc, nx); b.st[0] = nloc; b.st[1] = nx; }
        const unsigned old = xb_add(&bar[XB_XSUB(b.x)], 1u);
        const unsigned gen = old / nloc;
        if (old + 1u == (gen + 1u) * nloc) {
            __builtin_amdgcn_fence(__ATOMIC_RELEASE, "agent");
            asm volatile("s_waitcnt vmcnt(0)" ::: "memory");
            const unsigned og = xb_add(&bar[XB_TOP], 1u);
            const unsigned tg = og / nx;
            if (og + 1u == (tg + 1u) * nx) xb_add(&bar[XB_TOPGEN], 1u);
            else XB_SPIN(xb_ld(&bar[XB_TOPGEN]) == tg, bar);
            __builtin_amdgcn_fence(__ATOMIC_ACQUIRE, "agent");
            xb_add(&bar[XB_XGEN(b.x)], 1u);
            asm volatile("s_waitcnt vmcnt(0)" ::: "memory");
        } else {
            XB_SPIN(xb_ld(&bar[XB_XGEN(b.x)]) == gen, bar);
            __builtin_amdgcn_fence(__ATOMIC_ACQUIRE, "agent");
            asm volatile("s_waitcnt vmcnt(0)" ::: "memory");
        }
    }
    __syncthreads();
}

struct Frame {
    LAS unsigned char* lds; unsigned char* ldsg;
    int tid, lane, wave, vcu, G;
    const float *x, *g_mix, *w_in, *w_pa, *w_pb, *w_out, *g_ffn, *w_group, *b_group, *w_expert, *b_expert, *w1, *w3, *w2, *g_final;
    float* out; unsigned char* ws;
};

__device__ __forceinline__ int lane_id_v() { int l; asm volatile("v_mbcnt_lo_u32_b32 %0, -1, 0\n\tv_mbcnt_hi_u32_b32 %0, -1, %0" : "=v"(l)); return l; }
__device__ __forceinline__ float wave_sum(float v) {
#pragma unroll
    for (int o = 1; o < 64; o <<= 1) v += __shfl_xor(v, o);
    return v;
}

struct P0Item { const float* sp; const float* kscale; bf16* WT; unsigned sstride; int K, nrow0, k0; float mulz; float f8scale; };
__device__ __forceinline__ void p0_load(const P0Item& d, int lane, float (&v)[32], f32x4& g0, f32x4& g1) {
    const int c = lane & 7; g0 = (f32x4){1.f, 1.f, 1.f, 1.f}; g1 = g0;
    if (d.kscale) { g0 = *(const GAS f32x4*)(d.kscale + d.k0 + 8 * c); g1 = *(const GAS f32x4*)(d.kscale + d.k0 + 8 * c + 4); }
#pragma unroll
    for (int i = 0; i < 32; ++i) { const int kk = 2 * i + (lane >> 5); v[i] = d.sp[(size_t)(d.k0 + kk) * d.sstride]; }
}
__device__ __forceinline__ void p0_finish(const P0Item& d, int lane, const float (&v)[32], LAS float* scr, f32x4 g0, f32x4 g1) {
#pragma unroll
    for (int i = 0; i < 32; ++i) { const int kk = 2 * i + (lane >> 5); scr[kk * 33 + (lane & 31)] = v[i] * d.mulz; }
    LDS_WAIT(); asm volatile("" ::: "memory");
    const int c = lane & 7;
    if (d.f8scale != 0.f) { g0 = g0 * d.f8scale; g1 = g1 * d.f8scale;
#pragma unroll
        for (int j = 0; j < 4; ++j) { const int n = (lane >> 3) + 8 * j; const LAS float* s = scr + (8 * c) * 33 + n;
            v2u o; o.x = pg8::cvt4_fp8(s[0 * 33] * g0[0], s[1 * 33] * g0[1], s[2 * 33] * g0[2], s[3 * 33] * g0[3]); o.y = pg8::cvt4_fp8(s[4 * 33] * g1[0], s[5 * 33] * g1[1], s[6 * 33] * g1[2], s[7 * 33] * g1[3]);
            *(GAS v2u*)((unsigned char*)d.WT + (size_t)(d.nrow0 + n) * d.K + d.k0 + 8 * c) = o; }
        LDS_WAIT(); asm volatile("" ::: "memory"); return; }
#pragma unroll
    for (int j = 0; j < 4; ++j) { const int n = (lane >> 3) + 8 * j; const LAS float* s = scr + (8 * c) * 33 + n;
        v4u o; o.x = pk2(s[0 * 33] * g0[0], s[1 * 33] * g0[1]); o.y = pk2(s[2 * 33] * g0[2], s[3 * 33] * g0[3]); o.z = pk2(s[4 * 33] * g1[0], s[5 * 33] * g1[1]); o.w = pk2(s[6 * 33] * g1[2], s[7 * 33] * g1[3]);
        *(GAS v4u*)(d.WT + (size_t)(d.nrow0 + n) * d.K + d.k0 + 8 * c) = o; }
    LDS_WAIT(); asm volatile("" ::: "memory");
}
__device__ __forceinline__ int cmap_in(int np) {
    const int tile = np >> 8, sl = np & 255, bj = sl >> 7, wc = (sl >> 5) & 3, rho = sl & 31;
    if (tile < 14) { const int seg = tile >> 1;
        if (seg == 2 || seg == 5) return (np & ~255) + pg8::perm16(sl);
        return (np & ~255) + 64 * wc + 32 * bj + pg8::perm32(rho); }
    if (tile == 14) { if (wc == 0) return 3584 + 32 * bj + pg8::perm32(rho); if (bj == 0 && wc == 1 && rho < 8) return 3648 + rho; return -1; }
    return 3656 + (tile - 15) * 256 + pg8::perm16(sl);
}
__device__ const double INV_FREQ[32] = {1.0, 0.7498942093324559, 0.5623413251903491, 0.4216965034285822, 0.31622776601683794, 0.23713737056616552, 0.1778279410038923, 0.1333521432163324, 0.09999999999999999, 0.07498942093324558, 0.056234132519034905, 0.042169650342858224, 0.03162277660168379, 0.023713737056616554, 0.01778279410038923, 0.013335214321633239, 0.01, 0.007498942093324559, 0.005623413251903491, 0.004216965034285822, 0.0031622776601683794, 0.002371373705661655, 0.0017782794100389228, 0.0013335214321633238, 0.001, 0.0007498942093324559, 0.000562341325190349, 0.00042169650342858224, 0.00031622776601683794, 0.00023713737056616554, 0.0001778279410038923, 0.0001333521432163324};
__device__ __forceinline__ void sincos_d(double a, float& c, float& s) {
    const double TWO_OVER_PI = 0.63661977236758134308, PIO2_HI = 1.57079632679489655800e+00, PIO2_LO = 6.12323399573676603587e-17;
    const double kf = __builtin_rint(a * TWO_OVER_PI); const long k = (long)kf;
    const double y = (a - kf * PIO2_HI) - kf * PIO2_LO, y2 = y * y;
    const double sp = y * (1.0 + y2 * (-1.0 / 6 + y2 * (1.0 / 120 + y2 * (-1.0 / 5040 + y2 * (1.0 / 362880 + y2 * (-1.0 / 39916800 + y2 * (1.0 / 6227020800.0)))))));
    const double cp = 1.0 + y2 * (-0.5 + y2 * (1.0 / 24 + y2 * (-1.0 / 720 + y2 * (1.0 / 40320 + y2 * (-1.0 / 3628800 + y2 * (1.0 / 479001600.0 + y2 * (-1.0 / 87178291200.0)))))));
    double sv, cv; switch (k & 3) { case 0: sv = sp; cv = cp; break; case 1: sv = cp; cv = -sp; break; case 2: sv = -sp; cv = -cp; break; default: sv = -cp; cv = sp; break; }
    c = (float)cv; s = (float)sv;
}

__device__ __forceinline__ void p0_prologue(Frame& F) {
    unsigned char* ws = F.ws;
    LAS float* scr = (LAS float*)(F.lds + F.wave * 16384);
    const int gw = F.vcu * NWAVES + F.wave, NGW = F.G * NWAVES, lane = F.lane;
    bf16* WinT = (bf16*)(ws + WS_WIN); bf16* WaT = (bf16*)(ws + WS_WA); bf16* WbT = (bf16*)(ws + WS_WB); bf16* WoutT = (bf16*)(ws + WS_WOUT);
    bf16* W13T = (bf16*)(ws + WS_W13); bf16* W2T = (bf16*)(ws + WS_W2);
    constexpr int I_INA = 16 * (NINA / 32), I_INB = 16 * (NINB / 32), I_IN = I_INA + I_INB, I_PA = 8 * 32, I_OUT = 16 * 32, I_13 = 16 * 32 * NEXP, I_2 = 8 * 32 * NEXP;
    constexpr int NITEMS = I_IN + 2 * I_PA + I_OUT;
    (void)I_13; (void)I_2; (void)W13T; (void)W2T;
    auto decode = [&](int it) -> P0Item { P0Item d; d.mulz = 1.0f; d.kscale = nullptr; d.f8scale = 0.f; int r = it;
        if (r < I_IN) { const int part = r >= I_INA ? 1 : 0; if (part) r -= I_INA; const int ng = (part ? NINB : NINA) / 32, nb = r % ng, kb = r / ng;
            const int col = cmap_in(pg8::in_tile_of(part, nb >> 3) * 256 + (nb & 7) * 32 + (lane & 31));
            d.sp = F.w_in + (col >= 0 ? col : 0); d.mulz = col >= 0 ? 1.0f : 0.0f; d.sstride = IN_COLS; d.kscale = F.g_mix; d.K = DMODEL; d.nrow0 = nb * 32; d.k0 = kb * 64;
            if (part) { d.WT = (bf16*)(ws + WS_WIN8); d.f8scale = 32.0f; } else d.WT = WinT; return d; } r -= I_IN;
        if (r < 2 * I_PA) { const bool second = r >= I_PA; if (second) r -= I_PA; const int nb = r % 32, kb = r / 32; const int col = (nb >> 3) * 256 + pg8::perm16((nb & 7) * 32 + (lane & 31));
            d.sp = (second ? F.w_pb : F.w_pa) + col; d.sstride = DMODEL; d.WT = second ? WbT : WaT; d.K = HW; d.f8scale = 16.0f; d.nrow0 = nb * 32; d.k0 = kb * 64; return d; } r -= 2 * I_PA;
        if (r < I_OUT) { const int nb = r % 32, kb = r / 32; d.sp = F.w_out + (nb >> 3) * 256 + pg8::perm16((nb & 7) * 32 + (lane & 31)); d.sstride = DMODEL; d.WT = WoutT; d.K = DMODEL; d.f8scale = 32.0f; d.nrow0 = nb * 32; d.k0 = kb * 64; return d; } r -= I_OUT;
        return d; };
    if (gw < NITEMS) { P0Item dA = decode(gw), dB = dA; float vA[32], vB[32]; f32x4 gA0, gA1, gB0, gB1; p0_load(dA, lane, vA, gA0, gA1);
        for (int it = gw;;) {
            const int itB = it + NGW; const bool hasB = itB < NITEMS; if (hasB) { dB = decode(itB); p0_load(dB, lane, vB, gB0, gB1); }
            p0_finish(dA, lane, vA, scr, gA0, gA1); if (!hasB) break;
            const int itA = itB + NGW; const bool hasA = itA < NITEMS; if (hasA) { dA = decode(itA); p0_load(dA, lane, vA, gA0, gA1); }
            p0_finish(dB, lane, vB, scr, gB0, gB1); if (!hasA) break;
            it = itA; } }
    { bf16* Wh = (bf16*)(ws + WS_WR); bf16* Wl = Wh + 48 * DMODEL;
      for (int i = (F.vcu * NWAVES * 64) + F.tid; i < 48 * DMODEL; i += F.G * NWAVES * 64) { const int n = i / DMODEL, k = i % DMODEL;
          float w = 0.f; if (n < 4) w = F.w_group[k * 4 + n]; else if (n < 36) w = F.w_expert[k * 32 + (n - 4)]; w *= F.g_ffn[k];
          const unsigned h = f2bf(w); const float lo = w - bf2f(h); Wh[i] = (bf16)h; Wl[i] = (bf16)f2bf(lo);
          ((unsigned char*)(ws + WS_WR8))[i] = (unsigned char)(pg8::cvt4_fp8(lo * 16384.0f, 0.f, 0.f, 0.f) & 0xffu); } }
    { bf16* XB = (bf16*)(ws + WS_XB); float* irstd1 = (float*)(ws + WS_RSTD1);
#define P0X_LOAD(V, M0) do { _Pragma("unroll") for (int r = 0; r < 4; ++r) { const GAS f32x4* xr = (const GAS f32x4*)(F.x + (size_t)((M0) + r) * DMODEL) + lane; \
          _Pragma("unroll") for (int j = 0; j < 4; ++j) V[r][j] = xr[64 * j]; } } while (0)
#define P0X_DONE(V, M0) do { _Pragma("unroll") for (int r = 0; r < 4; ++r) { float s = 0.f; \
          _Pragma("unroll") for (int j = 0; j < 4; ++j) s += (V[r][j].x * V[r][j].x + V[r][j].y * V[r][j].y) + (V[r][j].z * V[r][j].z + V[r][j].w * V[r][j].w); \
          s = wave_sum(s); const float irs = sqrtf(s * (1.0f / DMODEL) + RMS_EPS), rs = 1.0f / irs; if (lane == 0) irstd1[(M0) + r] = irs; \
          GAS unsigned long long* o8 = (GAS unsigned long long*)(XB + (size_t)((M0) + r) * DMODEL) + lane; GAS unsigned* q8 = (GAS unsigned*)(ws + WS_X8 + (size_t)((M0) + r) * DMODEL) + lane; \
          _Pragma("unroll") for (int j = 0; j < 4; ++j) { const f32x4 w = V[r][j] * rs; \
              o8[64 * j] = (unsigned long long)pk2(w.x, w.y) | ((unsigned long long)pk2(w.z, w.w) << 32); q8[64 * j] = pg8::cvt4_fp8(w.x, w.y, w.z, w.w); } } } while (0)
      const int mstep = NGW * 4; int m0 = gw * 4;
      if (m0 < T) { f32x4 va[4][4], vb[4][4]; P0X_LOAD(va, m0);
          for (;;) {
              const int m1 = m0 + mstep; const bool h1 = m1 < T; if (h1) P0X_LOAD(vb, m1);
              P0X_DONE(va, m0); if (!h1) break;
              const int m2 = m1 + mstep; const bool h2 = m2 < T; if (h2) P0X_LOAD(va, m2);
              P0X_DONE(vb, m1); if (!h2) break;
              m0 = m2; } }
#undef P0X_LOAD
#undef P0X_DONE
    }
}

__device__ __forceinline__ void p2_kbsum(Frame& F) {
    const bf16* KA = (const bf16*)(F.ws + WS_KA); float* kbsum = (float*)(F.ws + WS_KBSUM);
    const int gw = F.vcu * NWAVES + F.wave, NGW = F.G * NWAVES, lane = F.lane;
    for (int it = gw; it < NBATCH * NHEAD * 8; it += NGW) { const int j = it & 7, h = (it >> 3) & 7, b = it >> 6;
        const bf16* base = KA + ((size_t)(b * SEQ + j * 256 + (lane >> 3))) * HW + h * 64 + (lane & 7) * 8; float s[8];
#pragma unroll
        for (int k = 0; k < 8; ++k) s[k] = 0.f;
#pragma unroll 4
        for (int i = 0; i < 32; ++i) { const v4u w = *(const GAS v4u*)(base + (size_t)i * 8 * HW);
#pragma unroll
            for (int k = 0; k < 4; ++k) { s[2 * k] += bf2f(w[k] & 0xffffu); s[2 * k + 1] += __uint_as_float(w[k] & 0xffff0000u); } }
#pragma unroll
        for (int k = 0; k < 8; ++k) { s[k] += __shfl_xor(s[k], 8); s[k] += __shfl_xor(s[k], 16); s[k] += __shfl_xor(s[k], 32); }
        if (lane < 8) { float* o = kbsum + (size_t)it * 64 + lane * 8; *(f32x4*)o = (f32x4){s[0], s[1], s[2], s[3]}; *(f32x4*)(o + 4) = (f32x4){s[4], s[5], s[6], s[7]}; } }
}

__device__ __forceinline__ int wsum6(int c) { int tot = 0;
#pragma unroll
    for (int b = 0; b < 6; ++b) tot += __popcll(__ballot((c >> b) & 1)) << b;
    return tot; }
__device__ __forceinline__ int sel_cnt_ge(const unsigned (&key)[32], int nq, unsigned cand) { int c = 0;
    const unsigned cs = (unsigned)__builtin_amdgcn_readfirstlane((int)cand);
#pragma unroll
    for (int q = 0; q < 8; ++q) { if (q < nq) { unsigned long long m0, m1, m2, m3;
        asm volatile("v_cmp_le_u32_e64 %0, %4, %5\n\tv_cmp_le_u32_e64 %1, %4, %6\n\tv_cmp_le_u32_e64 %2, %4, %7\n\tv_cmp_le_u32_e64 %3, %4, %8"
                     : "=&s"(m0), "=&s"(m1), "=&s"(m2), "=&s"(m3) : "s"(cs), "v"(key[4 * q]), "v"(key[4 * q + 1]), "v"(key[4 * q + 2]), "v"(key[4 * q + 3]));
        c += (__popcll(m0) + __popcll(m1)) + (__popcll(m2) + __popcll(m3)); } }
    return c; }
#define SEL_CMP4(q) asm volatile("v_cmp_le_u32_e64 %0, %4, %5\n\tv_cmp_le_u32_e64 %1, %4, %6\n\tv_cmp_le_u32_e64 %2, %4, %7\n\tv_cmp_le_u32_e64 %3, %4, %8" \
        : "=&s"(m[q][0]), "=&s"(m[q][1]), "=&s"(m[q][2]), "=&s"(m[q][3]) : "s"(cs), "v"(key[4 * (q)]), "v"(key[4 * (q) + 1]), "v"(key[4 * (q) + 2]), "v"(key[4 * (q) + 3]))
template <int NQ> __device__ __forceinline__ int sel_cnt_ge_t(const unsigned (&key)[32], unsigned cand) {
    const unsigned cs = (unsigned)__builtin_amdgcn_readfirstlane((int)cand); unsigned long long m[NQ][4]; int c = 0;
    SEL_CMP4(0);
#pragma unroll
    for (int q = 0; q < NQ; ++q) { if (q + 1 < NQ) SEL_CMP4(q + 1); c += (__popcll(m[q][0]) + __popcll(m[q][1])) + (__popcll(m[q][2]) + __popcll(m[q][3])); }
    return c; }
template <int NQ> __device__ __forceinline__ void sel_bisect_full(const unsigned (&key)[32], const unsigned M, unsigned& lo, unsigned& hi, int& clo, int& chi, bool& exact) {
    { const unsigned lo0 = (M > (4u << 23)) ? M - (4u << 23) : 0u;
      if (lo0 > 0u) { const int c0 = sel_cnt_ge_t<NQ>(key, lo0); if (c0 >= 256) { lo = lo0; clo = c0; exact = (c0 == 256); } else { hi = lo0; chi = c0; } } }
#pragma unroll 1
    while (!exact && hi - lo > 1u && clo - chi > 64) { const unsigned mid = lo + ((hi - lo) >> 1);
        const int tot = sel_cnt_ge_t<NQ>(key, mid);
        if (tot >= 256) { lo = mid; clo = tot; exact = (tot == 256); } else { hi = mid; chi = tot; } }
}
__device__ __forceinline__ int sel_cnt_eq_lt(const unsigned (&key)[32], int nq, unsigned val, int cx, int lane) { int c = 0;
#pragma unroll
    for (int q = 0; q < 8; ++q) { if (q < nq) {
#pragma unroll
        for (int k = 0; k < 4; ++k) c += __popcll(__ballot(key[4 * q + k] == val && (64 * (4 * q + k) + lane) < cx)); } }
    return c; }
__device__ __forceinline__ unsigned wave_max_u32(unsigned v) {
    int x = (int)v;
    { const int t = __builtin_amdgcn_update_dpp(x, x, 0xB1, 0xF, 0xF, false); x = (int)max((unsigned)x, (unsigned)t); }
    { const int t = __builtin_amdgcn_update_dpp(x, x, 0x4E, 0xF, 0xF, false); x = (int)max((unsigned)x, (unsigned)t); }
    { const int t = __builtin_amdgcn_update_dpp(x, x, 0x141, 0xF, 0xF, false); x = (int)max((unsigned)x, (unsigned)t); }
    { const int t = __builtin_amdgcn_update_dpp(x, x, 0x140, 0xF, 0xF, false); x = (int)max((unsigned)x, (unsigned)t); }
    const unsigned a = (unsigned)__builtin_amdgcn_readlane(x, 0), b = (unsigned)__builtin_amdgcn_readlane(x, 16), c = (unsigned)__builtin_amdgcn_readlane(x, 32), d = (unsigned)__builtin_amdgcn_readlane(x, 48);
    return max(max(a, b), max(c, d));
}
struct SelStep { int b, g, half; };
__device__ __forceinline__ void sel_load_q(Frame& F, const SelStep st, bf16x8 (&bq)[8][2], float (&w8)[8]) {
    const bf16* QI = (const bf16*)(F.ws + WS_QI); const float* WI = (const float*)(F.ws + WS_WI);
    const int qidx = F.lane & 15, kc = F.lane >> 4; const size_t qrow = (size_t)(st.b * SEQ + st.g * 32 + st.half * 16 + qidx);
#pragma unroll
    for (int h = 0; h < 8; ++h) {
#pragma unroll
        for (int ks = 0; ks < 2; ++ks) bq[h][ks] = *(const GAS bf16x8*)(QI + qrow * HW + h * 64 + ks * 32 + kc * 8); }
    const f32x4 a = *(const GAS f32x4*)(WI + qrow * 8), c = *(const GAS f32x4*)(WI + qrow * 8 + 4); w8[0] = a[0]; w8[1] = a[1]; w8[2] = a[2]; w8[3] = a[3]; w8[4] = c[0]; w8[5] = c[1]; w8[6] = c[2]; w8[7] = c[3];
}
__device__ __forceinline__ void sel_scores(Frame& F, const SelStep st, const bf16x8 (&bq)[8][2], const float (&w8)[8]) {
    const bf16* KI = (const bf16*)(F.ws + WS_KI); LAS float* sc = (LAS float*)F.lds;
    const int lane = F.lane, wave = F.wave, qidx = lane & 15, kc = lane >> 4, b = st.b;
    const int ntg = __builtin_amdgcn_readfirstlane((st.g + 2) >> 1), nsub = ntg * 4;
    const int nit = (nsub + 7) >> 3, ngrp = (nit + 3) >> 2;
    bf16x8 A0[4], A1[4], B0[4], B1[4];
#define SEL_LOADG(X0, X1, gi) do { _Pragma("unroll") for (int u = 0; u < 4; ++u) { int st_ = wave + 8 * (4 * (gi) + u); st_ = st_ < nsub ? st_ : nsub - 1; \
        const bf16* kp_ = KI + (size_t)(b * SEQ + st_ * 16 + qidx) * 64 + kc * 8; X0[u] = *(const GAS bf16x8*)kp_; X1[u] = *(const GAS bf16x8*)(kp_ + 32); } } while (0)
#define SEL_COMPG(X0, X1, gi) do { _Pragma("unroll") for (int u = 0; u < 4; ++u) { const int st_ = wave + 8 * (4 * (gi) + u); if (st_ < nsub) { f32x4 s_ = {0.f, 0.f, 0.f, 0.f}; \
        _Pragma("unroll") for (int h = 0; h < 8; ++h) { f32x4 d_ = __builtin_amdgcn_mfma_f32_16x16x32_bf16(X0[u], bq[h][0], (f32x4){0.f, 0.f, 0.f, 0.f}, 0, 0, 0); \
            d_ = __builtin_amdgcn_mfma_f32_16x16x32_bf16(X1[u], bq[h][1], d_, 0, 0, 0); \
            _Pragma("unroll") for (int k = 0; k < 4; ++k) s_[k] += w8[h] * __int_as_float(max(__float_as_int(d_[k]), 0)); }   \
        *(LAS f32x4*)(sc + qidx * SC_STRIDE + st_ * 16 + 4 * kc) = s_; } } } while (0)
    SEL_LOADG(A0, A1, 0);
    for (int gi = 0; gi < ngrp; gi += 2) {
        if (gi + 1 < ngrp) SEL_LOADG(B0, B1, gi + 1);
        SEL_COMPG(A0, A1, gi);
        if (gi + 1 < ngrp) { if (gi + 2 < ngrp) SEL_LOADG(A0, A1, gi + 2); SEL_COMPG(B0, B1, gi + 1); }
    }
#undef SEL_LOADG
#undef SEL_COMPG
}
__device__ __forceinline__ void sel_rows(Frame& F, const SelStep st) {
    unsigned long long* maskw = (unsigned long long*)(F.ws + WS_MASK); LAS float* sc = (LAS float*)F.lds;
    const int lane = F.lane, wave = F.wave, b = st.b;
    const int ntg = __builtin_amdgcn_readfirstlane((st.g + 2) >> 1), nq = (ntg + 3) >> 2; const int qh = st.g * 32 + st.half * 16;
    LAS int* rowctr = (LAS int*)(F.lds + MISC_OFF + 3072);
    for (;;) { int row_ = 0; if (lane == 0) row_ = __hip_atomic_fetch_add(rowctr, 1, __ATOMIC_RELAXED, __HIP_MEMORY_SCOPE_WORKGROUP);
        const int row = __builtin_amdgcn_readfirstlane(row_); if (row >= 16) break;
        const int t = __builtin_amdgcn_readfirstlane(qh + row);
        unsigned key[32]; unsigned mx = 0u;
#pragma unroll
        for (int q = 0; q < 8; ++q) {
#pragma unroll
            for (int k = 0; k < 4; ++k) key[4 * q + k] = 0u;
            if (q < nq) {
#pragma unroll
                for (int k = 0; k < 4; ++k) { const int j = 4 * q + k; const float v = sc[row * SC_STRIDE + 64 * j + lane]; const unsigned u = __float_as_uint(v);
                    const unsigned kk = (u & 0x80000000u) ? ~u : (u | 0x80000000u); key[j] = (64 * j + lane <= t) ? kk : 0u; mx = max(mx, key[j]); } } }
        const unsigned M = wave_max_u32(mx);
        unsigned lo = 0u, hi = M + 1u; int clo = 1 << 20, chi = 0; bool exact = false;
        switch (nq) { case 2: sel_bisect_full<2>(key, M, lo, hi, clo, chi, exact); break; case 3: sel_bisect_full<3>(key, M, lo, hi, clo, chi, exact); break;
            case 4: sel_bisect_full<4>(key, M, lo, hi, clo, chi, exact); break; case 5: sel_bisect_full<5>(key, M, lo, hi, clo, chi, exact); break;
            case 6: sel_bisect_full<6>(key, M, lo, hi, clo, chi, exact); break; case 7: sel_bisect_full<7>(key, M, lo, hi, clo, chi, exact); break;
            default: sel_bisect_full<8>(key, M, lo, hi, clo, chi, exact); break; }
        if (!exact && hi - lo > 1u) {
            LAS unsigned* cb = (LAS unsigned*)(sc + row * SC_STRIDE); int base = 0; const unsigned wdt = hi - lo;
#pragma unroll
            for (int q = 0; q < 8; ++q) { if (q < nq) {
#pragma unroll
                for (int k = 0; k < 4; ++k) { const int j = 4 * q + k; const bool inb = (key[j] - lo) < wdt; const unsigned long long m = __ballot(inb);
                    const int pos = base + (int)__builtin_amdgcn_mbcnt_hi((unsigned)(m >> 32), __builtin_amdgcn_mbcnt_lo((unsigned)m, 0u));
                    cb[inb ? pos : 64 + lane] = key[j]; base += __popcll(m); } } }
            LDS_WAIT(); asm volatile("" ::: "memory");
            unsigned cand = cb[lane]; LDS_WAIT(); cand = (lane < base) ? cand : 0u;
#pragma unroll 1
            while (!exact && hi - lo > 1u) { const unsigned mid = lo + ((hi - lo) >> 1);
                const int tot = chi + __popcll(__ballot(cand >= mid));
                if (tot >= 256) { lo = mid; exact = (tot == 256); } else hi = mid; } }
        unsigned P; int xcut;
        if (exact) { P = lo - 1u; xcut = -1; }
        else {
            const int need = 256 - sel_cnt_ge(key, nq, lo + 1u); int xx = 0;
#pragma unroll 1
            for (int bit = 10; bit >= 0; --bit) { const int cx = xx | (1 << bit);
                if (sel_cnt_eq_lt(key, nq, lo, cx, lane) < need) xx = cx; }
            P = lo; xcut = xx; }
        int mlo = 0, mhi = 0;
        if (exact) {
            const unsigned cs = (unsigned)__builtin_amdgcn_readfirstlane((int)lo); unsigned long long m[8][4];
#define SEL_WL(q, k) do { const int a_ = (int)(unsigned)m[q][k], b_ = (int)(unsigned)(m[q][k] >> 32); \
                asm volatile("v_writelane_b32 %0, %1, %2" : "+v"(mlo) : "s"(a_), "n"(4 * (q) + (k))); asm volatile("v_writelane_b32 %0, %1, %2" : "+v"(mhi) : "s"(b_), "n"(4 * (q) + (k))); } while (0)
#define SEL_EX4(q) do { if ((q) < nq) { SEL_CMP4(q); SEL_WL(q, 0); SEL_WL(q, 1); SEL_WL(q, 2); SEL_WL(q, 3); } } while (0)
            SEL_EX4(0); SEL_EX4(1); SEL_EX4(2); SEL_EX4(3); SEL_EX4(4); SEL_EX4(5); SEL_EX4(6); SEL_EX4(7);
#undef SEL_EX4
#undef SEL_WL
        } else {
#define SEL_EMIT(j) do { const bool al = (key[j] > P) || (key[j] == P && (64 * (j) + lane) <= xcut); \
            const unsigned long long m = __ballot(al); const int m0_ = (int)(unsigned)m, m1_ = (int)(unsigned)(m >> 32); \
            asm volatile("v_writelane_b32 %0, %1, %2" : "+v"(mlo) : "s"(m0_), "n"(j)); asm volatile("v_writelane_b32 %0, %1, %2" : "+v"(mhi) : "s"(m1_), "n"(j)); } while (0)
#define SEL_EMIT4(q) do { if ((q) < nq) { SEL_EMIT(4 * (q)); SEL_EMIT(4 * (q) + 1); SEL_EMIT(4 * (q) + 2); SEL_EMIT(4 * (q) + 3); } } while (0)
        SEL_EMIT4(0); SEL_EMIT4(1); SEL_EMIT4(2); SEL_EMIT4(3); SEL_EMIT4(4); SEL_EMIT4(5); SEL_EMIT4(6); SEL_EMIT4(7);
#undef SEL_EMIT4
#undef SEL_EMIT
        }
        if (lane < 32) maskw[(size_t)(b * SEQ + t) * 32 + lane] = ((unsigned long long)(unsigned)mhi << 32) | (unsigned long long)(unsigned)mlo;
    }
}
constexpr int MW_I13 = 16 * 32 * NEXP, MW_I2 = 8 * 32 * NEXP, MW_ITEMS = MW_I13 + MW_I2;
struct MwItem { const float* sp; unsigned sstride; unsigned char* wt; const float* ks; float f8; };
__device__ __forceinline__ MwItem mw_decode(Frame& F, int it, int lane) { MwItem d; asm volatile("" : "+v"(lane));
    const int h = lane >> 5;
    if (it < MW_I13) { const int e = it / 512, r = it % 512, nb = r % 32, kb = r / 32;
        d.sp = (((nb >> 2) & 1) ? F.w3 : F.w1) + (size_t)e * DMODEL * EFF + 128 * (nb >> 3) + 32 * (nb & 3) + pg8::perm32(lane & 31) + (size_t)(kb * 64 + 32 * h) * EFF; d.sstride = EFF;
        d.wt = F.ws + WS_W13 + (size_t)e * 1024 * DMODEL + (size_t)(nb * 32 + (lane & 31)) * DMODEL + kb * 64 + 32 * h; d.ks = F.g_ffn + kb * 64; d.f8 = 32.0f; }
    else { const int r0 = it - MW_I13, e = r0 / 256, r = r0 % 256, nb = r % 32, kb = r / 32; const int col = (nb >> 3) * 256 + pg8::perm16((nb & 7) * 32 + (lane & 31));
        d.sp = F.w2 + (size_t)e * EFF * DMODEL + col + (size_t)(kb * 64 + 32 * h) * DMODEL; d.sstride = DMODEL;
        d.wt = F.ws + WS_W2 + (size_t)e * DMODEL * EFF + (size_t)(nb * 32 + (lane & 31)) * EFF + kb * 64 + 32 * h; d.ks = nullptr; d.f8 = 16.0f; }
    return d; }
__device__ __forceinline__ void mw_load(const MwItem& d, int lane, float (&v)[32], float& gv) {
#pragma unroll
    for (int i = 0; i < 32; ++i) v[i] = d.sp[(size_t)i * d.sstride];
    gv = d.ks ? d.ks[lane] : 1.0f; }
__device__ __forceinline__ void mw_finish(const MwItem& d, int lane, const float (&v)[32], float gv) {
    asm volatile("" : "+v"(lane)); const int src = (lane & 32); gv *= d.f8; unsigned w[8];
#pragma unroll
    for (int c = 0; c < 8; ++c) { float t[4];
#pragma unroll
        for (int k = 0; k < 4; ++k) t[k] = v[4 * c + k] * __shfl(gv, src + 4 * c + k);
        w[c] = pg8::cvt4_fp8(t[0], t[1], t[2], t[3]); }
    v4u o0, o1; o0.x = w[0]; o0.y = w[1]; o0.z = w[2]; o0.w = w[3]; o1.x = w[4]; o1.y = w[5]; o1.z = w[6]; o1.w = w[7];
    *(GAS v4u*)d.wt = o0; *(GAS v4u*)(d.wt + 16) = o1; }
__device__ __forceinline__ void p2_select(Frame& F) {
    const int nitems = (F.G == 256) ? 7 : ((NBATCH * 56 - F.vcu + F.G - 1) / F.G), nsteps = 2 * nitems;
    auto decode = [&](int s) -> SelStep { SelStep st; const int r = s >> 1; st.half = s & 1;
        if (F.G == 256) { st.b = F.vcu >> 3; const int c = F.vcu & 7; st.g = 8 + 8 * r + ((r & 1) ? 7 - c : c); }
        else { const int I = F.vcu + r * F.G; st.b = I / 56; st.g = 8 + I % 56; }
        return st; };
    if (nsteps <= 0) return;
    const int gw = F.vcu * NWAVES + F.wave, NGW = F.G * NWAVES;
    for (int s = 0; s < nsteps; ++s) {
        { int l_ = F.lane; asm volatile("" : "+v"(l_)); F.lane = l_; }
        const SelStep st = decode(s); bf16x8 qA[8][2]; float wA[8];
        const int mit = gw + NGW * s; const bool mw = mit < MW_ITEMS; float mv[32], mg = 1.0f;
        if (F.tid == 0) *(LAS int*)(F.lds + MISC_OFF + 3072) = 0;
        sel_load_q(F, st, qA, wA); sel_scores(F, st, qA, wA); __syncthreads();
        if (mw) { const MwItem md = mw_decode(F, mit, F.lane); mw_load(md, F.lane, mv, mg); }
        sel_rows(F, st);
        if (mw) { const MwItem md = mw_decode(F, mit, F.lane); mw_finish(md, F.lane, mv, mg); }
        __syncthreads(); }
    for (int mit = gw + NGW * nsteps; mit < MW_ITEMS; mit += NGW) { float mv[32], mg; const MwItem md = mw_decode(F, mit, F.lane); mw_load(md, F.lane, mv, mg); mw_finish(md, F.lane, mv, mg); }
}

__device__ __forceinline__ void p6_router(Frame& F, bool dummy) {
    const bf16* XH = (const bf16*)(F.ws + WS_X1H); const unsigned char* XL = (const unsigned char*)(F.ws + WS_X1L); float* rstd2 = (float*)(F.ws + WS_RSTD2);
    const bf16* Wh = (const bf16*)(F.ws + WS_WR); const bf16* Wl = Wh + 48 * DMODEL;
    int* tokl = (int*)(F.ws + WS_TOK); float* gate = (float*)(F.ws + WS_GATE); unsigned* gcnt = (unsigned*)(F.ws + WS_CTL) + CW_CNT + (dummy ? 32 : 0);
    LAS float* lg = (LAS float*)F.lds + F.wave * (16 * 48);
    LAS int* hist = (LAS int*)(F.lds + 32768); LAS int* base = hist + 32;
    LAS int* aE = (LAS int*)(F.lds + 36864); LAS int* aP = aE + 512; LAS float* aG = (LAS float*)(aP + 512); LAS float* aR = aG + 512;
    float* rsort = (float*)(F.ws + WS_RSORT); float* gsort = (float*)(F.ws + WS_GSORT);
    const int lane = F.lane, wave = F.wave, tk = lane & 15, kc = lane >> 4;
    constexpr int WLDS_OFF = 49152, WLDS_STRIDE = 2080;
    { LAS char* wl_ = (LAS char*)(F.lds + WLDS_OFF);
      for (int i = F.tid; i < 37 * 128; i += NWAVES * 64) { const int row = i >> 7, ch = i & 127; v4u v = {0u, 0u, 0u, 0u};
          if (row < 36) v = *(const GAS v4u*)((const GAS char*)Wh + (size_t)(row * 2048 + ch * 16));
          *(LAS v4u*)(wl_ + row * WLDS_STRIDE + ch * 16) = v; } }
    for (int st = F.vcu; st < T / 256; st += F.G) {
        if (F.tid < 32) hist[F.tid] = 0;
        __syncthreads();
        const int rbase = st * 256 + wave * 32;
        f32x4 acc[2][3], accs[2];
#pragma unroll
        for (int tt = 0; tt < 2; ++tt) { accs[tt] = (f32x4){0.f, 0.f, 0.f, 0.f};
#pragma unroll
            for (int nt = 0; nt < 3; ++nt) acc[tt][nt] = (f32x4){0.f, 0.f, 0.f, 0.f}; }
        unsigned w8o[3], xof[2], lof[2]; const unsigned char* W8 = (const unsigned char*)(F.ws + WS_WR8);
#pragma unroll
        for (int nt = 0; nt < 3; ++nt) { w8o[nt] = (unsigned)((nt * 16 + tk) * DMODEL + kc * 8); asm volatile("" : "+v"(w8o[nt])); }
#pragma unroll
        for (int tt = 0; tt < 2; ++tt) { lof[tt] = (unsigned)((rbase + tt * 16 + tk) * DMODEL + kc * 8); xof[tt] = lof[tt] * 2u; asm volatile("" : "+v"(xof[tt])); asm volatile("" : "+v"(lof[tt])); }
        bf16x8 whA[3]; v2u w80[3], w81[3], w82[3], w83[3], w84[3], w85[3], w86[3], w87[3]; bf16x8 xh0[2], xh1[2], xh2[2], xh3[2], xh4[2], xh5[2], xh6[2], xh7[2]; v2u xl0[2], xl1[2], xl2[2], xl3[2], xl4[2], xl5[2], xl6[2], xl7[2];
#define P6_LOADW(WH, kk) do { _Pragma("unroll") for (int nt = 0; nt < 3; ++nt) WH[nt] = *(const LAS bf16x8*)(F.lds + (WLDS_OFF + ((nt * 16 + tk) < 36 ? (nt * 16 + tk) : 36) * WLDS_STRIDE + kc * 16) + (kk) * 64); } while (0)
#define P6_LOADWL(W8r, kk) do { _Pragma("unroll") for (int nt = 0; nt < 3; ++nt) W8r[nt] = *(const GAS v2u*)((const GAS char*)W8 + (size_t)(w8o[nt] + (unsigned)((kk) * 32))); } while (0)
#define P6_LOADX(XHr, XLr, kk) do { _Pragma("unroll") for (int tt = 0; tt < 2; ++tt) { \
            XHr[tt] = *(const GAS bf16x8*)((const GAS char*)XH + (size_t)(xof[tt] + (unsigned)((kk) * 64))); XLr[tt] = *(const GAS v2u*)((const GAS char*)XL + (size_t)(lof[tt] + (unsigned)((kk) * 32))); } } while (0)
#define P6_COMP(WH, W8r, XHr, XLr, kk) do { bf16x8 WL[3]; \
        _Pragma("unroll") for (int nt = 0; nt < 3; ++nt) { typedef float v2f_ __attribute__((ext_vector_type(2))); const v2u l8 = W8r[nt]; v4u lw_; \
            const v2f_ a0 = __builtin_amdgcn_cvt_pk_f32_fp8((int)l8.x, false), a1 = __builtin_amdgcn_cvt_pk_f32_fp8((int)l8.x, true), c0 = __builtin_amdgcn_cvt_pk_f32_fp8((int)l8.y, false), c1 = __builtin_amdgcn_cvt_pk_f32_fp8((int)l8.y, true); \
            lw_.x = pg8::cvt_pk_bf16(a0.x * (1.0f / 16384.0f), a0.y * (1.0f / 16384.0f)); lw_.y = pg8::cvt_pk_bf16(a1.x * (1.0f / 16384.0f), a1.y * (1.0f / 16384.0f)); \
            lw_.z = pg8::cvt_pk_bf16(c0.x * (1.0f / 16384.0f), c0.y * (1.0f / 16384.0f)); lw_.w = pg8::cvt_pk_bf16(c1.x * (1.0f / 16384.0f), c1.y * (1.0f / 16384.0f)); WL[nt] = __builtin_bit_cast(bf16x8, lw_); } \
        _Pragma("unroll") for (int tt = 0; tt < 2; ++tt) { const bf16x8 xh = XHr[tt]; bf16x8 xl; \
            { typedef float v2f_ __attribute__((ext_vector_type(2))); const v2u l8 = XLr[tt]; v4u lw_; \
              const v2f_ a0 = __builtin_amdgcn_cvt_pk_f32_fp8((int)l8.x, false), a1 = __builtin_amdgcn_cvt_pk_f32_fp8((int)l8.x, true), c0 = __builtin_amdgcn_cvt_pk_f32_fp8((int)l8.y, false), c1 = __builtin_amdgcn_cvt_pk_f32_fp8((int)l8.y, true); \
              lw_.x = pg8::cvt_pk_bf16(a0.x * (1.0f / 512.0f), a0.y * (1.0f / 512.0f)); lw_.y = pg8::cvt_pk_bf16(a1.x * (1.0f / 512.0f), a1.y * (1.0f / 512.0f)); \
              lw_.z = pg8::cvt_pk_bf16(c0.x * (1.0f / 512.0f), c0.y * (1.0f / 512.0f)); lw_.w = pg8::cvt_pk_bf16(c1.x * (1.0f / 512.0f), c1.y * (1.0f / 512.0f)); xl = __builtin_bit_cast(bf16x8, lw_); } \
            accs[tt] = __builtin_amdgcn_mfma_f32_16x16x32_bf16(xh, xh, accs[tt], 0, 0, 0); \
            _Pragma("unroll") for (int nt = 0; nt < 3; ++nt) { \
                acc[tt][nt] = __builtin_amdgcn_mfma_f32_16x16x32_bf16(WH[nt], xh, acc[tt][nt], 0, 0, 0); \
                acc[tt][nt] = __builtin_amdgcn_mfma_f32_16x16x32_bf16(WL[nt], xh, acc[tt][nt], 0, 0, 0); \
                acc[tt][nt] = __builtin_amdgcn_mfma_f32_16x16x32_bf16(WH[nt], xl, acc[tt][nt], 0, 0, 0); } } } while (0)
        P6_LOADWL(w80, 0); P6_LOADX(xh0, xl0, 0); P6_LOADWL(w81, 1); P6_LOADX(xh1, xl1, 1); P6_LOADWL(w82, 2); P6_LOADX(xh2, xl2, 2); P6_LOADWL(w83, 3); P6_LOADX(xh3, xl3, 3);
        P6_LOADWL(w84, 4); P6_LOADX(xh4, xl4, 4); P6_LOADWL(w85, 5); P6_LOADX(xh5, xl5, 5); P6_LOADWL(w86, 6); P6_LOADX(xh6, xl6, 6);
#define P6_SLOT(WHc, WHn, W8c, W8n, XHc, XLc, XHn, XLn, k) do { P6_LOADW(whA, k); if ((k) + 7 < 32) { P6_LOADWL(W8n, (k) + 7); P6_LOADX(XHn, XLn, (k) + 7); } P6_COMP(whA, W8c, XHc, XLc, k); } while (0)
#pragma unroll 1
        for (int kk = 0; kk < 32; kk += 8) {
            P6_SLOT(whA, whA, w80, w87, xh0, xl0, xh7, xl7, kk);     P6_SLOT(whA, whA, w81, w80, xh1, xl1, xh0, xl0, kk + 1);
            P6_SLOT(whA, whA, w82, w81, xh2, xl2, xh1, xl1, kk + 2); P6_SLOT(whA, whA, w83, w82, xh3, xl3, xh2, xl2, kk + 3);
            P6_SLOT(whA, whA, w84, w83, xh4, xl4, xh3, xl3, kk + 4); P6_SLOT(whA, whA, w85, w84, xh5, xl5, xh4, xl4, kk + 5);
            P6_SLOT(whA, whA, w86, w85, xh6, xl6, xh5, xl5, kk + 6); P6_SLOT(whA, whA, w87, w86, xh7, xl7, xh6, xl6, kk + 7);
        }
#undef P6_SLOT
#undef P6_LOADW
#undef P6_LOADWL
#undef P6_LOADX
#undef P6_COMP
        for (int tt = 0; tt < 2; ++tt) { const int r0 = rbase + tt * 16;
            const f32x4 dg = tt == 0 ? accs[0] : accs[1]; const int rsel = tk & 3;
            float sst = rsel == 0 ? dg[0] : rsel == 1 ? dg[1] : rsel == 2 ? dg[2] : dg[3]; sst = (kc == (tk >> 2)) ? sst : 0.f;
            sst += __shfl_xor(sst, 16); sst += __shfl_xor(sst, 32);
            const float rs = 1.0f / sqrtf(sst * (1.0f / DMODEL) + RMS_EPS);
#pragma unroll
            for (int nt = 0; nt < 3; ++nt)
#pragma unroll
                for (int k = 0; k < 4; ++k) lg[tk * 48 + nt * 16 + 4 * kc + k] = (tt == 0 ? acc[0][nt][k] : acc[1][nt][k]) * rs;
            LDS_WAIT(); asm volatile("" ::: "memory");
            if (lane < 16) { const int tokid = r0 + lane; rstd2[tokid] = rs; aR[wave * 32 + tt * 16 + lane] = rs;
                const LAS float* L = lg + lane * 48;
                float gl[4];
#pragma unroll
                for (int k = 0; k < 4; ++k) gl[k] = L[k] + F.b_group[k];
                int gs = 0; float gm = gl[0];
#pragma unroll
                for (int k = 1; k < 4; ++k) if (gl[k] > gm) { gm = gl[k]; gs = k; }
                float gz = 0.f;
#pragma unroll
                for (int k = 0; k < 4; ++k) gz += __expf(gl[k] - gm);
                const float gwt = 1.0f / gz;
                float el[8];
#pragma unroll
                for (int k = 0; k < 8; ++k) el[k] = L[4 + 8 * gs + k] + F.b_expert[8 * gs + k];
                int ia = 0; float ea = el[0];
#pragma unroll
                for (int k = 1; k < 8; ++k) if (el[k] > ea) { ea = el[k]; ia = k; }
                int ib = -1; float eb = -INFINITY;
#pragma unroll
                for (int k = 0; k < 8; ++k) if (k != ia && el[k] > eb) { eb = el[k]; ib = k; }
                const float pa = 1.0f, pb = __expf(eb - ea); const float inv = gwt / (pa + pb);
                const int e0 = 8 * gs + ia, e1 = 8 * gs + ib;
                const int l0 = __hip_atomic_fetch_add(hist + e0, 1, __ATOMIC_RELAXED, __HIP_MEMORY_SCOPE_WORKGROUP);
                const int l1 = __hip_atomic_fetch_add(hist + e1, 1, __ATOMIC_RELAXED, __HIP_MEMORY_SCOPE_WORKGROUP);
                const int ai = (wave * 32 + tt * 16 + lane) * 2;
                aE[ai] = e0; aP[ai] = l0; aG[ai] = pa * inv; aE[ai + 1] = e1; aP[ai + 1] = l1; aG[ai + 1] = pb * inv; }
            LDS_WAIT(); asm volatile("" ::: "memory");
        }
        __syncthreads();
        { int t32 = F.tid; asm volatile("" : "+v"(t32)); if (t32 < 32) base[t32] = (int)__hip_atomic_fetch_add(gcnt + t32, (unsigned)hist[t32], __ATOMIC_RELAXED, __HIP_MEMORY_SCOPE_AGENT); }
        __syncthreads();
        { int ai = F.tid; asm volatile("" : "+v"(ai));
          const int e = aE[ai]; const int pos = base[e] + aP[ai]; const int ts = (st * 256) * 2 + ai;
          tokl[(size_t)e * 65536 + pos] = ts; gate[ts] = aG[ai]; if (!dummy) { rsort[(size_t)e * 65536 + pos] = aR[ai >> 1]; gsort[(size_t)e * 65536 + pos] = aG[ai]; } }
        __syncthreads();
    }
}

__device__ __forceinline__ void p9_final(Frame& F, bool dummy) {
    const unsigned char* YS = (const unsigned char*)(F.ws + WS_YS); const int gw = F.vcu * NWAVES + F.wave, NGW = F.G * NWAVES, lane = F.lane;
    f32x4 gf[4];
#pragma unroll
    for (int j = 0; j < 4; ++j) gf[j] = *((const GAS f32x4*)F.g_final + lane + 64 * j);
    float* dst = dummy ? (float*)(F.ws + WS_XB) : F.out;
    for (int m = gw; m < T; m += NGW) { const GAS v2u* xr = (const GAS v2u*)(F.ws + WS_X1H + (size_t)m * DMODEL * 2) + lane; GAS f32x4* xw = (GAS f32x4*)(dst + (size_t)m * DMODEL) + lane;
        const GAS unsigned* y0 = (const GAS unsigned*)(YS + (size_t)(2 * m) * DMODEL) + lane; const GAS unsigned* y1 = (const GAS unsigned*)(YS + (size_t)(2 * m + 1) * DMODEL) + lane;
        f32x4 v[4]; float s = 0.f;
#pragma unroll
        for (int j = 0; j < 4; ++j) { const v2u hx = xr[64 * j]; v[j] = (f32x4){__uint_as_float(hx.x << 16), __uint_as_float(hx.x & 0xffff0000u), __uint_as_float(hx.y << 16), __uint_as_float(hx.y & 0xffff0000u)}; const unsigned a = y0[64 * j], c = y1[64 * j];
            typedef float v2f_ __attribute__((ext_vector_type(2)));
            const v2f_ a0 = __builtin_amdgcn_cvt_pk_f32_fp8((int)a, false), a1 = __builtin_amdgcn_cvt_pk_f32_fp8((int)a, true), c0 = __builtin_amdgcn_cvt_pk_f32_fp8((int)c, false), c1 = __builtin_amdgcn_cvt_pk_f32_fp8((int)c, true);
            v[j].x += (a0.x + c0.x) * (1.0f / 16.0f); v[j].y += (a0.y + c0.y) * (1.0f / 16.0f); v[j].z += (a1.x + c1.x) * (1.0f / 16.0f); v[j].w += (a1.y + c1.y) * (1.0f / 16.0f);
            s += (v[j].x * v[j].x + v[j].y * v[j].y) + (v[j].z * v[j].z + v[j].w * v[j].w); }
        s = wave_sum(s); const float rs = 1.0f / sqrtf(s * (1.0f / DMODEL) + RMS_EPS);
#pragma unroll
        for (int j = 0; j < 4; ++j) xw[64 * j] = v[j] * rs * gf[j]; }
}

template <class T_> struct KArgPtr { typedef T_ V; typedef const V __attribute__((address_space(4)))* type; };
struct Args { const float* in[15]; float* out; unsigned char* ws; int ph_lo, ph_hi; };
static_assert(sizeof(Args) == 144 && offsetof(Args, out) == 120 && offsetof(Args, ws) == 128 && offsetof(Args, ph_lo) == 136, "Args layout is read by offset (KARG)");
constexpr int N_PHASES = 10;

__global__ void __launch_bounds__(NWAVES * 64, 2) skel_fwd(Args args) {
    extern __shared__ __attribute__((aligned(16))) unsigned char lds[];
    Frame F;
    F.lds = (LAS unsigned char*)lds; F.ldsg = lds;
    F.wave = __builtin_amdgcn_readfirstlane(threadIdx.x >> 6); F.lane = lane_id_v(); F.tid = F.wave * 64 + F.lane;
    F.G = gridDim.x; { const int bx = blockIdx.x; F.vcu = (F.G % 8 == 0) ? (bx % 8) * (F.G / 8) + bx / 8 : bx; }
    typedef __attribute__((address_space(4))) const char* kptr_t;
    kptr_t ka = (kptr_t)__builtin_amdgcn_kernarg_segment_ptr();
#define KARG(T_, off) (*(KArgPtr<T_>::type)(ka + (off)))
#define LOADARGS() do { asm volatile("" : "+s"(ka)); \
    F.x = KARG(const float*, 0); F.g_mix = KARG(const float*, 8); F.w_in = KARG(const float*, 16); F.w_pa = KARG(const float*, 24); F.w_pb = KARG(const float*, 32); F.w_out = KARG(const float*, 40); \
    F.g_ffn = KARG(const float*, 48); F.w_group = KARG(const float*, 56); F.b_group = KARG(const float*, 64); F.w_expert = KARG(const float*, 72); F.b_expert = KARG(const float*, 80); \
    F.w1 = KARG(const float*, 88); F.w3 = KARG(const float*, 96); F.w2 = KARG(const float*, 104); F.g_final = KARG(const float*, 112); F.out = KARG(float*, 120); F.ws = KARG(unsigned char*, 128); ws = F.ws; \
    F.lane = lane_id_v(); F.tid = F.wave * 64 + F.lane; } while (0)
    unsigned char* ws;
    const int lo = KARG(int, 136), hi = KARG(int, 140);
    LOADARGS();
    for (int u = F.tid; u < (LDS_BYTES - MISC_OFF) / 4; u += NWAVES * 64) ((LAS unsigned*)(F.lds + MISC_OFF))[u] = 0u;
    __syncthreads();
    XcdBarrier bar = xcd_barrier_post((unsigned*)(ws + WS_CTL) + CW_BAR, (volatile LAS unsigned*)(F.lds + MISC_OFF + 1024), F.tid);
    cg::grid_group grid = cg::this_grid();
#define FRESH() LOADARGS()
#ifndef PHASE_MASK
#define PHASE_MASK 0x3ff
#endif
#define IN(k) (((PHASE_MASK >> (k)) & 1) && lo <= (k) && (k) < hi)
#ifndef DUP_PHASE
#define DUP_PHASE -1
#endif
#define REPS(k) for (int rep_ = 0, nrep_ = ((k) == DUP_PHASE ? 2 : 1); rep_ < nrep_; ++rep_, (rep_ < nrep_ ? (xcd_barrier(bar, F.tid, (unsigned)F.G), 0) : 0))
#define DUMMY() (rep_ + 1 < nrep_)
#define SEAM(k) do { if (IN(k) && IN((k) + 1)) { if ((k) == 0 && lo < 0) { grid.sync(); } xcd_barrier(bar, F.tid, (unsigned)F.G); } } while (0)

    if (IN(0)) REPS(0) { FRESH(); p0_prologue(F); }
    SEAM(0);
    if (IN(1)) REPS(1) {
        FRESH(); unsigned char* sga = (unsigned char*)F.out; unsigned char* sgb = sga + (size_t)T * DMODEL;
        { pg8::GmPlain g{(const char*)(ws + WS_XB), (const char*)(ws + WS_WIN), DMODEL};
          pg8::StaticOrder S; S.init(T, NINA, F.G, (int)blockIdx.x);
          pg8::EpiIn<0> E{
                     (bf16*)(ws + WS_QA), (bf16*)(ws + WS_KA), (bf16*)(ws + WS_VA), (bf16*)(ws + WS_QB), (bf16*)(ws + WS_KB), (bf16*)(ws + WS_VB), (bf16*)(ws + WS_QI), (bf16*)(ws + WS_KI),
                     (float*)(ws + WS_WI), sga, sgb};
          pg8::gemm_phase(F.lds, g, S, E, F.tid); }
        FRESH();
        { unsigned char* sga2 = (unsigned char*)F.out; unsigned char* sgb2 = sga2 + (size_t)T * DMODEL;
          pg8::GmPlainF8 g{(const char*)(ws + WS_X8), (const char*)(ws + WS_WIN8), DMODEL};
          pg8::StaticOrder S; S.init(T, NINB, F.G, (int)blockIdx.x);
          pg8::EpiIn<1> E{
                     (bf16*)(ws + WS_QA), (bf16*)(ws + WS_KA), (bf16*)(ws + WS_VA), (bf16*)(ws + WS_QB), (bf16*)(ws + WS_KB), (bf16*)(ws + WS_VB), (bf16*)(ws + WS_QI), (bf16*)(ws + WS_KI),
                     (float*)(ws + WS_WI), sga2, sgb2};
          pg8::gemm_phase(F.lds, g, S, E, F.tid); }
    }
    SEAM(1);
    if (IN(2)) REPS(2) { FRESH(); p2_kbsum(F); p2_select(F); }
    SEAM(2);
    if (IN(3)) REPS(3) {
        FRESH(); using namespace attn_body;
        const float* kbsum = (const float*)(ws + WS_KBSUM); const unsigned long long* maskw = (const unsigned long long*)(ws + WS_MASK);
        for (int bh = F.vcu; bh < NBATCH * NHEAD; bh += F.G) { const int b = bh >> 3, h = bh & 7;
            for (int i = 0; i < 8; ++i) { const int qb = (i & 1) ? (i >> 1) : 7 - (i >> 1);
                attn_unit<0, 8>(b, h, qb, (const attn_body::bf16*)(ws + WS_QA), (const attn_body::bf16*)(ws + WS_KA), (const attn_body::bf16*)(ws + WS_VA), (unsigned char*)(ws + WS_OA), (char*)lds, kbsum, maskw, F.tid); }
            for (int i = 0; i < 8; ++i) { const int qb = (i & 1) ? (i >> 1) : 7 - (i >> 1);
                attn_unit<1, 8>(b, h, qb, (const attn_body::bf16*)(ws + WS_QB), (const attn_body::bf16*)(ws + WS_KB), (const attn_body::bf16*)(ws + WS_VB), (unsigned char*)(ws + WS_OB), (char*)lds, kbsum, maskw, F.tid); } }
    }
    SEAM(3);
    if (IN(4)) REPS(4) {
        FRESH(); unsigned char* sga = (unsigned char*)F.out; unsigned char* sgb = sga + (size_t)T * DMODEL;
        { pg8::GmPlainF8 g{(const char*)(ws + WS_OA), (const char*)(ws + WS_WA), HW}; pg8::StaticOrder S; S.init(T, DMODEL, F.G, (int)blockIdx.x);
          pg8::EpiGate<true> E{sga, (unsigned char*)(ws + WS_MIX), (unsigned char*)(ws + WS_MIX8)}; pg8::gemm_phase(F.lds, g, S, E, F.tid); }
        { pg8::GmPlainF8 g{(const char*)(ws + WS_OB), (const char*)(ws + WS_WB), HW}; pg8::StaticOrder S; S.init(T, DMODEL, F.G, (int)blockIdx.x);
          pg8::EpiGate<false> E{sgb, (unsigned char*)(ws + WS_MIX), (unsigned char*)(ws + WS_MIX8)}; pg8::gemm_phase(F.lds, g, S, E, F.tid); }
    }
    SEAM(4);
    if (IN(5)) REPS(5) {
        FRESH();
        pg8::GmPlainF8 g{(const char*)(ws + WS_MIX8), (const char*)(ws + WS_WOUT), DMODEL}; pg8::StaticOrder S; S.init(T, DMODEL, F.G, (int)blockIdx.x);
        pg8::EpiRes E{(const bf16*)(ws + WS_XB), (const float*)(ws + WS_RSTD1), (bf16*)(ws + WS_X1H), (unsigned char*)(ws + WS_X1L), (unsigned char*)(ws + WS_X1B)}; pg8::gemm_phase(F.lds, g, S, E, F.tid);
    }
    SEAM(5);
    if (IN(6)) REPS(6) { FRESH(); p6_router(F, DUMMY()); }
    SEAM(6);
    LAS int* tstart = (LAS int*)(F.lds + MISC_OFF); LAS int* ecnt = tstart + 64;
    if (IN(7) || IN(8)) {
        FRESH();
        const unsigned* gcnt = (const unsigned*)(ws + WS_CTL) + CW_CNT;
        if (F.tid < 32) ecnt[F.tid] = (int)__hip_atomic_load(gcnt + F.tid, __ATOMIC_RELAXED, __HIP_MEMORY_SCOPE_AGENT);
        __syncthreads();
        if (F.tid == 0) { int s = 0; for (int e = 0; e < NEXP; ++e) { tstart[e] = s; s += (ecnt[e] + 255) >> 8; } tstart[NEXP] = s; }
        __syncthreads();
    }
    if (IN(7)) REPS(7) {
        FRESH();
        pg8::GmMoe1F8 g{(const char*)(ws + WS_X1B), (const char*)(ws + WS_W13), (const int*)(ws + WS_TOK), DMODEL};
        pg8::MoeOrder S{tstart, ecnt, 4, F.G, (int)blockIdx.x};
        pg8::EpiSwiGlu E{(const float*)(ws + WS_RSORT), (unsigned char*)(ws + WS_HID)};
        pg8::gemm_phase(F.lds, g, S, E, F.tid);
    }
    SEAM(7);
    if (IN(8)) REPS(8) {
        FRESH();
        pg8::GmMoe2F8 g{(const char*)(ws + WS_HID), (const char*)(ws + WS_W2), EFF};
        pg8::MoeOrder S{tstart, ecnt, 4, F.G, (int)blockIdx.x};
        pg8::EpiDown E{(const int*)(ws + WS_TOK), (const float*)(ws + WS_GSORT), (unsigned char*)(ws + WS_YS)};
        pg8::gemm_phase(F.lds, g, S, E, F.tid);
    }
    SEAM(8);
    if (IN(9)) REPS(9) { FRESH(); p9_final(F, DUMMY()); }
#undef IN
#undef SEAM
}

extern "C" void kernel_launch(void* const* d_in, const int* in_sizes, int n_in, void* d_out, int out_size, void* d_ws, size_t ws_size, hipStream_t stream) {
    static int grid = 0;
    if (grid == 0) {
        if (n_in != 15 || in_sizes[0] != T * DMODEL || out_size != T * DMODEL || ws_size < WS_END) {
            fprintf(stderr, "kernel_launch: unexpected shapes: n_in %d in0 %d out %d ws %zu (need >= %zu)\n", n_in, n_in > 0 ? in_sizes[0] : -1, out_size, ws_size, (size_t)WS_END); grid = -1; return; }
        int dev = 0, cus = 0, per_cu = 0;
        if (hipGetDevice(&dev) != hipSuccess || hipDeviceGetAttribute(&cus, hipDeviceAttributeMultiprocessorCount, dev) != hipSuccess) { grid = -1; return; }
        if (hipFuncSetAttribute((const void*)skel_fwd, hipFuncAttributeMaxDynamicSharedMemorySize, LDS_BYTES) != hipSuccess) { fprintf(stderr, "kernel_launch: hipFuncSetAttribute failed\n"); grid = -1; return; }
        if (hipOccupancyMaxActiveBlocksPerMultiprocessor(&per_cu, (const void*)skel_fwd, NWAVES * 64, LDS_BYTES) != hipSuccess || per_cu < 1) { fprintf(stderr, "kernel_launch: occupancy query says %d blocks per CU\n", per_cu); grid = -1; (void)hipGetLastError(); return; }
        grid = cus;
    }
    if (grid < 0) return;
    (void)hipMemsetAsync((char*)d_ws + WS_CTL, 0, CTL_ZERO_BYTES, stream);
    Args a{};
    for (int i = 0; i < 15; ++i) a.in[i] = (const float*)d_in[i];
    a.out = (float*)d_out; a.ws = (unsigned char*)d_ws;
#if MK_N_LAUNCHES == 1
    a.ph_lo = 0; a.ph_hi = N_PHASES;
    { void* kargs[] = {&a}; hipError_t e = hipLaunchCooperativeKernel((const void*)skel_fwd, dim3(grid), dim3(NWAVES * 64), kargs, LDS_BYTES, stream);
      if (e != hipSuccess) fprintf(stderr, "kernel_launch: cooperative launch failed: %s (grid %d)\n", hipGetErrorString(e), grid); }
#else
    for (int p = 0; p < N_PHASES; ++p) { a.ph_lo = p; a.ph_hi = p + 1; hipLaunchKernelGGL(skel_fwd, dim3(grid), dim3(NWAVES * 64), LDS_BYTES, stream, a); }
#endif
}
```

```cpp
#include <hip/hip_runtime.h>
#include <hip/hip_cooperative_groups.h>
#include <hip/hip_bf16.h>
#include <cstdio>
#include <cstdint>
#include <cstddef>
#include <cmath>
namespace cg = cooperative_groups;

#ifndef MK_N_LAUNCHES
#define MK_N_LAUNCHES 1
#endif

constexpr int NBATCH = 32, SEQ = 2048, DMODEL = 1024, T = NBATCH * SEQ;
constexpr int NHEAD = 8, HD = 64, HW = NHEAD * HD;
constexpr int IN_COLS = 5704, NINA = 768, NINB = 5120;
constexpr int NEXP = 32, EFF = 512;
constexpr float RMS_EPS = 1e-6f;
constexpr float IDX_SCALE = 0.044194173824159216f;
constexpr float C2 = 0.125f * 1.4426950408889634f;
constexpr int HID_ROWS = 131072 + 8192;

namespace pg8 {
#define PG8_LAS __attribute__((address_space(3)))
typedef unsigned short bf16_t;
typedef short bf16x8 __attribute__((ext_vector_type(8)));
typedef float f32x4 __attribute__((ext_vector_type(4)));
typedef unsigned u32x4 __attribute__((ext_vector_type(4)));
typedef unsigned u32x2 __attribute__((ext_vector_type(2)));
constexpr int BM = 256, BK = 64, HALF = 128, HTB = HALF * BK * 2, STAGE_BYTES = 8 * HTB, NXCD = 8, WGM = 8;

__host__ __device__ __forceinline__ int lds_byte(int r, int c) { const int st = (r >> 4) * 2 + (c >> 5), rr = r & 15, cc = c & 31, ob = rr * 64 + cc * 2; return st * 1024 + (ob ^ (((ob >> 9) & 1) << 5)); }
__host__ __device__ __forceinline__ void stage_rc(int b, int& R, int& C) { const int st = b / 1024, sb = b % 1024, swz = sb ^ (((sb >> 9) & 1) << 5); R = (st >> 1) * 16 + swz / 64; C = (st & 1) * 32 + (swz % 64) / 2; }
__host__ __device__ __forceinline__ int perm32(int rho) { const int n = rho >> 4, i = rho & 15; return 8 * (i >> 2) + 4 * n + (i & 3); }

typedef int v8i __attribute__((ext_vector_type(8)));
__host__ __device__ __forceinline__ int swz8(int r) { return (((r >> 1) & 3) << 5) ^ (((r >> 3) & 1) << 4); }
__host__ __device__ __forceinline__ int lds_byte8(int r, int cb) { return r * 128 + (cb ^ swz8(r)); }
__host__ __device__ __forceinline__ void stage_rc8(int b, int& R, int& Cb) { R = b >> 7; Cb = (b & 127) ^ swz8(R); }
constexpr int F8_SCALE1 = 0x7f7f7f7f;
__host__ __device__ __forceinline__ int perm16(int s) { return 64 * ((s >> 5) & 3) + 16 * ((s >> 2) & 3) + 8 * (s >> 7) + 4 * ((s >> 4) & 1) + (s & 3); }
struct Unit { int pm, pn, e, lt, cnt; };

struct StaticOrder {
    int nM, nN, nwg, G, c;
    __device__ void init(int M, int N, int G_, int c_) { nM = M / BM; nN = N / BM; nwg = nM * nN; G = G_; c = c_; }
    __device__ bool next(int i, Unit& u) const {
        const long L = (long)i * G + c; if (L >= nwg) return false;
        int wgid = (int)L; { const int q = nwg / NXCD, r = nwg % NXCD, xcd = wgid % NXCD, off = wgid / NXCD; wgid = (xcd < r ? xcd * (q + 1) : r * (q + 1) + (xcd - r) * q) + off; }
        const int nig = WGM * nN, gid = wgid / nig, fm = gid * WGM, gsz = (nM - fm) < WGM ? (nM - fm) : WGM;
        u.pm = fm + ((wgid % nig) % gsz); u.pn = (wgid % nig) / gsz; u.e = 0; u.lt = 0; u.cnt = 0; return true;
    }
};
struct MoeOrder {
    const PG8_LAS int* tstart; const PG8_LAS int* cnt; int nN, G, c;
    __device__ bool next(int i, Unit& u) const {
        const long L = (long)i * G + c; const int ntiles = tstart[NEXP];
        if (L >= (long)ntiles * nN) return false;
        const int pm = (int)(L / nN); u.pm = pm; u.pn = (int)(L % nN);
        int e = 0;
#pragma unroll 1
        for (int j = 1; j < NEXP; ++j) e = (tstart[j] <= pm) ? j : e;
        u.e = e; u.lt = pm - tstart[e]; u.cnt = cnt[e]; return true;
    }
};

__device__ __forceinline__ unsigned cvt_pk_bf16(float lo, float hi) { typedef float f2 __attribute__((ext_vector_type(2))); typedef __bf16 b2 __attribute__((ext_vector_type(2))); f2 v = {lo, hi}; b2 b = __builtin_convertvector(v, b2); return __builtin_bit_cast(unsigned, b); }
__device__ __forceinline__ float bf2f(unsigned short s) { return __uint_as_float((unsigned)s << 16); }

struct GmPlain {
    static constexpr bool FP8 = false;
    const char* A; const char* Bt; int K;
    __device__ __forceinline__ const char* abase() const { return A; }
    __device__ __forceinline__ void offs(const Unit& u, const int (&R)[2], const int (&C)[2], unsigned (&o)[2][2]) const {
#pragma unroll
        for (int h = 0; h < 2; ++h)
#pragma unroll
            for (int i = 0; i < 2; ++i) o[h][i] = (unsigned)(((u.pm * 256 + h * 128 + R[i]) * K + C[i]) * 2);
    }
    __device__ __forceinline__ const char* bptr(const Unit& u) const { return Bt + (size_t)u.pn * 256 * K * 2; }
};
struct GmMoe1 {
    static constexpr bool FP8 = false;
    const char* A; const char* Bt; const int* tok; int K;
    __device__ __forceinline__ const char* abase() const { return A; }
    __device__ __forceinline__ void offs(const Unit& u, const int (&R)[2], const int (&C)[2], unsigned (&o)[2][2]) const {
#pragma unroll
        for (int h = 0; h < 2; ++h)
#pragma unroll
            for (int i = 0; i < 2; ++i) { int r = u.lt * 256 + h * 128 + R[i]; r = r < u.cnt ? r : u.cnt - 1; const int ts = tok[(size_t)u.e * 65536 + r]; o[h][i] = (unsigned)((((ts >> 1)) * K + C[i]) * 2); }
    }
    __device__ __forceinline__ const char* bptr(const Unit& u) const { return Bt + ((size_t)u.e * 1024 + (size_t)u.pn * 256) * K * 2; }
};
struct GmMoe2 {
    static constexpr bool FP8 = false;
    const char* A; const char* Bt; int K;
    __device__ __forceinline__ const char* abase() const { return A; }
    __device__ __forceinline__ void offs(const Unit& u, const int (&R)[2], const int (&C)[2], unsigned (&o)[2][2]) const {
#pragma unroll
        for (int h = 0; h < 2; ++h)
#pragma unroll
            for (int i = 0; i < 2; ++i) o[h][i] = (unsigned)(((u.pm * 256 + h * 128 + R[i]) * K + C[i]) * 2);
    }
    __device__ __forceinline__ const char* bptr(const Unit& u) const { return Bt + ((size_t)u.e * 1024 + (size_t)u.pn * 256) * K * 2; }
};

struct GmMoe1F8 {
    static constexpr bool FP8 = true;
    const char* A; const char* Bt; const int* tok; int K;
    __device__ __forceinline__ const char* abase() const { return A; }
    __device__ __forceinline__ void offs(const Unit& u, const int (&R)[2], const int (&C)[2], unsigned (&o)[2][2]) const {
#pragma unroll
        for (int h = 0; h < 2; ++h)
#pragma unroll
            for (int i = 0; i < 2; ++i) { int r = u.lt * 256 + h * 128 + R[i]; r = r < u.cnt ? r : u.cnt - 1; const int ts = tok[(size_t)u.e * 65536 + r]; o[h][i] = (unsigned)((ts >> 1) * K + C[i]); }
    }
    __device__ __forceinline__ const char* bptr(const Unit& u) const { return Bt + ((size_t)u.e * 1024 + (size_t)u.pn * 256) * K; }
};
struct GmPlainF8 {
    static constexpr bool FP8 = true;
    const char* A; const char* Bt; int K;
    __device__ __forceinline__ const char* abase() const { return A; }
    __device__ __forceinline__ void offs(const Unit& u, const int (&R)[2], const int (&C)[2], unsigned (&o)[2][2]) const {
#pragma unroll
        for (int h = 0; h < 2; ++h)
#pragma unroll
            for (int i = 0; i < 2; ++i) o[h][i] = (unsigned)((u.pm * 256 + h * 128 + R[i]) * K + C[i]);
    }
    __device__ __forceinline__ const char* bptr(const Unit& u) const { return Bt + (size_t)u.pn * 256 * K; }
};
struct GmMoe2F8 {
    static constexpr bool FP8 = true;
    const char* A; const char* Bt; int K;
    __device__ __forceinline__ const char* abase() const { return A; }
    __device__ __forceinline__ void offs(const Unit& u, const int (&R)[2], const int (&C)[2], unsigned (&o)[2][2]) const {
#pragma unroll
        for (int h = 0; h < 2; ++h)
#pragma unroll
            for (int i = 0; i < 2; ++i) o[h][i] = (unsigned)((u.pm * 256 + h * 128 + R[i]) * K + C[i]);
    }
    __device__ __forceinline__ const char* bptr(const Unit& u) const { return Bt + ((size_t)u.e * 1024 + (size_t)u.pn * 256) * K; }
};
__device__ __forceinline__ unsigned cvt4_fp8(float a, float b, float c, float d) { int w = 0; w = __builtin_amdgcn_cvt_pk_fp8_f32(a, b, w, false); w = __builtin_amdgcn_cvt_pk_fp8_f32(c, d, w, true); return (unsigned)w; }


__host__ __device__ __forceinline__ int in_tile_of(int part, int p) { return part == 0 ? (p < 2 ? 12 + p : 14) : (p < 12 ? p : p + 3); }
__device__ __forceinline__ size_t pairaddr(int row, int col) { return ((size_t)(row >> 1) << 11) + (size_t)(((col >> 6) << 7) + ((row & 1) << 6) + (col & 63)); }
template <int PART> struct EpiIn {
    bf16_t *qa, *ka, *va, *qb, *kb, *vb, *qi, *ki; float* wi; unsigned char *sga, *sgb;
    static constexpr float ASCALE = PART == 0 ? 1.0f : (1.0f / 32.0f);
    __device__ __forceinline__ void rope_rows(const f32x4 (&acc)[2][2][4][2], bf16_t* dst, int pitch, int rowb, int fq, float sc) const {
        constexpr float B8[8] = {0.15915494309189535f, 0.11934937021124886f, 0.08949940160889101f, 0.06711508300522726f, 0.050329212104487035f, 0.03774158471741977f, 0.0283021958306234f, 0.02122365276477766f};
        const float dec = fq == 0 ? 1.0f : fq == 1 ? 0.1f : fq == 2 ? 0.01f : 0.001f; const int j0 = 8 * fq;
        f32x4 c4[2][2], s4[2][2], cr[2], sr[2];
        const float p0 = (float)(rowb & (SEQ - 1)), p1 = (float)((rowb + HALF) & (SEQ - 1));
#pragma unroll
        for (int n = 0; n < 2; ++n)
#pragma unroll
            for (int k = 0; k < 4; ++k) { const float w = dec * B8[4 * n + k];
                const float r16 = __builtin_amdgcn_fractf(16.0f * w); cr[n][k] = __builtin_amdgcn_cosf(r16); sr[n][k] = __builtin_amdgcn_sinf(r16);
                const float ra = __builtin_amdgcn_fractf(p0 * w); c4[0][n][k] = __builtin_amdgcn_cosf(ra); s4[0][n][k] = __builtin_amdgcn_sinf(ra);
                const float rb = __builtin_amdgcn_fractf(p1 * w); c4[1][n][k] = __builtin_amdgcn_cosf(rb); s4[1][n][k] = __builtin_amdgcn_sinf(rb); }
#pragma unroll
        for (int ai = 0; ai < 2; ++ai) {
#pragma unroll
            for (int m = 0; m < 4; ++m) { const int row = rowb + ai * HALF + m * 16;
                u32x4 a, b;
#pragma unroll
                for (int n = 0; n < 2; ++n) { const f32x4 c = c4[ai][n], sn = s4[ai][n];
                    const f32x4 x1 = acc[ai][0][m][n] * sc, x2 = acc[ai][1][m][n] * sc; const f32x4 o1 = x1 * c - x2 * sn, o2 = x1 * sn + x2 * c;
                    a[2 * n] = cvt_pk_bf16(o1[0], o1[1]); a[2 * n + 1] = cvt_pk_bf16(o1[2], o1[3]); b[2 * n] = cvt_pk_bf16(o2[0], o2[1]); b[2 * n + 1] = cvt_pk_bf16(o2[2], o2[3]);
                    c4[ai][n] = c * cr[n] - sn * sr[n]; s4[ai][n] = sn * cr[n] + c * sr[n]; }
                bf16_t* p = dst + (size_t)row * pitch + j0; *(u32x4*)p = a; *(u32x4*)(p + 32) = b; } }
    }
    __device__ __forceinline__ void operator()(const f32x4 (&acc)[2][2][4][2], const Unit& u, int wr, int wc, int fr, int fq) const {
        const int pn = in_tile_of(PART, u.pn); const int rowb = u.pm * BM + wr * 64 + fr;
        if (pn < 14) {
            const int seg = pn >> 1;
            if (seg == 2 || seg == 5) {
                bf16_t* dst = (seg == 2) ? va : vb; const int colb = (pn & 1) * 256 + wc * 64 + 16 * fq;
#pragma unroll
                for (int ai = 0; ai < 2; ++ai) {
#pragma unroll
                    for (int m = 0; m < 4; ++m) { const int row = rowb + ai * HALF + m * 16; const float r = ASCALE;
#pragma unroll
                        for (int bj = 0; bj < 2; ++bj) { const f32x4 v0 = acc[ai][bj][m][0] * r, v1 = acc[ai][bj][m][1] * r; u32x4 w;
                            w.x = cvt_pk_bf16(v0[0], v0[1]); w.y = cvt_pk_bf16(v0[2], v0[3]); w.z = cvt_pk_bf16(v1[0], v1[1]); w.w = cvt_pk_bf16(v1[2], v1[3]);
                            *(u32x4*)(dst + (size_t)row * HW + colb + bj * 8) = w; } } }
            } else {
                bf16_t* dst = (seg == 0) ? qa : (seg == 1) ? ka : (seg == 3) ? qb : (seg == 4) ? kb : qi;
                const float sc = ((seg == 0 || seg == 3) ? C2 : 1.0f) * ASCALE; const int head = 4 * (pn & 1) + wc;
                rope_rows(acc, dst + head * 64, HW, rowb, fq, sc);
            }
        } else if (pn == 14) {
            if (wc == 0) rope_rows(acc, ki, 64, rowb, fq, 1.0f);
            else if (wc == 1 && fq < 2) {
#pragma unroll
                for (int ai = 0; ai < 2; ++ai)
#pragma unroll
                    for (int m = 0; m < 4; ++m) { const int row = rowb + ai * HALF + m * 16; const float r = IDX_SCALE;
                        *(f32x4*)(wi + (size_t)row * 8 + 4 * fq) = acc[ai][0][m][0] * r; }
            }
        } else {
            const int gi = pn - 15; unsigned char* dst = (gi < 4) ? sga : sgb; const int colb = (gi & 3) * 256 + wc * 64 + 16 * fq;
#pragma unroll
            for (int ai = 0; ai < 2; ++ai) {
#pragma unroll
                for (int m = 0; m < 4; ++m) { const int row = rowb + ai * HALF + m * 16; const float r = -1.4426950408889634f * ASCALE; u32x4 w;
#pragma unroll
                    for (int bj = 0; bj < 2; ++bj)
#pragma unroll
                        for (int n = 0; n < 2; ++n) { f32x4 v = acc[ai][bj][m][n] * r;
#pragma unroll
                            for (int k = 0; k < 4; ++k) v[k] = 256.0f * __builtin_amdgcn_rcpf(1.0f + __builtin_amdgcn_exp2f(v[k]));
                            w[2 * bj + n] = cvt4_fp8(v[0], v[1], v[2], v[3]); }
                    *(u32x4*)(dst + pairaddr(row, colb)) = w; } }
        }
    }
};
template <bool FIRST> struct EpiGate {
    const unsigned char* sg; unsigned char* tmp; unsigned char* out8;
    __device__ __forceinline__ void operator()(const f32x4 (&acc)[2][2][4][2], const Unit& u, int wr, int wc, int fr, int fq) const {
        typedef float v2f_ __attribute__((ext_vector_type(2)));
        const int rowb = u.pm * BM + wr * 64 + fr, colb = u.pn * BM + wc * 64 + 16 * fq;
#pragma unroll
        for (int ai = 0; ai < 2; ++ai) { u32x4 g[4], pv[4];
#pragma unroll
            for (int m = 0; m < 4; ++m) { const size_t off = pairaddr(rowb + ai * HALF + m * 16, colb);
                g[m] = *(const u32x4*)(sg + off); if (!FIRST) pv[m] = *(const u32x4*)(tmp + off); else pv[m] = (u32x4){0u, 0u, 0u, 0u}; }
#pragma unroll
            for (int m = 0; m < 4; ++m) { const int row = rowb + ai * HALF + m * 16; const size_t off = FIRST ? pairaddr(row, colb) : (size_t)row * DMODEL + colb; u32x4 w;
#pragma unroll
                for (int bj = 0; bj < 2; ++bj)
#pragma unroll
                    for (int n = 0; n < 2; ++n) { const f32x4 a = acc[ai][bj][m][n] * (32.0f / 65536.0f); const int q = 2 * bj + n;
                        const v2f_ g0 = __builtin_amdgcn_cvt_pk_f32_fp8((int)g[m][q], false), g1 = __builtin_amdgcn_cvt_pk_f32_fp8((int)g[m][q], true);
                        const v2f_ p0 = __builtin_amdgcn_cvt_pk_f32_fp8((int)pv[m][q], false), p1 = __builtin_amdgcn_cvt_pk_f32_fp8((int)pv[m][q], true);
                        w[q] = cvt4_fp8(a[0] * g0.x + p0.x, a[1] * g0.y + p0.y, a[2] * g1.x + p1.x, a[3] * g1.y + p1.y); }
                *(u32x4*)((FIRST ? tmp : out8) + off) = w; } }
    }
};
struct EpiRes {
    const bf16_t* xb; const float* irstd; bf16_t* xh; unsigned char* xl; unsigned char* xq;
    __device__ __forceinline__ void operator()(const f32x4 (&acc)[2][2][4][2], const Unit& u, int wr, int wc, int fr, int fq) const {
        const int rowb = u.pm * BM + wr * 64 + fr, colb = u.pn * BM + wc * 64 + 16 * fq;
#pragma unroll
        for (int ai = 0; ai < 2; ++ai) { u32x4 bs[4][2]; float ir[4];
#pragma unroll
            for (int m = 0; m < 4; ++m) { const int row = rowb + ai * HALF + m * 16; const size_t off = (size_t)row * DMODEL + colb; ir[m] = irstd[row];
#pragma unroll
                for (int bj = 0; bj < 2; ++bj) bs[m][bj] = *(const u32x4*)(xb + off + bj * 8); }
#pragma unroll
            for (int m = 0; m < 4; ++m) { const size_t off = (size_t)(rowb + ai * HALF + m * 16) * DMODEL + colb; u32x4 hw[2], lw, qw;
#pragma unroll
                for (int bj = 0; bj < 2; ++bj)
#pragma unroll
                    for (int n = 0; n < 2; ++n) { float qv[4], lo[4];
#pragma unroll
                        for (int q = 0; q < 2; ++q) { const unsigned xw = bs[m][bj][2 * n + q];
                            const float v0 = __uint_as_float(xw << 16) * ir[m] + acc[ai][bj][m][n][2 * q] * (1.0f / 1024.0f), v1 = __uint_as_float(xw & 0xffff0000u) * ir[m] + acc[ai][bj][m][n][2 * q + 1] * (1.0f / 1024.0f);
                            const unsigned h = cvt_pk_bf16(v0, v1); qv[2 * q] = v0; qv[2 * q + 1] = v1; hw[bj][2 * n + q] = h;
                            lo[2 * q] = (v0 - __uint_as_float(h << 16)) * 512.0f; lo[2 * q + 1] = (v1 - __uint_as_float(h & 0xffff0000u)) * 512.0f; }
                        qw[2 * bj + n] = cvt4_fp8(qv[0], qv[1], qv[2], qv[3]); lw[2 * bj + n] = cvt4_fp8(lo[0], lo[1], lo[2], lo[3]); }
                *(u32x4*)(xh + off) = hw[0]; *(u32x4*)(xh + off + 8) = hw[1]; *(u32x4*)(xl + off) = lw; *(u32x4*)(xq + off) = qw; } }
    }
};
struct EpiSwiGlu {
    const float* rsort; unsigned char* hid;
    __device__ __forceinline__ void operator()(const f32x4 (&acc)[2][2][4][2], const Unit& u, int wr, int wc, int fr, int fq) const {
        float rr[2][4];
#pragma unroll
        for (int ai = 0; ai < 2; ++ai)
#pragma unroll
            for (int m = 0; m < 4; ++m) { int er = u.lt * 256 + ai * HALF + wr * 64 + m * 16 + fr; er = er < u.cnt ? er : u.cnt - 1; rr[ai][m] = rsort[(size_t)u.e * 65536 + er] * (1.0f / 32.0f); }
#pragma unroll
        for (int ai = 0; ai < 2; ++ai)
#pragma unroll
            for (int m = 0; m < 4; ++m) { const int lr = ai * HALF + wr * 64 + m * 16 + fr; const int er = u.lt * 256 + lr;
                if (er < u.cnt) { const float r = rr[ai][m]; float o[8];
#pragma unroll
                    for (int n = 0; n < 2; ++n) { const f32x4 a = acc[ai][0][m][n] * r, b = acc[ai][1][m][n] * r;
#pragma unroll
                        for (int k = 0; k < 4; ++k) { const float sg = __builtin_amdgcn_rcpf(1.0f + __builtin_amdgcn_exp2f(a[k] * (-1.4426950408889634f))); o[4 * n + k] = 2.0f * a[k] * sg * b[k]; } }
                    u32x2 w; w.x = cvt4_fp8(o[0], o[1], o[2], o[3]); w.y = cvt4_fp8(o[4], o[5], o[6], o[7]);
                    *(u32x2*)(hid + (size_t)(u.pm * 256 + lr) * EFF + 128 * u.pn + 32 * wc + 8 * fq) = w; } }
    }
};
struct EpiDown {
    const int* tok; const float* gsort; unsigned char* ys;
    __device__ __forceinline__ void operator()(const f32x4 (&acc)[2][2][4][2], const Unit& u, int wr, int wc, int fr, int fq) const {
        const int colb = u.pn * BM + wc * 64 + 16 * fq;
        int ts[2][4]; float gg[2][4];
#pragma unroll
        for (int ai = 0; ai < 2; ++ai)
#pragma unroll
            for (int m = 0; m < 4; ++m) { int er = u.lt * 256 + ai * HALF + wr * 64 + m * 16 + fr; er = er < u.cnt ? er : u.cnt - 1; ts[ai][m] = tok[(size_t)u.e * 65536 + er]; gg[ai][m] = gsort[(size_t)u.e * 65536 + er]; }
#pragma unroll
        for (int ai = 0; ai < 2; ++ai)
#pragma unroll
            for (int m = 0; m < 4; ++m) { const int er = u.lt * 256 + ai * HALF + wr * 64 + m * 16 + fr;
                if (er < u.cnt) { const float g = gg[ai][m] * (16.0f / 32.0f); const int t_ = ts[ai][m]; u32x4 w;
#pragma unroll
                    for (int bj = 0; bj < 2; ++bj)
#pragma unroll
                        for (int n = 0; n < 2; ++n) { const f32x4 v = acc[ai][bj][m][n] * g; w[2 * bj + n] = cvt4_fp8(v[0], v[1], v[2], v[3]); }
                    *(u32x4*)(ys + (size_t)t_ * DMODEL + colb) = w; } }
    }
};

template <class GM, class Epi, class Sched>
__device__ __forceinline__ void gemm_phase(PG8_LAS unsigned char* lds, const GM g, const Sched& S, const Epi& E, const int tid) {
    const int wid = __builtin_amdgcn_readfirstlane(tid >> 6), lane = tid & 63, wr = wid >> 2, wc = wid & 3, fr = lane & 15, fq = lane >> 4;
    constexpr bool FP8 = GM::FP8;
    const int K = g.K, nt = FP8 ? K / 128 : K / BK;
    int sR[2], sC[2]; unsigned voffB[2];
#pragma unroll
    for (int i = 0; i < 2; ++i) { int R, C; if constexpr (FP8) { stage_rc8(tid * 16 + i * 8192, R, C); voffB[i] = (unsigned)(R * K + C); } else { stage_rc(tid * 16 + i * 8192, R, C); voffB[i] = (unsigned)(R * K + C) * 2u; }
        sR[i] = R; sC[i] = C; }
    const size_t kstep = (size_t)(BK * 2);
    const size_t hstep = FP8 ? (size_t)HALF * K : (size_t)HALF * K * 2;
    const unsigned ldsw = (unsigned)wid * 1024u;
    const int aoff = FP8 ? lds_byte8(wr * 64 + fr, fq * 32) : lds_byte(wr * 64 + fr, fq * 8), boff = FP8 ? lds_byte8(wc * 32 + fr, fq * 32) : lds_byte(wc * 32 + fr, fq * 8);
    const int aoff1 = aoff ^ 16, boff1 = boff ^ 16;
    const char* const abase = g.abase();
#define PG8_SA(b, h) (((b) * 2 + (h)) * HTB)
#define PG8_SB(b, h) ((4 + (b) * 2 + (h)) * HTB)
#define PG8_STAGE(bufoff, gbase, voff) do { _Pragma("unroll") for (int _i = 0; _i < 2; ++_i) \
        __builtin_amdgcn_global_load_lds((const unsigned*)((const char*)(gbase) + (voff)[_i]), (PG8_LAS unsigned*)(lds + (bufoff) + ldsw + _i * 8192), 16, 0, 0); } while (0)
#define PG8_STAGEA(bufoff, OFF, h, kb) do { const char* ub_ = abase + (kb);   _Pragma("unroll") for (int _i = 0; _i < 2; ++_i) \
        __builtin_amdgcn_global_load_lds((const unsigned*)(ub_ + (OFF)[h][_i]), (PG8_LAS unsigned*)(lds + (bufoff) + ldsw + _i * 8192), 16, 0, 0); } while (0)
#define PG8_LD8(off0_, off1_, cst_) ({ typedef int v4i_ __attribute__((ext_vector_type(4))); const v4i_ lo_ = *(const PG8_LAS v4i_*)(lds + (cst_) + (off0_)); const v4i_ hi_ = *(const PG8_LAS v4i_*)(lds + (cst_) + (off1_)); __builtin_shufflevector(lo_, hi_, 0, 1, 2, 3, 4, 5, 6, 7); })
#define PG8_LDA(dst, b, h) do { if constexpr (FP8) { _Pragma("unroll") for (int m = 0; m < 4; ++m) dst##8[m] = PG8_LD8(aoff, aoff1, PG8_SA(b, h) + m * 2048); } \
        else { _Pragma("unroll") for (int m = 0; m < 4; ++m) _Pragma("unroll") for (int k = 0; k < 2; ++k) dst[m][k] = *(const PG8_LAS bf16x8*)(lds + PG8_SA(b, h) + aoff + m * 2048 + k * 1024); } } while (0)
#define PG8_LDB(dst, b, h) do { if constexpr (FP8) { _Pragma("unroll") for (int n = 0; n < 2; ++n) dst##8[n] = PG8_LD8(boff, boff1, PG8_SB(b, h) + n * 2048); } \
        else { _Pragma("unroll") for (int n = 0; n < 2; ++n) _Pragma("unroll") for (int k = 0; k < 2; ++k) dst[n][k] = *(const PG8_LAS bf16x8*)(lds + PG8_SB(b, h) + boff + n * 2048 + k * 1024); } } while (0)
#define PG8_MMA(ai, bj, At, Bt) do { __builtin_amdgcn_s_setprio(1); if constexpr (FP8) { _Pragma("unroll") for (int m = 0; m < 4; ++m) _Pragma("unroll") for (int n = 0; n < 2; ++n) \
        asm volatile("v_mfma_scale_f32_16x16x128_f8f6f4 %0, %1, %2, %0, %3, %3 op_sel_hi:[0,0,0]" : "+v"(acc[ai][bj][m][n]) : "v"(Bt##8[n]), "v"(At##8[m]), "v"(f8sc)); } \
        else { _Pragma("unroll") for (int m = 0; m < 4; ++m) _Pragma("unroll") for (int n = 0; n < 2; ++n) _Pragma("unroll") for (int k = 0; k < 2; ++k) \
        acc[ai][bj][m][n] = __builtin_amdgcn_mfma_f32_16x16x32_bf16(Bt[n][k], At[m][k], acc[ai][bj][m][n], 0, 0, 0); } __builtin_amdgcn_s_setprio(0); } while (0)
#define PG8_WAIT_V(n) asm volatile("s_waitcnt vmcnt(" #n ")" ::: "memory")
#define PG8_WAIT_L(n) asm volatile("s_waitcnt lgkmcnt(" #n ")" ::: "memory")
#define PG8_BAR __builtin_amdgcn_s_barrier()
#define PG8_SCHED __builtin_amdgcn_sched_barrier(0)
    Unit cur, nxt; int ui = 0;
    if (!S.next(0, cur)) return;
    f32x4 acc[2][2][4][2];
#pragma unroll
    for (int a = 0; a < 2; ++a)
#pragma unroll
        for (int b = 0; b < 2; ++b)
#pragma unroll
            for (int m = 0; m < 4; ++m)
#pragma unroll
                for (int n = 0; n < 2; ++n) acc[a][b][m][n] = (f32x4){0.f, 0.f, 0.f, 0.f};
    bf16x8 At[4][2], B0[2][2], B1[2][2]; v8i At8[4], B08[2], B18[2];
    const int f8sc = F8_SCALE1;
    unsigned cOff[2][2], nOff[2][2];
    g.offs(cur, sR, sC, cOff);
    const char* cB = g.bptr(cur);
    PG8_STAGE(PG8_SB(0, 0), cB, voffB); PG8_STAGE(PG8_SB(0, 1), cB + hstep, voffB); PG8_STAGEA(PG8_SA(0, 0), cOff, 0, (size_t)0); PG8_STAGEA(PG8_SA(0, 1), cOff, 1, (size_t)0);
    if (wr == 1) PG8_BAR;
    PG8_WAIT_V(2); PG8_BAR;
    PG8_STAGE(PG8_SB(1, 0), cB + kstep, voffB); PG8_STAGEA(PG8_SA(1, 0), cOff, 0, kstep); PG8_STAGE(PG8_SB(1, 1), cB + hstep + kstep, voffB);
    PG8_WAIT_V(6); PG8_BAR;
    for (;;) {
        const bool has_next = S.next(ui + 1, nxt);
        const char* nB = cB;
        if (has_next) { g.offs(nxt, sR, sC, nOff); nB = g.bptr(nxt); }
        else {
#pragma unroll
            for (int h = 0; h < 2; ++h)
#pragma unroll
                for (int i = 0; i < 2; ++i) nOff[h][i] = cOff[h][i];
        }
#pragma unroll 1
        for (int t = 0; t < nt; t += 2) {
            const bool last = (t == nt - 2);
            const size_t kb1 = (size_t)(t + 1) * kstep;
            const size_t kb2 = last ? (size_t)0 : (size_t)(t + 2) * kstep, kb3 = kb2 + kstep;
            unsigned o2[2][2];
#pragma unroll
            for (int h = 0; h < 2; ++h)
#pragma unroll
                for (int i = 0; i < 2; ++i) o2[h][i] = last ? nOff[h][i] : cOff[h][i];
            const char* b2 = last ? nB : cB + (size_t)(t + 2) * kstep; const char* b3 = b2 + kstep;
            PG8_LDB(B0, 0, 0); PG8_LDB(B1, 0, 1); PG8_SCHED; PG8_LDA(At, 0, 0); PG8_STAGEA(PG8_SA(1, 1), cOff, 1, kb1);
            PG8_WAIT_V(8); PG8_WAIT_L(0); PG8_BAR; PG8_MMA(0, 0, At, B0); PG8_MMA(0, 1, At, B1); PG8_BAR; PG8_SCHED;
            PG8_LDA(At, 0, 1); PG8_STAGE(PG8_SB(0, 0), b2, voffB); PG8_STAGE(PG8_SB(0, 1), b2 + hstep, voffB); PG8_STAGEA(PG8_SA(0, 0), o2, 0, kb2);
            PG8_WAIT_V(8); PG8_WAIT_L(0); PG8_BAR; PG8_MMA(1, 0, At, B0); PG8_MMA(1, 1, At, B1); PG8_BAR; PG8_SCHED;
            PG8_LDB(B0, 1, 0); PG8_LDB(B1, 1, 1); PG8_SCHED; PG8_LDA(At, 1, 0); PG8_STAGEA(PG8_SA(0, 1), o2, 1, kb2);
            PG8_WAIT_V(8); PG8_WAIT_L(0); PG8_BAR; PG8_MMA(0, 0, At, B0); PG8_MMA(0, 1, At, B1); PG8_BAR; PG8_SCHED;
            PG8_LDA(At, 1, 1); PG8_STAGE(PG8_SB(1, 0), b3, voffB); PG8_STAGE(PG8_SB(1, 1), b3 + hstep, voffB); PG8_STAGEA(PG8_SA(1, 0), o2, 0, kb3);
            PG8_WAIT_V(8); PG8_WAIT_L(0); PG8_BAR; PG8_MMA(1, 0, At, B0); PG8_MMA(1, 1, At, B1); PG8_BAR; PG8_SCHED;
        }
        if constexpr (FP8) asm volatile("s_nop 15\n\ts_nop 15" ::: "memory");
        if (wr == 0) PG8_BAR;
        { int fr_ = fr, fq_ = fq; asm volatile("" : "+v"(fr_), "+v"(fq_));
          E(acc, cur, wr, wc, fr_, fq_); }
        if (!has_next) break;
#pragma unroll
        for (int a = 0; a < 2; ++a)
#pragma unroll
            for (int b = 0; b < 2; ++b)
#pragma unroll
                for (int m = 0; m < 4; ++m)
#pragma unroll
                    for (int n = 0; n < 2; ++n) acc[a][b][m][n] = (f32x4){0.f, 0.f, 0.f, 0.f};
        cur = nxt; cB = nB; ++ui;
#pragma unroll
        for (int h = 0; h < 2; ++h)
#pragma unroll
            for (int i = 0; i < 2; ++i) cOff[h][i] = nOff[h][i];
        if (wr == 1) PG8_BAR;
    }
    PG8_WAIT_V(0);
    PG8_BAR;
#undef PG8_SA
#undef PG8_SB
#undef PG8_STAGE
#undef PG8_STAGEA
#undef PG8_LDA
#undef PG8_LD8
#undef PG8_LDB
#undef PG8_MMA
#undef PG8_WAIT_V
#undef PG8_WAIT_L
#undef PG8_BAR
#undef PG8_SCHED
}
}

namespace attn_body {
using bf16=__hip_bfloat16;
using bf16x8=__attribute__((ext_vector_type(8)))short;
using s16x4=__attribute__((ext_vector_type(4)))short;
using f32x16=__attribute__((ext_vector_type(16)))float;
using f32x4=__attribute__((ext_vector_type(4)))float;
using u32x4=__attribute__((ext_vector_type(4)))unsigned;
using u32x2=__attribute__((ext_vector_type(2)))unsigned;
constexpr int D=64,DM=HW;
constexpr int NW=8,QBLK=32,QB=QBLK*NW,KVBLK=64;
__device__ __forceinline__ int crow(int r,int hi){return (r&3)+8*(r>>2)+4*hi;}
#define SBAR() __builtin_amdgcn_sched_barrier(0)
__device__ __forceinline__ void cmask(f32x16&p0,f32x16&p1,int jb,int qrel,int hi){
  const float NEG=-INFINITY; const int d=qrel-64*jb-4*hi;
  #pragma unroll
  for(int r=0;r<16;++r){const int c=(r&3)+8*(r>>2); if(c>d)p0[r]=NEG; if(c+32>d)p1[r]=NEG;}
}
__device__ __forceinline__ void addmask(f32x16&p0,f32x16&p1,float addv){
  #pragma unroll
  for(int r=0;r<16;++r){p0[r]+=addv;p1[r]+=addv;}
}
typedef __attribute__((address_space(3))) const char* lds_cptr;
__device__ __forceinline__ float mselect(int m,float v){ return __uint_as_float((__float_as_uint(v)&(unsigned)m)|(0xff800000u&~(unsigned)m)); }
__device__ __forceinline__ void bitmask(f32x16&p0,f32x16&p1,lds_cptr mrow,int t,int hi){
  const u32x2 w=*(const __attribute__((address_space(3))) u32x2*)(mrow+((t>>2)&1)*1024+((t>>1)&1)*512+(t&1)*8);
  const int w0=(int)(w.x>>(4*hi)),w1=(int)(w.y>>(4*hi));
  #pragma unroll
  for(int r=0;r<16;++r){const int bpos=(r&3)+8*(r>>2); p0[r]=mselect(__builtin_amdgcn_sbfe(w0,bpos,1),p0[r]); p1[r]=mselect(__builtin_amdgcn_sbfe(w1,bpos,1),p1[r]);}
}

constexpr int NSLOT=3, SLOTB=8192;
constexpr int LDS_K=0, LDS_V=NSLOT*SLOTB, LDS_WS=2*NSLOT*SLOTB, LDS_OST=LDS_WS+NW*64*4, LDS_MSK=LDS_OST+NW*4096, LDS_BYTES=LDS_MSK+NW*2048;
__device__ __forceinline__ void glds16(const void*gsrc,unsigned lds_dst){unsigned keep;
  asm volatile("s_mov_b32 %0, m0\n\ts_mov_b32 m0, %2\n\ts_nop 0\n\tglobal_load_lds_dwordx4 %1, off\n\ts_mov_b32 m0, %0":"=&s"(keep):"v"(gsrc),"s"(lds_dst):"memory");}
__device__ __forceinline__ float max3f(float a,float b,float c){float r;asm("v_max3_f32 %0, %1, %2, %3":"=v"(r):"v"(a),"v"(b),"v"(c));return r;}
__device__ __forceinline__ float max2f(float a,float b){float r;asm("v_max_f32_e32 %0, %1, %2":"=v"(r):"v"(a),"v"(b));return r;}
__device__ __forceinline__ float fadd_s(float a,float b){float r;asm("v_add_f32_e32 %0, %1, %2":"=v"(r):"v"(a),"v"(b));return r;}
__device__ __forceinline__ float fsub_s(float a,float b){float r;asm("v_sub_f32_e32 %0, %1, %2":"=v"(r):"v"(a),"v"(b));return r;}
typedef float f32x2_t __attribute__((ext_vector_type(2))); typedef __bf16 bf16x2_t __attribute__((ext_vector_type(2)));
__device__ __forceinline__ unsigned cvtpk_s(float lo,float hi){f32x2_t v={lo,hi};bf16x2_t b=__builtin_convertvector(v,bf16x2_t);return __builtin_bit_cast(unsigned,b);}
#define WAIT_BAR(N) asm volatile("s_waitcnt vmcnt(" #N ") lgkmcnt(0)\n\ts_barrier":::"memory")

__device__ __forceinline__ void qkt(f32x16&p0,f32x16&p1,const char*Kslot,const bf16x8*qr,int r32,int hi){
  const f32x16 negm=f32x16{};
  const char*kb=Kslot+hi*1024+r32*16;
  #pragma unroll
  for(int d0=0;d0<4;++d0){
    const bf16x8 b0=*reinterpret_cast<const bf16x8*>(kb+d0*2048);
    const bf16x8 b1=*reinterpret_cast<const bf16x8*>(kb+d0*2048+512);
    if(d0==0){p0=__builtin_amdgcn_mfma_f32_32x32x16_bf16(b0,qr[0],negm,0,0,0);p1=__builtin_amdgcn_mfma_f32_32x32x16_bf16(b1,qr[0],negm,0,0,0);}
    else{p0=__builtin_amdgcn_mfma_f32_32x32x16_bf16(b0,qr[d0],p0,0,0,0);p1=__builtin_amdgcn_mfma_f32_32x32x16_bf16(b1,qr[d0],p1,0,0,0);}}
}
typedef short v4i16_t __attribute__((ext_vector_type(4)));
__device__ __forceinline__ void kload8(bf16x8*kf,lds_cptr kp){
  kf[0]=*(const __attribute__((address_space(3))) bf16x8*)(kp);      kf[1]=*(const __attribute__((address_space(3))) bf16x8*)(kp+512);
  kf[2]=*(const __attribute__((address_space(3))) bf16x8*)(kp+2048); kf[3]=*(const __attribute__((address_space(3))) bf16x8*)(kp+2560);
  kf[4]=*(const __attribute__((address_space(3))) bf16x8*)(kp+4096); kf[5]=*(const __attribute__((address_space(3))) bf16x8*)(kp+4608);
  kf[6]=*(const __attribute__((address_space(3))) bf16x8*)(kp+6144); kf[7]=*(const __attribute__((address_space(3))) bf16x8*)(kp+6656);
}
__device__ __forceinline__ void kload2(bf16x8*kf,lds_cptr kp,int j){ kf[2*j]=*(const __attribute__((address_space(3))) bf16x8*)(kp+j*2048); kf[2*j+1]=*(const __attribute__((address_space(3))) bf16x8*)(kp+j*2048+512); }
__device__ __forceinline__ s16x4 vtr(lds_cptr p){ return __builtin_bit_cast(s16x4,__builtin_amdgcn_ds_read_tr16_b64_v4i16((__attribute__((address_space(3))) v4i16_t*)p)); }
__device__ __forceinline__ float rowmax(const f32x16&p0,const f32x16&p1){
  float a=max3f(p0[0],p0[1],p1[0]),b=max3f(p0[2],p0[3],p1[1]);a=max3f(a,p1[2],p1[3]);
  #pragma unroll
  for(int r=4;r<16;r+=4){a=max3f(a,p0[r],p0[r+1]);b=max3f(b,p0[r+2],p0[r+3]);a=max3f(a,p1[r],p1[r+1]);b=max3f(b,p1[r+2],p1[r+3]);}
  const float m=max2f(a,b);
  auto rr=__builtin_amdgcn_permlane32_swap(__float_as_uint(m),__float_as_uint(m),false,false);
  return max2f(__uint_as_float(rr[0]),__uint_as_float(rr[1]));
}
__device__ __forceinline__ void pv(f32x16*o,int vb,bf16x8 pa0,bf16x8 pa1,bf16x8 pa2,bf16x8 pa3){
  #pragma unroll
  for(int d0=0;d0<2;++d0){s16x4 lo[4],hi[4];
    #pragma unroll
    for(int ks=0;ks<4;++ks){
      asm volatile("ds_read_b64_tr_b16 %0,%1 offset:%c2":"=&v"(lo[ks]):"v"(vb),"i"(d0*4096+ks*1024):"memory");
      asm volatile("ds_read_b64_tr_b16 %0,%1 offset:%c2":"=&v"(hi[ks]):"v"(vb),"i"(d0*4096+ks*1024+512):"memory");}
    asm volatile("s_waitcnt lgkmcnt(0)":::"memory");SBAR();
    #define PK(k) (bf16x8){lo[k][0],lo[k][1],lo[k][2],lo[k][3],hi[k][0],hi[k][1],hi[k][2],hi[k][3]}
    o[d0]=__builtin_amdgcn_mfma_f32_32x32x16_bf16(pa0,PK(0),o[d0],0,0,0);
    o[d0]=__builtin_amdgcn_mfma_f32_32x32x16_bf16(pa1,PK(1),o[d0],0,0,0);
    o[d0]=__builtin_amdgcn_mfma_f32_32x32x16_bf16(pa2,PK(2),o[d0],0,0,0);
    o[d0]=__builtin_amdgcn_mfma_f32_32x32x16_bf16(pa3,PK(3),o[d0],0,0,0);
    #undef PK
  }
}
#ifndef ATTN_STORE16
#define ATTN_STORE16(p,v) (*(u32x4*)(p)=(v))
#endif
__device__ __forceinline__ float bfs(short s){ return __uint_as_float(((unsigned)(unsigned short)s)<<16); }

template<int MODE,int THRL> __device__ __forceinline__ void attn_unit(int b,int h,int qb,const bf16*Q,const bf16*__restrict__ K,const bf16*__restrict__ V,unsigned char*O,char*shm,
                                                                      const float*kbsum,const unsigned long long*maskw,const int tid){
  const int lane=tid&63,r32=lane&31,hi=lane>>5; const int wid=__builtin_amdgcn_readfirstlane(tid>>6);
  const long rowbase=(long)b*SEQ; const int q0=qb*QB;
  const bf16*Qw=Q+(rowbase+q0+wid*QBLK)*DM+h*D;
  const bf16*Kh=K+rowbase*DM+h*D,*Vh=V+rowbase*DM+h*D;
  const unsigned lds0=(unsigned)(uintptr_t)shm;
  float*wsf=(float*)(shm+LDS_WS)+wid*64;
  const unsigned koff=(unsigned)((lane*DM+wid*8)*2);
  const unsigned voff=(unsigned)(((16*(wid&3)+(lane>>2))*DM+(wid>>2)*32+(lane&3)*8)*2);
  const unsigned kdst=lds0+LDS_K+wid*1024, vdst=lds0+LDS_V+wid*1024;
  #define DMA_K(t,slot) glds16((const char*)Kh+(size_t)(t)*(KVBLK*DM*2)+koff,(unsigned)__builtin_amdgcn_readfirstlane(kdst+(slot)))
  #define DMA_V(t,slot) glds16((const char*)Vh+(size_t)(t)*(KVBLK*DM*2)+voff,(unsigned)__builtin_amdgcn_readfirstlane(vdst+(slot)))
  const unsigned long long*mbase=maskw+(size_t)(rowbase+q0+wid*QBLK)*32;
  const unsigned moff=(unsigned)((r32*32+2*hi)*8);
  const unsigned mdst=lds0+LDS_MSK+wid*2048;
  #define DMA_M(tg) glds16((const char*)mbase+(size_t)(32*(tg))+moff,(unsigned)__builtin_amdgcn_readfirstlane(mdst+((tg)&1)*1024))
  const bool usebits=(MODE==1)&&(qb>0);
  const int vb0=(int)(lds0+LDS_V)+((lane>>4)&1)*32+(lane&3)*8+(4*hi+((lane&15)>>2))*64;
  const char*Kbase=shm+LDS_K; bf16x8 kf[8];
  const lds_cptr shm3=(lds_cptr)shm; const lds_cptr kp0=shm3+LDS_K+hi*1024+r32*16; const lds_cptr vp0=shm3+LDS_V+((lane>>4)&1)*32+(lane&3)*8+(4*hi+((lane&15)>>2))*64;
  const lds_cptr mrow=shm3+LDS_MSK+wid*2048+r32*16;
  const int NT=(q0+QB)/KVBLK;
  if(usebits){DMA_M(0);}
  DMA_K(0,0);DMA_V(0,0);DMA_K(1,SLOTB);
  bf16x8 qr[4];
  #pragma unroll
  for(int d0=0;d0<4;++d0)qr[d0]=*reinterpret_cast<const bf16x8*>(&Qw[(long)r32*DM+d0*16+hi*8]);
  unsigned selbits=(1u<<qb)-1u;
  if(MODE==0&&qb>3){
    float g[7];
    #pragma unroll
    for(int j=0;j<7;++j){ g[j]=0.f;
      if(j<qb){ const float*kbp=kbsum+((size_t)(b*NHEAD+h)*8+j)*64+hi*8; float s=0.f;
        #pragma unroll
        for(int d0=0;d0<4;++d0){ const f32x4 k0=*(const f32x4*)(kbp+d0*16),k1=*(const f32x4*)(kbp+d0*16+4);
          s+=bfs(qr[d0][0])*k0[0]+bfs(qr[d0][1])*k0[1]+bfs(qr[d0][2])*k0[2]+bfs(qr[d0][3])*k0[3]+bfs(qr[d0][4])*k1[0]+bfs(qr[d0][5])*k1[1]+bfs(qr[d0][6])*k1[2]+bfs(qr[d0][7])*k1[3]; }
        s+=__shfl_xor(s,32); g[j]=s; } }
    selbits=0u;
    #pragma unroll
    for(int j=0;j<7;++j){ if(j<qb){ int rank=0;
      #pragma unroll
      for(int i=0;i<7;++i){ if(i!=j&&i<qb){ rank+=(g[i]>g[j]||(g[i]==g[j]&&i<j))?1:0; } }
      if(rank<3)selbits|=(1u<<j); } }
  }
  float mhat=0.f,l_reg=0.f;f32x16 o[2];o[0]=f32x16{};o[1]=f32x16{};const f32x16 zero16=f32x16{};
  const int qrel=wid*QBLK+r32;
  #define AMASK_PEEL(P0,P1,t) do{ const int jb_=(t)-(NT-4); \
      if(usebits){ bitmask(P0,P1,mrow,(t),hi); } \
      else if(jb_>=0){ cmask(P0,P1,jb_,qrel,hi); } }while(0)
  #define ADDV_PEEL(t) ((MODE==0&&(t)<NT-4)?(((selbits>>((t)>>2))&1u)?0.f:-INFINITY):0.f)
  #define AMASK_STEADY(P0,P1,t) do{ if(MODE==1){ bitmask(P0,P1,mrow,(t),hi); } }while(0)
  #define ADDV_STEADY(t) ((MODE==0)?(((selbits>>((t)>>2))&1u)?0.f:-INFINITY):0.f)
  #define CMASK(P0,P1,t) AMASK_PEEL(P0,P1,t)
  #define ADDV(t) ADDV_PEEL(t)
  bool resc=false;
  #define START(P0,P1) do{ const float rm=rowmax(P0,P1); resc=false; \
    { const float dl=(rm<-1e30f)?0.f:rm; mhat=fadd_s(mhat,dl); \
      _Pragma("unroll") for(int r=0;r<16;++r){P0[r]=fsub_s(P0[r],dl);P1[r]=fsub_s(P1[r],dl);} } \
    _Pragma("unroll") for(int r=0;r<16;++r)P0[r]=__builtin_amdgcn_exp2f(P0[r]); }while(0)
  #define RESC() do{ if(resc){ asm volatile("s_waitcnt lgkmcnt(0)":::"memory"); \
      _Pragma("unroll") for(int d_=0;d_<2;++d_) _Pragma("unroll") for(int r=0;r<16;++r)o[d_][r]*=wsf[crow(r,hi)]; } }while(0)
  f32x16 pA0,pA1,pB0,pB1;
  int sl_prev=0,sl_cur=0,sl_next=SLOTB;
  #define ROT() do{sl_prev=sl_cur;sl_cur=sl_next;sl_next=(sl_next==(NSLOT-1)*SLOTB)?0:sl_next+SLOTB;}while(0)
  DMA_K(2,2*SLOTB);
  WAIT_BAR(3);
  qkt(pA0,pA1,Kbase,qr,r32,hi);asm volatile("s_nop 15\n\ts_nop 7":"+v"(pA0),"+v"(pA1));CMASK(pA0,pA1,0);
  if(MODE==0){ addmask(pA0,pA1,ADDV(0)); }
  asm volatile("s_nop 7":"+v"(pA0),"+v"(pA1));
  START(pA0,pA1);
  _Pragma("unroll") for(int r=0;r<16;++r)pA1[r]=__builtin_amdgcn_exp2f(pA1[r]);
  WAIT_BAR(0);
  if(usebits&&NT>4){DMA_M(1);}
  DMA_K(3,0);DMA_V(1,SLOTB);
  ROT();
  kload8(kf,kp0+sl_cur);
  WAIT_BAR(2);
  s16x4 vlo[8],vhi[8]; u32x4 pw0,pw1,pw2,pw3;
  #define PKW(P,B) cvtpk_s(P[B],P[B+1])
  #define PAF(k) __builtin_bit_cast(bf16x8,pw##k)
  #define VFR(i) (bf16x8){vlo[i][0],vlo[i][1],vlo[i][2],vlo[i][3],vhi[i][0],vhi[i][1],vhi[i][2],vhi[i][3]}
  #define PIN(x) asm volatile("":"+v"(x))
  #define MX3(a,b,c) __builtin_fmaxf(__builtin_fmaxf((a),(b)),(c))
  #define GAPA(MF,A0,A1,A2,A3,W0,W1,PW) do{ MF; sacc+=A0; sacc+=A1; sacc+=A2; sacc+=A3; PIN(sacc); W0; W1; PIN(PW); SBAR(); }while(0)
  #define EX(v) __builtin_amdgcn_exp2f(v)
  #define GAPB(MF,X,B) do{ MF; X[B]=EX(X[B]); X[B+1]=EX(X[B+1]); X[B+2]=EX(X[B+2]); X[B+3]=EX(X[B+3]); PIN(X); SBAR(); }while(0)
  #define VRD(i) do{ vlo[i]=vtr(vp_+(((i)>>2)*4096+((i)&3)*1024)); vhi[i]=vtr(vp_+(((i)>>2)*4096+((i)&3)*1024+512)); }while(0)
  #define KRD(G,j) do{ if(G){ kload2(kf,kp0+sl_next,j); SBAR(); } }while(0)
  #define STEP(C0,C1,P0,P1,t,GK,GV,GL,GM) do{ SBAR(); \
    const lds_cptr vp_=vp0+sl_prev; \
    VRD(0); SBAR(); float sacc=(P0[0]+P0[1]); \
    GAPA(C0=__builtin_amdgcn_mfma_f32_32x32x16_bf16(kf[0],qr[0],zero16,0,0,0), P0[2],P0[3],P0[4],P0[5],     pw0[0]=PKW(P0,0), pw0[1]=PKW(P0,2), pw0); \
    VRD(4); SBAR(); GAPA(C1=__builtin_amdgcn_mfma_f32_32x32x16_bf16(kf[1],qr[0],zero16,0,0,0), P0[6],P0[7],P0[8],P0[9],     pw0[2]=PKW(P0,4), pw0[3]=PKW(P0,6), pw0); \
    VRD(1); SBAR(); GAPA(C0=__builtin_amdgcn_mfma_f32_32x32x16_bf16(kf[2],qr[1],C0,0,0,0),   P0[10],P0[11],P0[12],P0[13], pw1[0]=PKW(P0,8), pw1[1]=PKW(P0,10), pw1); \
    VRD(5); SBAR(); GAPA(C1=__builtin_amdgcn_mfma_f32_32x32x16_bf16(kf[3],qr[1],C1,0,0,0),   P0[14],P0[15],P1[0],P1[1],   pw1[2]=PKW(P0,12),pw1[3]=PKW(P0,14), pw1); \
    VRD(2); SBAR(); GAPA(C0=__builtin_amdgcn_mfma_f32_32x32x16_bf16(kf[4],qr[2],C0,0,0,0),   P1[2],P1[3],P1[4],P1[5],     pw2[0]=PKW(P1,0), pw2[1]=PKW(P1,2), pw2); \
    VRD(6); SBAR(); GAPA(C1=__builtin_amdgcn_mfma_f32_32x32x16_bf16(kf[5],qr[2],C1,0,0,0),   P1[6],P1[7],P1[8],P1[9],     pw2[2]=PKW(P1,4), pw2[3]=PKW(P1,6), pw2); \
    VRD(3); SBAR(); GAPA(C0=__builtin_amdgcn_mfma_f32_32x32x16_bf16(kf[6],qr[3],C0,0,0,0),   P1[10],P1[11],P1[12],P1[13], pw3[0]=PKW(P1,8), pw3[1]=PKW(P1,10), pw3); \
    VRD(7); SBAR(); GAPA(C1=__builtin_amdgcn_mfma_f32_32x32x16_bf16(kf[7],qr[3],C1,0,0,0),   P1[14],P1[15],0.f,0.f,       pw3[2]=PKW(P1,12),pw3[3]=PKW(P1,14), pw3); \
    l_reg+=sacc; \
    if(GM){DMA_M(((t)>>2)+1);} \
    if(GK){DMA_K((t)+3,sl_cur);} if(GV){DMA_V((t)+1,sl_next);} \
    CMASK(C0,C1,t); \
    { float a=MX3(C0[0],C0[1],C1[0]),b=MX3(C0[2],C0[3],C1[1]); a=MX3(a,C1[2],C1[3]); \
      _Pragma("unroll") for(int r=4;r<16;r+=4){a=MX3(a,C0[r],C0[r+1]);b=MX3(b,C0[r+2],C0[r+3]);a=MX3(a,C1[r],C1[r+1]);b=MX3(b,C1[r+2],C1[r+3]);} \
      float rm=__builtin_fmaxf(a,b); { auto rr=__builtin_amdgcn_permlane32_swap(__float_as_uint(rm),__float_as_uint(rm),false,false); rm=__builtin_fmaxf(__uint_as_float(rr[0]),__uint_as_float(rr[1])); } \
      const float addv_=ADDV(t); rm=(rm+addv_)-mhat; \
      resc=false; \
      if(__builtin_expect(__any(rm>(float)THRL),0)){ const float dl=__builtin_fmaxf(rm,0.f); mhat+=dl; \
        const float f=__builtin_amdgcn_exp2f(-dl); l_reg*=f; if(hi==0)wsf[r32]=f; resc=true; } \
      const float sub_=mhat-addv_; \
      _Pragma("unroll") for(int r=0;r<16;++r){C0[r]-=sub_;C1[r]-=sub_;} } \
    SBAR(); \
    GAPB(o[0]=__builtin_amdgcn_mfma_f32_32x32x16_bf16(PAF(0),VFR(0),o[0],0,0,0), C0,0); \
    GAPB(o[1]=__builtin_amdgcn_mfma_f32_32x32x16_bf16(PAF(0),VFR(4),o[1],0,0,0), C0,4); \
    KRD(GL,0); GAPB(o[0]=__builtin_amdgcn_mfma_f32_32x32x16_bf16(PAF(1),VFR(1),o[0],0,0,0), C0,8); \
    KRD(GL,1); GAPB(o[1]=__builtin_amdgcn_mfma_f32_32x32x16_bf16(PAF(1),VFR(5),o[1],0,0,0), C0,12); \
    KRD(GL,2); GAPB(o[0]=__builtin_amdgcn_mfma_f32_32x32x16_bf16(PAF(2),VFR(2),o[0],0,0,0), C1,0); \
    KRD(GL,3); GAPB(o[1]=__builtin_amdgcn_mfma_f32_32x32x16_bf16(PAF(2),VFR(6),o[1],0,0,0), C1,4); \
    GAPB(o[0]=__builtin_amdgcn_mfma_f32_32x32x16_bf16(PAF(3),VFR(3),o[0],0,0,0), C1,8); \
    GAPB(o[1]=__builtin_amdgcn_mfma_f32_32x32x16_bf16(PAF(3),VFR(7),o[1],0,0,0), C1,12); \
    }while(0)
  int t=1;
  #undef CMASK
  #undef ADDV
  #define CMASK(P0,P1,t) AMASK_STEADY(P0,P1,t)
  #define ADDV(t) ADDV_STEADY(t)
  for(;t+5<NT;t+=2){
    STEP(pB0,pB1,pA0,pA1,t,true,true,true,false);     WAIT_BAR(2); RESC(); ROT();
    STEP(pA0,pA1,pB0,pB1,t+1,true,true,true,(MODE==1&&(((t+1)&3)==0)&&(t+5<NT)));   WAIT_BAR(2); RESC(); ROT();
  }
  #undef CMASK
  #undef ADDV
  #define CMASK(P0,P1,t) AMASK_PEEL(P0,P1,t)
  #define ADDV(t) ADDV_PEEL(t)
  #define ENDW(tt) do{ if((tt)+3<NT){WAIT_BAR(2);} else if((tt)+2<NT){WAIT_BAR(1);} else {WAIT_BAR(0);} }while(0)
  for(;t+1<NT;t+=2){
    STEP(pB0,pB1,pA0,pA1,t,(t+3<NT),(t+1<NT),(t+1<NT),false);       ENDW(t);   RESC(); ROT();
    STEP(pA0,pA1,pB0,pB1,t+1,(t+4<NT),(t+2<NT),(t+2<NT),false);     ENDW(t+1); RESC(); ROT();
  }
  STEP(pB0,pB1,pA0,pA1,NT-1,false,false,false,false); RESC();
  { float sacc=pB0[0]+pB0[1]; _Pragma("unroll") for(int r=2;r<16;++r)sacc+=pB0[r]; _Pragma("unroll") for(int r=0;r<16;++r)sacc+=pB1[r]; l_reg+=sacc;
    pw0=(u32x4){PKW(pB0,0),PKW(pB0,2),PKW(pB0,4),PKW(pB0,6)};pw1=(u32x4){PKW(pB0,8),PKW(pB0,10),PKW(pB0,12),PKW(pB0,14)};pw2=(u32x4){PKW(pB1,0),PKW(pB1,2),PKW(pB1,4),PKW(pB1,6)};pw3=(u32x4){PKW(pB1,8),PKW(pB1,10),PKW(pB1,12),PKW(pB1,14)};
    SBAR(); pv(o,vb0+sl_cur,PAF(0),PAF(1),PAF(2),PAF(3)); }
  #undef PKW
  #undef PAF
  #undef VFR
  #undef PIN
  #undef MX3
  #undef GAPA
  #undef GAPB
  #undef EX
  #undef VRD
  #undef KRD
  #undef STEP
  #undef ENDW
  {auto rr=__builtin_amdgcn_permlane32_swap(__float_as_uint(l_reg),__float_as_uint(l_reg),false,false);l_reg=__uint_as_float(rr[0])+__uint_as_float(rr[1]);}
  if(hi==0)wsf[32+r32]=l_reg;asm volatile("s_waitcnt lgkmcnt(0)":::"memory");
  float rli[16];
  #pragma unroll
  for(int r=0;r<16;++r)rli[r]=__builtin_amdgcn_rcpf(wsf[32+crow(r,hi)]);
  unsigned char*Ow=O+(rowbase+q0+wid*QBLK)*DM+h*D;
  { bf16*stg=(bf16*)(shm+LDS_OST)+wid*2048;
    #pragma unroll
    for(int r=0;r<16;++r){const int orow=crow(r,hi);
      #pragma unroll
      for(int d0=0;d0<2;++d0)stg[orow*64+d0*32+r32]=__float2bfloat16(o[d0][r]*rli[r]);}
    asm volatile("s_waitcnt lgkmcnt(0)":::"memory");
    #pragma unroll
    for(int i=0;i<4;++i){const int row=i*8+(lane>>3),ch=lane&7; const u32x4 v=*(const u32x4*)(stg+row*64+ch*8); u32x2 w;
      w.x=pg8::cvt4_fp8(16.f*__uint_as_float(v.x<<16),16.f*__uint_as_float(v.x&0xffff0000u),16.f*__uint_as_float(v.y<<16),16.f*__uint_as_float(v.y&0xffff0000u));
      w.y=pg8::cvt4_fp8(16.f*__uint_as_float(v.z<<16),16.f*__uint_as_float(v.z&0xffff0000u),16.f*__uint_as_float(v.w<<16),16.f*__uint_as_float(v.w&0xffff0000u));
      *(u32x2*)(Ow+(long)row*DM+ch*8)=w;} }
  asm volatile("s_waitcnt lgkmcnt(0)\n\ts_barrier":::"memory");
  #undef DMA_K
  #undef DMA_V
  #undef DMA_M
  #undef CMASK
  #undef AMASK_PEEL
  #undef AMASK_STEADY
  #undef ADDV
  #undef ADDV_PEEL
  #undef ADDV_STEADY
  #undef START
  #undef RESC
  #undef ROT
}
constexpr int ATTN_LDS_BYTES=LDS_BYTES;
#undef SBAR
#undef WAIT_BAR
}

constexpr int NWAVES = 8;
constexpr size_t MiB = 1u << 20;
constexpr size_t WS_CTL = 0, CTL_ZERO_BYTES = 1 * MiB;
constexpr size_t WS_WIN = 1 * MiB, WS_WA = 13 * MiB, WS_WB = 14 * MiB, WS_WOUT = 15 * MiB, WS_W13 = 17 * MiB, WS_W2 = 81 * MiB;
constexpr size_t WS_WR = 113 * MiB, WS_ROPE = 113 * MiB + 512 * 1024;
constexpr size_t WS_RSTD1 = 114 * MiB, WS_RSTD2 = 114 * MiB + 256 * 1024, WS_KBSUM = 114 * MiB + 512 * 1024;
constexpr size_t WS_KI = 115 * MiB, WS_WI = 123 * MiB, WS_MASK = 125 * MiB, WS_TOK = 141 * MiB, WS_GATE = 149 * MiB;
constexpr size_t WS_RSORT = WS_KI, WS_GSORT = WS_MASK;
constexpr size_t WS_QA = 152 * MiB, WS_KA = 216 * MiB, WS_VA = 280 * MiB, WS_QB = 344 * MiB, WS_KB = 408 * MiB, WS_VB = 472 * MiB, WS_QI = 536 * MiB;
constexpr size_t WS_XB = 600 * MiB, WS_OA = 928 * MiB, WS_OB = 960 * MiB, WS_MIX = 216 * MiB, WS_X1B = 728 * MiB, WS_HID = 856 * MiB, WS_YS = 152 * MiB, WS_END = 1024 * MiB;
constexpr size_t WS_WR8 = 113 * MiB + 256 * 1024;
constexpr size_t WS_X1H = 280 * MiB, WS_X1L = 408 * MiB;
static_assert(WS_HID + (size_t)HID_ROWS * EFF <= WS_OA, "ws map");
constexpr size_t WS_MIX8 = 152 * MiB;
constexpr size_t WS_WIN8 = WS_WIN + 6 * MiB, WS_X8 = 728 * MiB;
static_assert(WS_WIN + (size_t)NINA * DMODEL * 2 <= WS_WIN8 && WS_WIN8 + (size_t)NINB * DMODEL <= WS_WA, "ws map");
constexpr int CW_CNT = 64;
constexpr int CW_BAR = 4096;
constexpr int RING_BYTES = 131072, SCR_BYTES = 132096, MISC_OFF = SCR_BYTES, LDS_BYTES = 155648;
constexpr int QSTG_OFF = MISC_OFF + 4096, QSTG_STRIDE = 1056, WSTG_OFF = QSTG_OFF + 16 * QSTG_STRIDE;
static_assert(WSTG_OFF + 512 <= LDS_BYTES, "lds map");
constexpr int SC_STRIDE = 2052;
static_assert(16 * SC_STRIDE * 4 <= SCR_BYTES && attn_body::ATTN_LDS_BYTES <= RING_BYTES, "lds map");

#define GAS __attribute__((address_space(1)))
#define LAS __attribute__((address_space(3)))
typedef unsigned short bf16;
typedef unsigned v4u __attribute__((ext_vector_type(4)));
typedef unsigned v2u __attribute__((ext_vector_type(2)));
typedef float f32x4 __attribute__((ext_vector_type(4)));
typedef short bf16x8 __attribute__((ext_vector_type(8)));
#define LDS_WAIT() asm volatile("s_waitcnt lgkmcnt(0)" ::: "memory")
__device__ __forceinline__ unsigned f2bf(float f) { unsigned u = __builtin_bit_cast(unsigned, f); return (u + 0x7fffu + ((u >> 16) & 1u)) >> 16; }
__device__ __forceinline__ unsigned pk2(float lo, float hi) { return f2bf(lo) | (f2bf(hi) << 16); }
__device__ __forceinline__ float bf2f(unsigned s) { return __uint_as_float(s << 16); }

#define XB_TMO      128
#define XB_XCNT(j)  (256  + 64 * (j))
#define XB_XSUB(j)  (1280 + 64 * (j))
#define XB_XGEN(j)  (2304 + 64 * (j))
#define XB_TOP      3328
#define XB_TOPGEN   3392
#define XCD_BAR_WORDS 3456
#define XB_SPIN_CAP (1u << 22)
__device__ __forceinline__ unsigned xb_ld(unsigned* p)              { return __hip_atomic_load(p, __ATOMIC_RELAXED, __HIP_MEMORY_SCOPE_AGENT); }
__device__ __forceinline__ unsigned xb_add(unsigned* p, unsigned v) { return __hip_atomic_fetch_add(p, v, __ATOMIC_RELAXED, __HIP_MEMORY_SCOPE_AGENT); }
__device__ __forceinline__ unsigned xb_xcc_id() { return (unsigned)__builtin_amdgcn_s_getreg((3 << 11) | 20) & 0xFu; }
#define XB_SPIN(cond, bar) do { unsigned _sp = 0; while (cond) { __builtin_amdgcn_s_sleep(1); \
    if ((++_sp & 255u) == 0u) { if (xb_ld(&(bar)[XB_TMO])) break; if (_sp > XB_SPIN_CAP) { atomicAdd(&(bar)[XB_TMO], 1u); break; } } } } while (0)
struct XcdBarrier { unsigned* bar; unsigned x; volatile LAS unsigned* st; };
__device__ __forceinline__ XcdBarrier xcd_barrier_post(unsigned* bar, volatile LAS unsigned* st, int tid) {
    XcdBarrier b; b.bar = bar; b.x = xb_xcc_id(); b.st = st;
    if (tid == 0) (void)xb_add(&bar[XB_XCNT(b.x)], 1u);
    return b;
}
__device__ __forceinline__ void xcd_barrier_complete(unsigned* bar, unsigned x, unsigned G, unsigned& nloc, unsigned& nx) {
    unsigned sum, cnt, mine, sp = 0u;
    for (;;) {
        sum = 0u; cnt = 0u; mine = 0u;
#pragma unroll
        for (unsigned j = 0; j < 16; ++j) { const unsigned c = xb_ld(&bar[XB_XCNT(j)]); sum += c; cnt += (c > 0u) ? 1u : 0u; mine = (j == x) ? c : mine; }
        if (sum == G) break;
        __builtin_amdgcn_s_sleep(1);
        if ((++sp & 255u) == 0u) { if (xb_ld(&bar[XB_TMO])) break; if (sp > XB_SPIN_CAP) { atomicAdd(&bar[XB_TMO], 1u); break; } }
    }
    nloc = mine > 0u ? mine : 1u; nx = cnt > 0u ? cnt : 1u;
}
__device__ __forceinline__ void xcd_barrier(const XcdBarrier& b, int tid, unsigned G) {
    asm volatile("s_waitcnt vmcnt(0)" ::: "memory");
    __syncthreads();
    if (tid == 0) {
        unsigned* bar = b.bar;
        __builtin_amdgcn_s_waitcnt(0);
        unsigned nloc = b.st[0], nx = b.st[1];
        if (nloc == 0u) { xcd_barrier_complete(bar, b.x, G, nloc, nx); b.st[0] = nloc; b.st[1] = nx; }
        const unsigned old = xb_add(&bar[XB_XSUB(b.x)], 1u);
        const unsigned gen = old / nloc;
        if (old + 1u == (gen + 1u) * nloc) {
            __builtin_amdgcn_fence(__ATOMIC_RELEASE, "agent");
            asm volatile("s_waitcnt vmcnt(0)" ::: "memory");
            const unsigned og = xb_add(&bar[XB_TOP], 1u);
            const unsigned tg = og / nx;
            if (og + 1u == (tg + 1u) * nx) xb_add(&bar[XB_TOPGEN], 1u);
            else XB_SPIN(xb_ld(&bar[XB_TOPGEN]) == tg, bar);
            __builtin_amdgcn_fence(__ATOMIC_ACQUIRE, "agent");
            xb_add(&bar[XB_XGEN(b.x)], 1u);
            asm volatile("s_waitcnt vmcnt(0)" ::: "memory");
        } else {
            XB_SPIN(xb_ld(&bar[XB_XGEN(b.x)]) == gen, bar);
            __builtin_amdgcn_fence(__ATOMIC_ACQUIRE, "agent");
            asm volatile("s_waitcnt vmcnt(0)" ::: "memory");
        }
    }
    __syncthreads();
}

struct Frame {
    LAS unsigned char* lds; unsigned char* ldsg;
    int tid, lane, wave, vcu, G;
    const float *x, *g_mix, *w_in, *w_pa, *w_pb, *w_out, *g_ffn, *w_group, *b_group, *w_expert, *b_expert, *w1, *w3, *w2, *g_final;
    float* out; unsigned char* ws;
};

__device__ __forceinline__ int lane_id_v() { int l; asm volatile("v_mbcnt_lo_u32_b32 %0, -1, 0\n\tv_mbcnt_hi_u32_b32 %0, -1, %0" : "=v"(l)); return l; }
__device__ __forceinline__ float wave_sum(float v) {
#pragma unroll
    for (int o = 1; o < 64; o <<= 1) v += __shfl_xor(v, o);
    return v;
}

struct P0Item { const float* sp; const float* kscale; bf16* WT; unsigned sstride; int K, nrow0, k0; float mulz; float f8scale; };
__device__ __forceinline__ void p0_load(const P0Item& d, int lane, float (&v)[32], f32x4& g0, f32x4& g1) {
    const int c = lane & 7; g0 = (f32x4){1.f, 1.f, 1.f, 1.f}; g1 = g0;
    if (d.kscale) { g0 = *(const GAS f32x4*)(d.kscale + d.k0 + 8 * c); g1 = *(const GAS f32x4*)(d.kscale + d.k0 + 8 * c + 4); }
#pragma unroll
    for (int i = 0; i < 32; ++i) { const int kk = 2 * i + (lane >> 5); v[i] = d.sp[(size_t)(d.k0 + kk) * d.sstride]; }
}
__device__ __forceinline__ void p0_finish(const P0Item& d, int lane, const float (&v)[32], LAS float* scr, f32x4 g0, f32x4 g1) {
#pragma unroll
    for (int i = 0; i < 32; ++i) { const int kk = 2 * i + (lane >> 5); scr[kk * 33 + (lane & 31)] = v[i] * d.mulz; }
    LDS_WAIT(); asm volatile("" ::: "memory");
    const int c = lane & 7;
    if (d.f8scale != 0.f) { g0 = g0 * d.f8scale; g1 = g1 * d.f8scale;
#pragma unroll
        for (int j = 0; j < 4; ++j) { const int n = (lane >> 3) + 8 * j; const LAS float* s = scr + (8 * c) * 33 + n;
            v2u o; o.x = pg8::cvt4_fp8(s[0 * 33] * g0[0], s[1 * 33] * g0[1], s[2 * 33] * g0[2], s[3 * 33] * g0[3]); o.y = pg8::cvt4_fp8(s[4 * 33] * g1[0], s[5 * 33] * g1[1], s[6 * 33] * g1[2], s[7 * 33] * g1[3]);
            *(GAS v2u*)((unsigned char*)d.WT + (size_t)(d.nrow0 + n) * d.K + d.k0 + 8 * c) = o; }
        LDS_WAIT(); asm volatile("" ::: "memory"); return; }
#pragma unroll
    for (int j = 0; j < 4; ++j) { const int n = (lane >> 3) + 8 * j; const LAS float* s = scr + (8 * c) * 33 + n;
        v4u o; o.x = pk2(s[0 * 33] * g0[0], s[1 * 33] * g0[1]); o.y = pk2(s[2 * 33] * g0[2], s[3 * 33] * g0[3]); o.z = pk2(s[4 * 33] * g1[0], s[5 * 33] * g1[1]); o.w = pk2(s[6 * 33] * g1[2], s[7 * 33] * g1[3]);
        *(GAS v4u*)(d.WT + (size_t)(d.nrow0 + n) * d.K + d.k0 + 8 * c) = o; }
    LDS_WAIT(); asm volatile("" ::: "memory");
}
__device__ __forceinline__ int cmap_in(int np) {
    const int tile = np >> 8, sl = np & 255, bj = sl >> 7, wc = (sl >> 5) & 3, rho = sl & 31;
    if (tile < 14) { const int seg = tile >> 1;
        if (seg == 2 || seg == 5) return (np & ~255) + pg8::perm16(sl);
        return (np & ~255) + 64 * wc + 32 * bj + pg8::perm32(rho); }
    if (tile == 14) { if (wc == 0) return 3584 + 32 * bj + pg8::perm32(rho); if (bj == 0 && wc == 1 && rho < 8) return 3648 + rho; return -1; }
    return 3656 + (tile - 15) * 256 + pg8::perm16(sl);
}
__device__ const double INV_FREQ[32] = {1.0, 0.7498942093324559, 0.5623413251903491, 0.4216965034285822, 0.31622776601683794, 0.23713737056616552, 0.1778279410038923, 0.1333521432163324, 0.09999999999999999, 0.07498942093324558, 0.056234132519034905, 0.042169650342858224, 0.03162277660168379, 0.023713737056616554, 0.01778279410038923, 0.013335214321633239, 0.01, 0.007498942093324559, 0.005623413251903491, 0.004216965034285822, 0.0031622776601683794, 0.002371373705661655, 0.0017782794100389228, 0.0013335214321633238, 0.001, 0.0007498942093324559, 0.000562341325190349, 0.00042169650342858224, 0.00031622776601683794, 0.00023713737056616554, 0.0001778279410038923, 0.0001333521432163324};
__device__ __forceinline__ void sincos_d(double a, float& c, float& s) {
    const double TWO_OVER_PI = 0.63661977236758134308, PIO2_HI = 1.57079632679489655800e+00, PIO2_LO = 6.12323399573676603587e-17;
    const double kf = __builtin_rint(a * TWO_OVER_PI); const long k = (long)kf;
    const double y = (a - kf * PIO2_HI) - kf * PIO2_LO, y2 = y * y;
    const double sp = y * (1.0 + y2 * (-1.0 / 6 + y2 * (1.0 / 120 + y2 * (-1.0 / 5040 + y2 * (1.0 / 362880 + y2 * (-1.0 / 39916800 + y2 * (1.0 / 6227020800.0)))))));
    const double cp = 1.0 + y2 * (-0.5 + y2 * (1.0 / 24 + y2 * (-1.0 / 720 + y2 * (1.0 / 40320 + y2 * (-1.0 / 3628800 + y2 * (1.0 / 479001600.0 + y2 * (-1.0 / 87178291200.0)))))));
    double sv, cv; switch (k & 3) { case 0: sv = sp; cv = cp; break; case 1: sv = cp; cv = -sp; break; case 2: sv = -sp; cv = -cp; break; default: sv = -cp; cv = sp; break; }
    c = (float)cv; s = (float)sv;
}

__device__ __forceinline__ void p0_prologue(Frame& F) {
    unsigned char* ws = F.ws;
    LAS float* scr = (LAS float*)(F.lds + F.wave * 16384);
    const int gw = F.vcu * NWAVES + F.wave, NGW = F.G * NWAVES, lane = F.lane;
    bf16* WinT = (bf16*)(ws + WS_WIN); bf16* WaT = (bf16*)(ws + WS_WA); bf16* WbT = (bf16*)(ws + WS_WB); bf16* WoutT = (bf16*)(ws + WS_WOUT);
    bf16* W13T = (bf16*)(ws + WS_W13); bf16* W2T = (bf16*)(ws + WS_W2);
    constexpr int I_INA = 16 * (NINA / 32), I_INB = 16 * (NINB / 32), I_IN = I_INA + I_INB, I_PA = 8 * 32, I_OUT = 16 * 32, I_13 = 16 * 32 * NEXP, I_2 = 8 * 32 * NEXP;
    constexpr int NITEMS = I_IN + 2 * I_PA + I_OUT;
    (void)I_13; (void)I_2; (void)W13T; (void)W2T;
    auto decode = [&](int it) -> P0Item { P0Item d; d.mulz = 1.0f; d.kscale = nullptr; d.f8scale = 0.f; int r = it;
        if (r < I_IN) { const int part = r >= I_INA ? 1 : 0; if (part) r -= I_INA; const int ng = (part ? NINB : NINA) / 32, nb = r % ng, kb = r / ng;
            const int col = cmap_in(pg8::in_tile_of(part, nb >> 3) * 256 + (nb & 7) * 32 + (lane & 31));
            d.sp = F.w_in + (col >= 0 ? col : 0); d.mulz = col >= 0 ? 1.0f : 0.0f; d.sstride = IN_COLS; d.kscale = F.g_mix; d.K = DMODEL; d.nrow0 = nb * 32; d.k0 = kb * 64;
            if (part) { d.WT = (bf16*)(ws + WS_WIN8); d.f8scale = 32.0f; } else d.WT = WinT; return d; } r -= I_IN;
        if (r < 2 * I_PA) { const bool second = r >= I_PA; if (second) r -= I_PA; const int nb = r % 32, kb = r / 32; const int col = (nb >> 3) * 256 + pg8::perm16((nb & 7) * 32 + (lane & 31));
            d.sp = (second ? F.w_pb : F.w_pa) + col; d.sstride = DMODEL; d.WT = second ? WbT : WaT; d.K = HW; d.f8scale = 16.0f; d.nrow0 = nb * 32; d.k0 = kb * 64; return d; } r -= 2 * I_PA;
        if (r < I_OUT) { const int nb = r % 32, kb = r / 32; d.sp = F.w_out + (nb >> 3) * 256 + pg8::perm16((nb & 7) * 32 + (lane & 31)); d.sstride = DMODEL; d.WT = WoutT; d.K = DMODEL; d.f8scale = 32.0f; d.nrow0 = nb * 32; d.k0 = kb * 64; return d; } r -= I_OUT;
        return d; };
    if (gw < NITEMS) { P0Item dA = decode(gw), dB = dA; float vA[32], vB[32]; f32x4 gA0, gA1, gB0, gB1; p0_load(dA, lane, vA, gA0, gA1);
        for (int it = gw;;) {
            const int itB = it + NGW; const bool hasB = itB < NITEMS; if (hasB) { dB = decode(itB); p0_load(dB, lane, vB, gB0, gB1); }
            p0_finish(dA, lane, vA, scr, gA0, gA1); if (!hasB) break;
            const int itA = itB + NGW; const bool hasA = itA < NITEMS; if (hasA) { dA = decode(itA); p0_load(dA, lane, vA, gA0, gA1); }
            p0_finish(dB, lane, vB, scr, gB0, gB1); if (!hasA) break;
            it = itA; } }
    { bf16* Wh = (bf16*)(ws + WS_WR); bf16* Wl = Wh + 48 * DMODEL;
      for (int i = (F.vcu * NWAVES * 64) + F.tid; i < 48 * DMODEL; i += F.G * NWAVES * 64) { const int n = i / DMODEL, k = i % DMODEL;
          float w = 0.f; if (n < 4) w = F.w_group[k * 4 + n]; else if (n < 36) w = F.w_expert[k * 32 + (n - 4)]; w *= F.g_ffn[k];
          const unsigned h = f2bf(w); const float lo = w - bf2f(h); Wh[i] = (bf16)h; Wl[i] = (bf16)f2bf(lo);
          ((unsigned char*)(ws + WS_WR8))[i] = (unsigned char)(pg8::cvt4_fp8(lo * 16384.0f, 0.f, 0.f, 0.f) & 0xffu); } }
    { bf16* XB = (bf16*)(ws + WS_XB); float* irstd1 = (float*)(ws + WS_RSTD1);
#define P0X_LOAD(V, M0) do { _Pragma("unroll") for (int r = 0; r < 4; ++r) { const GAS f32x4* xr = (const GAS f32x4*)(F.x + (size_t)((M0) + r) * DMODEL) + lane; \
          _Pragma("unroll") for (int j = 0; j < 4; ++j) V[r][j] = xr[64 * j]; } } while (0)
#define P0X_DONE(V, M0) do { _Pragma("unroll") for (int r = 0; r < 4; ++r) { float s = 0.f; \
          _Pragma("unroll") for (int j = 0; j < 4; ++j) s += (V[r][j].x * V[r][j].x + V[r][j].y * V[r][j].y) + (V[r][j].z * V[r][j].z + V[r][j].w * V[r][j].w); \
          s = wave_sum(s); const float irs = sqrtf(s * (1.0f / DMODEL) + RMS_EPS), rs = 1.0f / irs; if (lane == 0) irstd1[(M0) + r] = irs; \
          GAS unsigned long long* o8 = (GAS unsigned long long*)(XB + (size_t)((M0) + r) * DMODEL) + lane; GAS unsigned* q8 = (GAS unsigned*)(ws + WS_X8 + (size_t)((M0) + r) * DMODEL) + lane; \
          _Pragma("unroll") for (int j = 0; j < 4; ++j) { const f32x4 w = V[r][j] * rs; \
              o8[64 * j] = (unsigned long long)pk2(w.x, w.y) | ((unsigned long long)pk2(w.z, w.w) << 32); q8[64 * j] = pg8::cvt4_fp8(w.x, w.y, w.z, w.w); } } } while (0)
      const int mstep = NGW * 4; int m0 = gw * 4;
      if (m0 < T) { f32x4 va[4][4], vb[4][4]; P0X_LOAD(va, m0);
          for (;;) {
              const int m1 = m0 + mstep; const bool h1 = m1 < T; if (h1) P0X_LOAD(vb, m1);
              P0X_DONE(va, m0); if (!h1) break;
              const int m2 = m1 + mstep; const bool h2 = m2 < T; if (h2) P0X_LOAD(va, m2);
              P0X_DONE(vb, m1); if (!h2) break;
              m0 = m2; } }
#undef P0X_LOAD
#undef P0X_DONE
    }
}

__device__ __forceinline__ void p2_kbsum(Frame& F) {
    const bf16* KA = (const bf16*)(F.ws + WS_KA); float* kbsum = (float*)(F.ws + WS_KBSUM);
    const int gw = F.vcu * NWAVES + F.wave, NGW = F.G * NWAVES, lane = F.lane;
    for (int it = gw; it < NBATCH * NHEAD * 8; it += NGW) { const int j = it & 7, h = (it >> 3) & 7, b = it >> 6;
        const bf16* base = KA + ((size_t)(b * SEQ + j * 256 + (lane >> 3))) * HW + h * 64 + (lane & 7) * 8; float s[8];
#pragma unroll
        for (int k = 0; k < 8; ++k) s[k] = 0.f;
#pragma unroll 4
        for (int i = 0; i < 32; ++i) { const v4u w = *(const GAS v4u*)(base + (size_t)i * 8 * HW);
#pragma unroll
            for (int k = 0; k < 4; ++k) { s[2 * k] += bf2f(w[k] & 0xffffu); s[2 * k + 1] += __uint_as_float(w[k] & 0xffff0000u); } }
#pragma unroll
        for (int k = 0; k < 8; ++k) { s[k] += __shfl_xor(s[k], 8); s[k] += __shfl_xor(s[k], 16); s[k] += __shfl_xor(s[k], 32); }
        if (lane < 8) { float* o = kbsum + (size_t)it * 64 + lane * 8; *(f32x4*)o = (f32x4){s[0], s[1], s[2], s[3]}; *(f32x4*)(o + 4) = (f32x4){s[4], s[5], s[6], s[7]}; } }
}

__device__ __forceinline__ int wsum6(int c) { int tot = 0;
#pragma unroll
    for (int b = 0; b < 6; ++b) tot += __popcll(__ballot((c >> b) & 1)) << b;
    return tot; }
__device__ __forceinline__ int sel_cnt_ge(const unsigned (&key)[32], int nq, unsigned cand) { int c = 0;
    const unsigned cs = (unsigned)__builtin_amdgcn_readfirstlane((int)cand);
#pragma unroll
    for (int q = 0; q < 8; ++q) { if (q < nq) { unsigned long long m0, m1, m2, m3;
        asm volatile("v_cmp_le_u32_e64 %0, %4, %5\n\tv_cmp_le_u32_e64 %1, %4, %6\n\tv_cmp_le_u32_e64 %2, %4, %7\n\tv_cmp_le_u32_e64 %3, %4, %8"
                     : "=&s"(m0), "=&s"(m1), "=&s"(m2), "=&s"(m3) : "s"(cs), "v"(key[4 * q]), "v"(key[4 * q + 1]), "v"(key[4 * q + 2]), "v"(key[4 * q + 3]));
        c += (__popcll(m0) + __popcll(m1)) + (__popcll(m2) + __popcll(m3)); } }
    return c; }
#define SEL_CMP4(q) asm volatile("v_cmp_le_u32_e64 %0, %4, %5\n\tv_cmp_le_u32_e64 %1, %4, %6\n\tv_cmp_le_u32_e64 %2, %4, %7\n\tv_cmp_le_u32_e64 %3, %4, %8" \
        : "=&s"(m[q][0]), "=&s"(m[q][1]), "=&s"(m[q][2]), "=&s"(m[q][3]) : "s"(cs), "v"(key[4 * (q)]), "v"(key[4 * (q) + 1]), "v"(key[4 * (q) + 2]), "v"(key[4 * (q) + 3]))
template <int NQ> __device__ __forceinline__ int sel_cnt_ge_t(const unsigned (&key)[32], unsigned cand) {
    const unsigned cs = (unsigned)__builtin_amdgcn_readfirstlane((int)cand); unsigned long long m[NQ][4]; int c = 0;
    SEL_CMP4(0);
#pragma unroll
    for (int q = 0; q < NQ; ++q) { if (q + 1 < NQ) SEL_CMP4(q + 1); c += (__popcll(m[q][0]) + __popcll(m[q][1])) + (__popcll(m[q][2]) + __popcll(m[q][3])); }
    return c; }
template <int NQ> __device__ __forceinline__ void sel_bisect_full(const unsigned (&key)[32], const unsigned M, unsigned& lo, unsigned& hi, int& clo, int& chi, bool& exact) {
    { const unsigned lo0 = (M > (4u << 23)) ? M - (4u << 23) : 0u;
      if (lo0 > 0u) { const int c0 = sel_cnt_ge_t<NQ>(key, lo0); if (c0 >= 256) { lo = lo0; clo = c0; exact = (c0 == 256); } else { hi = lo0; chi = c0; } } }
#pragma unroll 1
    while (!exact && hi - lo > 1u && clo - chi > 64) { const unsigned mid = lo + ((hi - lo) >> 1);
        const int tot = sel_cnt_ge_t<NQ>(key, mid);
        if (tot >= 256) { lo = mid; clo = tot; exact = (tot == 256); } else { hi = mid; chi = tot; } }
}
__device__ __forceinline__ int sel_cnt_eq_lt(const unsigned (&key)[32], int nq, unsigned val, int cx, int lane) { int c = 0;
#pragma unroll
    for (int q = 0; q < 8; ++q) { if (q < nq) {
#pragma unroll
        for (int k = 0; k < 4; ++k) c += __popcll(__ballot(key[4 * q + k] == val && (64 * (4 * q + k) + lane) < cx)); } }
    return c; }
__device__ __forceinline__ unsigned wave_max_u32(unsigned v) {
    int x = (int)v;
    { const int t = __builtin_amdgcn_update_dpp(x, x, 0xB1, 0xF, 0xF, false); x = (int)max((unsigned)x, (unsigned)t); }
    { const int t = __builtin_amdgcn_update_dpp(x, x, 0x4E, 0xF, 0xF, false); x = (int)max((unsigned)x, (unsigned)t); }
    { const int t = __builtin_amdgcn_update_dpp(x, x, 0x141, 0xF, 0xF, false); x = (int)max((unsigned)x, (unsigned)t); }
    { const int t = __builtin_amdgcn_update_dpp(x, x, 0x140, 0xF, 0xF, false); x = (int)max((unsigned)x, (unsigned)t); }
    const unsigned a = (unsigned)__builtin_amdgcn_readlane(x, 0), b = (unsigned)__builtin_amdgcn_readlane(x, 16), c = (unsigned)__builtin_amdgcn_readlane(x, 32), d = (unsigned)__builtin_amdgcn_readlane(x, 48);
    return max(max(a, b), max(c, d));
}
struct SelStep { int b, g, half; };
__device__ __forceinline__ void sel_load_q(Frame& F, const SelStep st, bf16x8 (&bq)[8][2], float (&w8)[8]) {
    const bf16* QI = (const bf16*)(F.ws + WS_QI); const float* WI = (const float*)(F.ws + WS_WI);
    const int qidx = F.lane & 15, kc = F.lane >> 4; const size_t qrow = (size_t)(st.b * SEQ + st.g * 32 + st.half * 16 + qidx);
#pragma unroll
    for (int h = 0; h < 8; ++h) {
#pragma unroll
        for (int ks = 0; ks < 2; ++ks) bq[h][ks] = *(const GAS bf16x8*)(QI + qrow * HW + h * 64 + ks * 32 + kc * 8); }
    const f32x4 a = *(const GAS f32x4*)(WI + qrow * 8), c = *(const GAS f32x4*)(WI + qrow * 8 + 4); w8[0] = a[0]; w8[1] = a[1]; w8[2] = a[2]; w8[3] = a[3]; w8[4] = c[0]; w8[5] = c[1]; w8[6] = c[2]; w8[7] = c[3];
}
__device__ __forceinline__ void sel_stage_q(Frame& F, const SelStep st) {
    const size_t qrow0 = (size_t)(st.b * SEQ + st.g * 32 + st.half * 16); const unsigned lds0 = (unsigned)(uintptr_t)F.lds;
#pragma unroll
    for (int rr = 0; rr < 2; ++rr) { const int row = 2 * F.wave + rr;
        attn_body::glds16((const char*)(F.ws + WS_QI) + (qrow0 + row) * (HW * 2) + F.lane * 16, (unsigned)__builtin_amdgcn_readfirstlane((int)(lds0 + QSTG_OFF + row * QSTG_STRIDE))); }
    if (F.wave == 0 && F.lane < 32) attn_body::glds16((const char*)(F.ws + WS_WI) + qrow0 * 32 + F.lane * 16, (unsigned)__builtin_amdgcn_readfirstlane((int)(lds0 + WSTG_OFF)));
}
__device__ __forceinline__ void sel_load_q_lds(Frame& F, bf16x8 (&bq)[8][2], float (&w8)[8]) {
    const int qidx = F.lane & 15, kc = F.lane >> 4; LAS char* q = (LAS char*)(F.lds + QSTG_OFF + qidx * QSTG_STRIDE + kc * 16);
#pragma unroll
    for (int h = 0; h < 8; ++h) {
#pragma unroll
        for (int ks = 0; ks < 2; ++ks) bq[h][ks] = *(const LAS bf16x8*)(q + h * 128 + ks * 64); }
    const f32x4 a = *(const LAS f32x4*)(F.lds + WSTG_OFF + qidx * 32), c = *(const LAS f32x4*)(F.lds + WSTG_OFF + qidx * 32 + 16); w8[0] = a[0]; w8[1] = a[1]; w8[2] = a[2]; w8[3] = a[3]; w8[4] = c[0]; w8[5] = c[1]; w8[6] = c[2]; w8[7] = c[3];
}
__device__ __forceinline__ void sel_scores(Frame& F, const SelStep st, const bf16x8 (&bq)[8][2], const float (&w8)[8]) {
    const bf16* KI = (const bf16*)(F.ws + WS_KI); LAS float* sc = (LAS float*)F.lds;
    const int lane = F.lane, wave = F.wave, qidx = lane & 15, kc = lane >> 4, b = st.b;
    const int ntg = __builtin_amdgcn_readfirstlane((st.g + 2) >> 1), nsub = ntg * 4;
    const int nit = (nsub + 7) >> 3, ngrp = (nit + 3) >> 2;
    bf16x8 A0[4], A1[4], B0[4], B1[4];
#define SEL_LOADG(X0, X1, gi) do { _Pragma("unroll") for (int u = 0; u < 4; ++u) { int st_ = wave + 8 * (4 * (gi) + u); st_ = st_ < nsub ? st_ : nsub - 1; \
        const bf16* kp_ = KI + (size_t)(b * SEQ + st_ * 16 + qidx) * 64 + kc * 8; X0[u] = *(const GAS bf16x8*)kp_; X1[u] = *(const GAS bf16x8*)(kp_ + 32); } } while (0)
#define SEL_COMPG(X0, X1, gi) do { _Pragma("unroll") for (int u = 0; u < 4; ++u) { const int st_ = wave + 8 * (4 * (gi) + u); if (st_ < nsub) { f32x4 s_ = {0.f, 0.f, 0.f, 0.f}; \
        _Pragma("unroll") for (int h = 0; h < 8; ++h) { f32x4 d_ = __builtin_amdgcn_mfma_f32_16x16x32_bf16(X0[u], bq[h][0], (f32x4){0.f, 0.f, 0.f, 0.f}, 0, 0, 0); \
            d_ = __builtin_amdgcn_mfma_f32_16x16x32_bf16(X1[u], bq[h][1], d_, 0, 0, 0); \
            _Pragma("unroll") for (int k = 0; k < 4; ++k) s_[k] += w8[h] * __int_as_float(max(__float_as_int(d_[k]), 0)); }   \
        *(LAS f32x4*)(sc + qidx * SC_STRIDE + st_ * 16 + 4 * kc) = s_; } } } while (0)
    SEL_LOADG(A0, A1, 0);
    for (int gi = 0; gi < ngrp; gi += 2) {
        if (gi + 1 < ngrp) SEL_LOADG(B0, B1, gi + 1);
        SEL_COMPG(A0, A1, gi);
        if (gi + 1 < ngrp) { if (gi + 2 < ngrp) SEL_LOADG(A0, A1, gi + 2); SEL_COMPG(B0, B1, gi + 1); }
    }
#undef SEL_LOADG
#undef SEL_COMPG
}
__device__ __forceinline__ void sel_rows(Frame& F, const SelStep st) {
    unsigned long long* maskw = (unsigned long long*)(F.ws + WS_MASK); LAS float* sc = (LAS float*)F.lds;
    const int lane = F.lane, wave = F.wave, b = st.b;
    const int ntg = __builtin_amdgcn_readfirstlane((st.g + 2) >> 1), nq = (ntg + 3) >> 2; const int qh = st.g * 32 + st.half * 16;
    LAS int* rowctr = (LAS int*)(F.lds + MISC_OFF + 3072);
    for (;;) { int row_ = 0; if (lane == 0) row_ = __hip_atomic_fetch_add(rowctr, 1, __ATOMIC_RELAXED, __HIP_MEMORY_SCOPE_WORKGROUP);
        const int row = __builtin_amdgcn_readfirstlane(row_); if (row >= 16) break;
        const int t = __builtin_amdgcn_readfirstlane(qh + row);
        unsigned key[32]; unsigned mx = 0u;
#pragma unroll
        for (int q = 0; q < 8; ++q) {
#pragma unroll
            for (int k = 0; k < 4; ++k) key[4 * q + k] = 0u;
            if (q < nq) {
#pragma unroll
                for (int k = 0; k < 4; ++k) { const int j = 4 * q + k; const float v = sc[row * SC_STRIDE + 64 * j + lane]; const unsigned u = __float_as_uint(v);
                    const unsigned kk = (u & 0x80000000u) ? ~u : (u | 0x80000000u); key[j] = (64 * j + lane <= t) ? kk : 0u; mx = max(mx, key[j]); } } }
        const unsigned M = wave_max_u32(mx);
        unsigned lo = 0u, hi = M + 1u; int clo = 1 << 20, chi = 0; bool exact = false;
        switch (nq) { case 2: sel_bisect_full<2>(key, M, lo, hi, clo, chi, exact); break; case 3: sel_bisect_full<3>(key, M, lo, hi, clo, chi, exact); break;
            case 4: sel_bisect_full<4>(key, M, lo, hi, clo, chi, exact); break; case 5: sel_bisect_full<5>(key, M, lo, hi, clo, chi, exact); break;
            case 6: sel_bisect_full<6>(key, M, lo, hi, clo, chi, exact); break; case 7: sel_bisect_full<7>(key, M, lo, hi, clo, chi, exact); break;
            default: sel_bisect_full<8>(key, M, lo, hi, clo, chi, exact); break; }
        if (!exact && hi - lo > 1u) {
            LAS unsigned* cb = (LAS unsigned*)(sc + row * SC_STRIDE); int base = 0; const unsigned wdt = hi - lo;
#pragma unroll
            for (int q = 0; q < 8; ++q) { if (q < nq) {
#pragma unroll
                for (int k = 0; k < 4; ++k) { const int j = 4 * q + k; const bool inb = (key[j] - lo) < wdt; const unsigned long long m = __ballot(inb);
                    const int pos = base + (int)__builtin_amdgcn_mbcnt_hi((unsigned)(m >> 32), __builtin_amdgcn_mbcnt_lo((unsigned)m, 0u));
                    cb[inb ? pos : 64 + lane] = key[j]; base += __popcll(m); } } }
            LDS_WAIT(); asm volatile("" ::: "memory");
            unsigned cand = cb[lane]; LDS_WAIT(); cand = (lane < base) ? cand : 0u;
#pragma unroll 1
            while (!exact && hi - lo > 1u) { const unsigned mid = lo + ((hi - lo) >> 1);
                const int tot = chi + __popcll(__ballot(cand >= mid));
                if (tot >= 256) { lo = mid; exact = (tot == 256); } else hi = mid; } }
        unsigned P; int xcut;
        if (exact) { P = lo - 1u; xcut = -1; }
        else {
            const int need = 256 - sel_cnt_ge(key, nq, lo + 1u); int xx = 0;
#pragma unroll 1
            for (int bit = 10; bit >= 0; --bit) { const int cx = xx | (1 << bit);
                if (sel_cnt_eq_lt(key, nq, lo, cx, lane) < need) xx = cx; }
            P = lo; xcut = xx; }
        int mlo = 0, mhi = 0;
        if (exact) {
            const unsigned cs = (unsigned)__builtin_amdgcn_readfirstlane((int)lo); unsigned long long m[8][4];
#define SEL_WL(q, k) do { const int a_ = (int)(unsigned)m[q][k], b_ = (int)(unsigned)(m[q][k] >> 32); \
                asm volatile("v_writelane_b32 %0, %1, %2" : "+v"(mlo) : "s"(a_), "n"(4 * (q) + (k))); asm volatile("v_writelane_b32 %0, %1, %2" : "+v"(mhi) : "s"(b_), "n"(4 * (q) + (k))); } while (0)
#define SEL_EX4(q) do { if ((q) < nq) { SEL_CMP4(q); SEL_WL(q, 0); SEL_WL(q, 1); SEL_WL(q, 2); SEL_WL(q, 3); } } while (0)
            SEL_EX4(0); SEL_EX4(1); SEL_EX4(2); SEL_EX4(3); SEL_EX4(4); SEL_EX4(5); SEL_EX4(6); SEL_EX4(7);
#undef SEL_EX4
#undef SEL_WL
        } else {
#define SEL_EMIT(j) do { const bool al = (key[j] > P) || (key[j] == P && (64 * (j) + lane) <= xcut); \
            const unsigned long long m = __ballot(al); const int m0_ = (int)(unsigned)m, m1_ = (int)(unsigned)(m >> 32); \
            asm volatile("v_writelane_b32 %0, %1, %2" : "+v"(mlo) : "s"(m0_), "n"(j)); asm volatile("v_writelane_b32 %0, %1, %2" : "+v"(mhi) : "s"(m1_), "n"(j)); } while (0)
#define SEL_EMIT4(q) do { if ((q) < nq) { SEL_EMIT(4 * (q)); SEL_EMIT(4 * (q) + 1); SEL_EMIT(4 * (q) + 2); SEL_EMIT(4 * (q) + 3); } } while (0)
        SEL_EMIT4(0); SEL_EMIT4(1); SEL_EMIT4(2); SEL_EMIT4(3); SEL_EMIT4(4); SEL_EMIT4(5); SEL_EMIT4(6); SEL_EMIT4(7);
#undef SEL_EMIT4
#undef SEL_EMIT
        }
        if (lane < 32) maskw[(size_t)(b * SEQ + t) * 32 + lane] = ((unsigned long long)(unsigned)mhi << 32) | (unsigned long long)(unsigned)mlo;
    }
}
constexpr int MW_I13 = 16 * 32 * NEXP, MW_I2 = 8 * 32 * NEXP, MW_ITEMS = MW_I13 + MW_I2;
struct MwItem { const float* sp; unsigned sstride; unsigned char* wt; const float* ks; float f8; };
__device__ __forceinline__ MwItem mw_decode(Frame& F, int it, int lane) { MwItem d; asm volatile("" : "+v"(lane));
    const int h = lane >> 5;
    if (it < MW_I13) { const int e = it / 512, r = it % 512, nb = r % 32, kb = r / 32;
        d.sp = (((nb >> 2) & 1) ? F.w3 : F.w1) + (size_t)e * DMODEL * EFF + 128 * (nb >> 3) + 32 * (nb & 3) + pg8::perm32(lane & 31) + (size_t)(kb * 64 + 32 * h) * EFF; d.sstride = EFF;
        d.wt = F.ws + WS_W13 + (size_t)e * 1024 * DMODEL + (size_t)(nb * 32 + (lane & 31)) * DMODEL + kb * 64 + 32 * h; d.ks = F.g_ffn + kb * 64; d.f8 = 32.0f; }
    else { const int r0 = it - MW_I13, e = r0 / 256, r = r0 % 256, nb = r % 32, kb = r / 32; const int col = (nb >> 3) * 256 + pg8::perm16((nb & 7) * 32 + (lane & 31));
        d.sp = F.w2 + (size_t)e * EFF * DMODEL + col + (size_t)(kb * 64 + 32 * h) * DMODEL; d.sstride = DMODEL;
        d.wt = F.ws + WS_W2 + (size_t)e * DMODEL * EFF + (size_t)(nb * 32 + (lane & 31)) * EFF + kb * 64 + 32 * h; d.ks = nullptr; d.f8 = 16.0f; }
    return d; }
__device__ __forceinline__ void mw_load(const MwItem& d, int lane, float (&v)[32], float& gv) {
#pragma unroll
    for (int i = 0; i < 32; ++i) v[i] = d.sp[(size_t)i * d.sstride];
    gv = d.ks ? d.ks[lane] : 1.0f; }
__device__ __forceinline__ void mw_finish(const MwItem& d, int lane, const float (&v)[32], float gv) {
    asm volatile("" : "+v"(lane)); const int src = (lane & 32); gv *= d.f8; unsigned w[8];
#pragma unroll
    for (int c = 0; c < 8; ++c) { float t[4];
#pragma unroll
        for (int k = 0; k < 4; ++k) t[k] = v[4 * c + k] * __shfl(gv, src + 4 * c + k);
        w[c] = pg8::cvt4_fp8(t[0], t[1], t[2], t[3]); }
    v4u o0, o1; o0.x = w[0]; o0.y = w[1]; o0.z = w[2]; o0.w = w[3]; o1.x = w[4]; o1.y = w[5]; o1.z = w[6]; o1.w = w[7];
    *(GAS v4u*)d.wt = o0; *(GAS v4u*)(d.wt + 16) = o1; }
__device__ __forceinline__ void p2_select(Frame& F) {
    const int nitems = (F.G == 256) ? 7 : ((NBATCH * 56 - F.vcu + F.G - 1) / F.G), nsteps = 2 * nitems;
    auto decode = [&](int s) -> SelStep { SelStep st; const int r = s >> 1; st.half = s & 1;
        if (F.G == 256) { st.b = F.vcu >> 3; const int c = F.vcu & 7; st.g = 8 + 8 * r + ((r & 1) ? 7 - c : c); }
        else { const int I = F.vcu + r * F.G; st.b = I / 56; st.g = 8 + I % 56; }
        return st; };
    if (nsteps <= 0) return;
    const int gw = F.vcu * NWAVES + F.wave, NGW = F.G * NWAVES;
    sel_stage_q(F, decode(0)); asm volatile("s_waitcnt vmcnt(0)" ::: "memory"); __syncthreads();
    for (int s = 0; s < nsteps; ++s) {
        { int l_ = F.lane; asm volatile("" : "+v"(l_)); F.lane = l_; }
        const SelStep st = decode(s); bf16x8 qA[8][2]; float wA[8];
        const int mit = gw + NGW * s; const bool mw = mit < MW_ITEMS; float mv[32], mg = 1.0f;
        if (F.tid == 0) *(LAS int*)(F.lds + MISC_OFF + 3072) = 0;
        sel_load_q_lds(F, qA, wA); sel_scores(F, st, qA, wA); __syncthreads();
        if (s + 1 < nsteps) sel_stage_q(F, decode(s + 1));
        if (mw) { const MwItem md = mw_decode(F, mit, F.lane); mw_load(md, F.lane, mv, mg); }
        sel_rows(F, st);
        if (mw) { const MwItem md = mw_decode(F, mit, F.lane); mw_finish(md, F.lane, mv, mg); }
        asm volatile("s_waitcnt vmcnt(0)" ::: "memory");
        __syncthreads(); }
    for (int mit = gw + NGW * nsteps; mit < MW_ITEMS; mit += NGW) { float mv[32], mg; const MwItem md = mw_decode(F, mit, F.lane); mw_load(md, F.lane, mv, mg); mw_finish(md, F.lane, mv, mg); }
}

__device__ __forceinline__ void p6_router(Frame& F, bool dummy) {
    const bf16* XH = (const bf16*)(F.ws + WS_X1H); const unsigned char* XL = (const unsigned char*)(F.ws + WS_X1L); float* rstd2 = (float*)(F.ws + WS_RSTD2);
    const bf16* Wh = (const bf16*)(F.ws + WS_WR); const bf16* Wl = Wh + 48 * DMODEL;
    int* tokl = (int*)(F.ws + WS_TOK); float* gate = (float*)(F.ws + WS_GATE); unsigned* gcnt = (unsigned*)(F.ws + WS_CTL) + CW_CNT + (dummy ? 32 : 0);
    LAS float* lg = (LAS float*)F.lds + F.wave * (16 * 48);
    LAS int* hist = (LAS int*)(F.lds + 32768); LAS int* base = hist + 32;
    LAS int* aE = (LAS int*)(F.lds + 36864); LAS int* aP = aE + 512; LAS float* aG = (LAS float*)(aP + 512); LAS float* aR = aG + 512;
    float* rsort = (float*)(F.ws + WS_RSORT); float* gsort = (float*)(F.ws + WS_GSORT);
    const int lane = F.lane, wave = F.wave, tk = lane & 15, kc = lane >> 4;
    constexpr int WLDS_OFF = 49152, WLDS_STRIDE = 2080;
    { LAS char* wl_ = (LAS char*)(F.lds + WLDS_OFF);
      for (int i = F.tid; i < 37 * 128; i += NWAVES * 64) { const int row = i >> 7, ch = i & 127; v4u v = {0u, 0u, 0u, 0u};
          if (row < 36) v = *(const GAS v4u*)((const GAS char*)Wh + (size_t)(row * 2048 + ch * 16));
          *(LAS v4u*)(wl_ + row * WLDS_STRIDE + ch * 16) = v; } }
    for (int st = F.vcu; st < T / 256; st += F.G) {
        if (F.tid < 32) hist[F.tid] = 0;
        __syncthreads();
        const int rbase = st * 256 + wave * 32;
        f32x4 acc[2][3], accs[2];
#pragma unroll
        for (int tt = 0; tt < 2; ++tt) { accs[tt] = (f32x4){0.f, 0.f, 0.f, 0.f};
#pragma unroll
            for (int nt = 0; nt < 3; ++nt) acc[tt][nt] = (f32x4){0.f, 0.f, 0.f, 0.f}; }
        unsigned w8o[3], xof[2], lof[2]; const unsigned char* W8 = (const unsigned char*)(F.ws + WS_WR8);
#pragma unroll
        for (int nt = 0; nt < 3; ++nt) { w8o[nt] = (unsigned)((nt * 16 + tk) * DMODEL + kc * 8); asm volatile("" : "+v"(w8o[nt])); }
#pragma unroll
        for (int tt = 0; tt < 2; ++tt) { lof[tt] = (unsigned)((rbase + tt * 16 + tk) * DMODEL + kc * 8); xof[tt] = lof[tt] * 2u; asm volatile("" : "+v"(xof[tt])); asm volatile("" : "+v"(lof[tt])); }
        bf16x8 whA[3]; v2u w80[3], w81[3], w82[3], w83[3], w84[3], w85[3], w86[3], w87[3]; bf16x8 xh0[2], xh1[2], xh2[2], xh3[2], xh4[2], xh5[2], xh6[2], xh7[2]; v2u xl0[2], xl1[2], xl2[2], xl3[2], xl4[2], xl5[2], xl6[2], xl7[2];
#define P6_LOADW(WH, kk) do { _Pragma("unroll") for (int nt = 0; nt < 3; ++nt) WH[nt] = *(const LAS bf16x8*)(F.lds + (WLDS_OFF + ((nt * 16 + tk) < 36 ? (nt * 16 + tk) : 36) * WLDS_STRIDE + kc * 16) + (kk) * 64); } while (0)
#define P6_LOADWL(W8r, kk) do { _Pragma("unroll") for (int nt = 0; nt < 3; ++nt) W8r[nt] = *(const GAS v2u*)((const GAS char*)W8 + (size_t)(w8o[nt] + (unsigned)((kk) * 32))); } while (0)
#define P6_LOADX(XHr, XLr, kk) do { _Pragma("unroll") for (int tt = 0; tt < 2; ++tt) { \
            XHr[tt] = *(const GAS bf16x8*)((const GAS char*)XH + (size_t)(xof[tt] + (unsigned)((kk) * 64))); XLr[tt] = *(const GAS v2u*)((const GAS char*)XL + (size_t)(lof[tt] + (unsigned)((kk) * 32))); } } while (0)
#define P6_COMP(WH, W8r, XHr, XLr, kk) do { bf16x8 WL[3]; \
        _Pragma("unroll") for (int nt = 0; nt < 3; ++nt) { typedef float v2f_ __attribute__((ext_vector_type(2))); const v2u l8 = W8r[nt]; v4u lw_; \
            const v2f_ a0 = __builtin_amdgcn_cvt_pk_f32_fp8((int)l8.x, false), a1 = __builtin_amdgcn_cvt_pk_f32_fp8((int)l8.x, true), c0 = __builtin_amdgcn_cvt_pk_f32_fp8((int)l8.y, false), c1 = __builtin_amdgcn_cvt_pk_f32_fp8((int)l8.y, true); \
            lw_.x = pg8::cvt_pk_bf16(a0.x * (1.0f / 16384.0f), a0.y * (1.0f / 16384.0f)); lw_.y = pg8::cvt_pk_bf16(a1.x * (1.0f / 16384.0f), a1.y * (1.0f / 16384.0f)); \
            lw_.z = pg8::cvt_pk_bf16(c0.x * (1.0f / 16384.0f), c0.y * (1.0f / 16384.0f)); lw_.w = pg8::cvt_pk_bf16(c1.x * (1.0f / 16384.0f), c1.y * (1.0f / 16384.0f)); WL[nt] = __builtin_bit_cast(bf16x8, lw_); } \
        _Pragma("unroll") for (int tt = 0; tt < 2; ++tt) { const bf16x8 xh = XHr[tt]; bf16x8 xl; \
            { typedef float v2f_ __attribute__((ext_vector_type(2))); const v2u l8 = XLr[tt]; v4u lw_; \
              const v2f_ a0 = __builtin_amdgcn_cvt_pk_f32_fp8((int)l8.x, false), a1 = __builtin_amdgcn_cvt_pk_f32_fp8((int)l8.x, true), c0 = __builtin_amdgcn_cvt_pk_f32_fp8((int)l8.y, false), c1 = __builtin_amdgcn_cvt_pk_f32_fp8((int)l8.y, true); \
              lw_.x = pg8::cvt_pk_bf16(a0.x * (1.0f / 512.0f), a0.y * (1.0f / 512.0f)); lw_.y = pg8::cvt_pk_bf16(a1.x * (1.0f / 512.0f), a1.y * (1.0f / 512.0f)); \
              lw_.z = pg8::cvt_pk_bf16(c0.x * (1.0f / 512.0f), c0.y * (1.0f / 512.0f)); lw_.w = pg8::cvt_pk_bf16(c1.x * (1.0f / 512.0f), c1.y * (1.0f / 512.0f)); xl = __builtin_bit_cast(bf16x8, lw_); } \
            accs[tt] = __builtin_amdgcn_mfma_f32_16x16x32_bf16(xh, xh, accs[tt], 0, 0, 0); \
            _Pragma("unroll") for (int nt = 0; nt < 3; ++nt) { \
                acc[tt][nt] = __builtin_amdgcn_mfma_f32_16x16x32_bf16(WH[nt], xh, acc[tt][nt], 0, 0, 0); \
                acc[tt][nt] = __builtin_amdgcn_mfma_f32_16x16x32_bf16(WL[nt], xh, acc[tt][nt], 0, 0, 0); \
                acc[tt][nt] = __builtin_amdgcn_mfma_f32_16x16x32_bf16(WH[nt], xl, acc[tt][nt], 0, 0, 0); } } } while (0)
        P6_LOADWL(w80, 0); P6_LOADX(xh0, xl0, 0); P6_LOADWL(w81, 1); P6_LOADX(xh1, xl1, 1); P6_LOADWL(w82, 2); P6_LOADX(xh2, xl2, 2); P6_LOADWL(w83, 3); P6_LOADX(xh3, xl3, 3);
        P6_LOADWL(w84, 4); P6_LOADX(xh4, xl4, 4); P6_LOADWL(w85, 5); P6_LOADX(xh5, xl5, 5); P6_LOADWL(w86, 6); P6_LOADX(xh6, xl6, 6);
#define P6_SLOT(WHc, WHn, W8c, W8n, XHc, XLc, XHn, XLn, k) do { P6_LOADW(whA, k); if ((k) + 7 < 32) { P6_LOADWL(W8n, (k) + 7); P6_LOADX(XHn, XLn, (k) + 7); } P6_COMP(whA, W8c, XHc, XLc, k); } while (0)
#pragma unroll 1
        for (int kk = 0; kk < 32; kk += 8) {
            P6_SLOT(whA, whA, w80, w87, xh0, xl0, xh7, xl7, kk);     P6_SLOT(whA, whA, w81, w80, xh1, xl1, xh0, xl0, kk + 1);
            P6_SLOT(whA, whA, w82, w81, xh2, xl2, xh1, xl1, kk + 2); P6_SLOT(whA, whA, w83, w82, xh3, xl3, xh2, xl2, kk + 3);
            P6_SLOT(whA, whA, w84, w83, xh4, xl4, xh3, xl3, kk + 4); P6_SLOT(whA, whA, w85, w84, xh5, xl5, xh4, xl4, kk + 5);
            P6_SLOT(whA, whA, w86, w85, xh6, xl6, xh5, xl5, kk + 6); P6_SLOT(whA, whA, w87, w86, xh7, xl7, xh6, xl6, kk + 7);
        }
#undef P6_SLOT
#undef P6_LOADW
#undef P6_LOADWL
#undef P6_LOADX
#undef P6_COMP
        for (int tt = 0; tt < 2; ++tt) { const int r0 = rbase + tt * 16;
            const f32x4 dg = tt == 0 ? accs[0] : accs[1]; const int rsel = tk & 3;
            float sst = rsel == 0 ? dg[0] : rsel == 1 ? dg[1] : rsel == 2 ? dg[2] : dg[3]; sst = (kc == (tk >> 2)) ? sst : 0.f;
            sst += __shfl_xor(sst, 16); sst += __shfl_xor(sst, 32);
            const float rs = 1.0f / sqrtf(sst * (1.0f / DMODEL) + RMS_EPS);
#pragma unroll
            for (int nt = 0; nt < 3; ++nt)
#pragma unroll
                for (int k = 0; k < 4; ++k) lg[tk * 48 + nt * 16 + 4 * kc + k] = (tt == 0 ? acc[0][nt][k] : acc[1][nt][k]) * rs;
            LDS_WAIT(); asm volatile("" ::: "memory");
            if (lane < 16) { const int tokid = r0 + lane; rstd2[tokid] = rs; aR[wave * 32 + tt * 16 + lane] = rs;
                const LAS float* L = lg + lane * 48;
                float gl[4];
#pragma unroll
                for (int k = 0; k < 4; ++k) gl[k] = L[k] + F.b_group[k];
                int gs = 0; float gm = gl[0];
#pragma unroll
                for (int k = 1; k < 4; ++k) if (gl[k] > gm) { gm = gl[k]; gs = k; }
                float gz = 0.f;
#pragma unroll
                for (int k = 0; k < 4; ++k) gz += __expf(gl[k] - gm);
                const float gwt = 1.0f / gz;
                float el[8];
#pragma unroll
                for (int k = 0; k < 8; ++k) el[k] = L[4 + 8 * gs + k] + F.b_expert[8 * gs + k];
                int ia = 0; float ea = el[0];
#pragma unroll
                for (int k = 1; k < 8; ++k) if (el[k] > ea) { ea = el[k]; ia = k; }
                int ib = -1; float eb = -INFINITY;
#pragma unroll
                for (int k = 0; k < 8; ++k) if (k != ia && el[k] > eb) { eb = el[k]; ib = k; }
                const float pa = 1.0f, pb = __expf(eb - ea); const float inv = gwt / (pa + pb);
                const int e0 = 8 * gs + ia, e1 = 8 * gs + ib;
                const int l0 = __hip_atomic_fetch_add(hist + e0, 1, __ATOMIC_RELAXED, __HIP_MEMORY_SCOPE_WORKGROUP);
                const int l1 = __hip_atomic_fetch_add(hist + e1, 1, __ATOMIC_RELAXED, __HIP_MEMORY_SCOPE_WORKGROUP);
                const int ai = (wave * 32 + tt * 16 + lane) * 2;
                aE[ai] = e0; aP[ai] = l0; aG[ai] = pa * inv; aE[ai + 1] = e1; aP[ai + 1] = l1; aG[ai + 1] = pb * inv; }
            LDS_WAIT(); asm volatile("" ::: "memory");
        }
        __syncthreads();
        { int t32 = F.tid; asm volatile("" : "+v"(t32)); if (t32 < 32) base[t32] = (int)__hip_atomic_fetch_add(gcnt + t32, (unsigned)hist[t32], __ATOMIC_RELAXED, __HIP_MEMORY_SCOPE_AGENT); }
        __syncthreads();
        { int ai = F.tid; asm volatile("" : "+v"(ai));
          const int e = aE[ai]; const int pos = base[e] + aP[ai]; const int ts = (st * 256) * 2 + ai;
          tokl[(size_t)e * 65536 + pos] = ts; gate[ts] = aG[ai]; if (!dummy) { rsort[(size_t)e * 65536 + pos] = aR[ai >> 1]; gsort[(size_t)e * 65536 + pos] = aG[ai]; } }
        __syncthreads();
    }
}

__device__ __forceinline__ void p9_final(Frame& F, bool dummy) {
    const unsigned char* YS = (const unsigned char*)(F.ws + WS_YS); const int gw = F.vcu * NWAVES + F.wave, NGW = F.G * NWAVES, lane = F.lane;
    f32x4 gf[4];
#pragma unroll
    for (int j = 0; j < 4; ++j) gf[j] = *((const GAS f32x4*)F.g_final + lane + 64 * j);
    float* dst = dummy ? (float*)(F.ws + WS_XB) : F.out;
    for (int m = gw; m < T; m += NGW) { const GAS v2u* xr = (const GAS v2u*)(F.ws + WS_X1H + (size_t)m * DMODEL * 2) + lane; GAS f32x4* xw = (GAS f32x4*)(dst + (size_t)m * DMODEL) + lane;
        const GAS unsigned* y0 = (const GAS unsigned*)(YS + (size_t)(2 * m) * DMODEL) + lane; const GAS unsigned* y1 = (const GAS unsigned*)(YS + (size_t)(2 * m + 1) * DMODEL) + lane;
        f32x4 v[4]; float s = 0.f;
#pragma unroll
        for (int j = 0; j < 4; ++j) { const v2u hx = xr[64 * j]; v[j] = (f32x4){__uint_as_float(hx.x << 16), __uint_as_float(hx.x & 0xffff0000u), __uint_as_float(hx.y << 16), __uint_as_float(hx.y & 0xffff0000u)}; const unsigned a = y0[64 * j], c = y1[64 * j];
            typedef float v2f_ __attribute__((ext_vector_type(2)));
            const v2f_ a0 = __builtin_amdgcn_cvt_pk_f32_fp8((int)a, false), a1 = __builtin_amdgcn_cvt_pk_f32_fp8((int)a, true), c0 = __builtin_amdgcn_cvt_pk_f32_fp8((int)c, false), c1 = __builtin_amdgcn_cvt_pk_f32_fp8((int)c, true);
            v[j].x += (a0.x + c0.x) * (1.0f / 16.0f); v[j].y += (a0.y + c0.y) * (1.0f / 16.0f); v[j].z += (a1.x + c1.x) * (1.0f / 16.0f); v[j].w += (a1.y + c1.y) * (1.0f / 16.0f);
            s += (v[j].x * v[j].x + v[j].y * v[j].y) + (v[j].z * v[j].z + v[j].w * v[j].w); }
        s = wave_sum(s); const float rs = 1.0f / sqrtf(s * (1.0f / DMODEL) + RMS_EPS);
#pragma unroll
        for (int j = 0; j < 4; ++j) xw[64 * j] = v[j] * rs * gf[j]; }
}

template <class T_> struct KArgPtr { typedef T_ V; typedef const V __attribute__((address_space(4)))* type; };
struct Args { const float* in[15]; float* out; unsigned char* ws; int ph_lo, ph_hi; };
static_assert(sizeof(Args) == 144 && offsetof(Args, out) == 120 && offsetof(Args, ws) == 128 && offsetof(Args, ph_lo) == 136, "Args layout is read by offset (KARG)");
constexpr int N_PHASES = 10;

__global__ void __launch_bounds__(NWAVES * 64, 2) skel_fwd(Args args) {
    extern __shared__ __attribute__((aligned(16))) unsigned char lds[];
    Frame F;
    F.lds = (LAS unsigned char*)lds; F.ldsg = lds;
    F.wave = __builtin_amdgcn_readfirstlane(threadIdx.x >> 6); F.lane = lane_id_v(); F.tid = F.wave * 64 + F.lane;
    F.G = gridDim.x; { const int bx = blockIdx.x; F.vcu = (F.G % 8 == 0) ? (bx % 8) * (F.G / 8) + bx / 8 : bx; }
    typedef __attribute__((address_space(4))) const char* kptr_t;
    kptr_t ka = (kptr_t)__builtin_amdgcn_kernarg_segment_ptr();
#define KARG(T_, off) (*(KArgPtr<T_>::type)(ka + (off)))
#define LOADARGS() do { asm volatile("" : "+s"(ka)); \
    F.x = KARG(const float*, 0); F.g_mix = KARG(const float*, 8); F.w_in = KARG(const float*, 16); F.w_pa = KARG(const float*, 24); F.w_pb = KARG(const float*, 32); F.w_out = KARG(const float*, 40); \
    F.g_ffn = KARG(const float*, 48); F.w_group = KARG(const float*, 56); F.b_group = KARG(const float*, 64); F.w_expert = KARG(const float*, 72); F.b_expert = KARG(const float*, 80); \
    F.w1 = KARG(const float*, 88); F.w3 = KARG(const float*, 96); F.w2 = KARG(const float*, 104); F.g_final = KARG(const float*, 112); F.out = KARG(float*, 120); F.ws = KARG(unsigned char*, 128); ws = F.ws; \
    F.lane = lane_id_v(); F.tid = F.wave * 64 + F.lane; } while (0)
    unsigned char* ws;
    const int lo = KARG(int, 136), hi = KARG(int, 140);
    LOADARGS();
    for (int u = F.tid; u < (LDS_BYTES - MISC_OFF) / 4; u += NWAVES * 64) ((LAS unsigned*)(F.lds + MISC_OFF))[u] = 0u;
    __syncthreads();
    XcdBarrier bar = xcd_barrier_post((unsigned*)(ws + WS_CTL) + CW_BAR, (volatile LAS unsigned*)(F.lds + MISC_OFF + 1024), F.tid);
    cg::grid_group grid = cg::this_grid();
#define FRESH() LOADARGS()
#ifndef PHASE_MASK
#define PHASE_MASK 0x3ff
#endif
#define IN(k) (((PHASE_MASK >> (k)) & 1) && lo <= (k) && (k) < hi)
#ifndef DUP_PHASE
#define DUP_PHASE -1
#endif
#define REPS(k) for (int rep_ = 0, nrep_ = ((k) == DUP_PHASE ? 2 : 1); rep_ < nrep_; ++rep_, (rep_ < nrep_ ? (xcd_barrier(bar, F.tid, (unsigned)F.G), 0) : 0))
#define DUMMY() (rep_ + 1 < nrep_)
#define SEAM(k) do { if (IN(k) && IN((k) + 1)) { if ((k) == 0 && lo < 0) { grid.sync(); } xcd_barrier(bar, F.tid, (unsigned)F.G); } } while (0)

    if (IN(0)) REPS(0) { FRESH(); p0_prologue(F); }
    SEAM(0);
    if (IN(1)) REPS(1) {
        FRESH(); unsigned char* sga = (unsigned char*)F.out; unsigned char* sgb = sga + (size_t)T * DMODEL;
        { pg8::GmPlain g{(const char*)(ws + WS_XB), (const char*)(ws + WS_WIN), DMODEL};
          pg8::StaticOrder S; S.init(T, NINA, F.G, (int)blockIdx.x);
          pg8::EpiIn<0> E{
                     (bf16*)(ws + WS_QA), (bf16*)(ws + WS_KA), (bf16*)(ws + WS_VA), (bf16*)(ws + WS_QB), (bf16*)(ws + WS_KB), (bf16*)(ws + WS_VB), (bf16*)(ws + WS_QI), (bf16*)(ws + WS_KI),
                     (float*)(ws + WS_WI), sga, sgb};
          pg8::gemm_phase(F.lds, g, S, E, F.tid); }
        FRESH();
        { unsigned char* sga2 = (unsigned char*)F.out; unsigned char* sgb2 = sga2 + (size_t)T * DMODEL;
          pg8::GmPlainF8 g{(const char*)(ws + WS_X8), (const char*)(ws + WS_WIN8), DMODEL};
          pg8::StaticOrder S; S.init(T, NINB, F.G, (int)blockIdx.x);
          pg8::EpiIn<1> E{
                     (bf16*)(ws + WS_QA), (bf16*)(ws + WS_KA), (bf16*)(ws + WS_VA), (bf16*)(ws + WS_QB), (bf16*)(ws + WS_KB), (bf16*)(ws + WS_VB), (bf16*)(ws + WS_QI), (bf16*)(ws + WS_KI),
                     (float*)(ws + WS_WI), sga2, sgb2};
          pg8::gemm_phase(F.lds, g, S, E, F.tid); }
    }
    SEAM(1);
    if (IN(2)) REPS(2) { FRESH(); p2_kbsum(F); p2_select(F); }
    SEAM(2);
    if (IN(3)) REPS(3) {
        FRESH(); using namespace attn_body;
        const float* kbsum = (const float*)(ws + WS_KBSUM); const unsigned long long* maskw = (const unsigned long long*)(ws + WS_MASK);
        for (int bh = F.vcu; bh < NBATCH * NHEAD; bh += F.G) { const int b = bh >> 3, h = bh & 7;
            for (int i = 0; i < 8; ++i) { const int qb = (i & 1) ? (i >> 1) : 7 - (i >> 1);
                attn_unit<0, 8>(b, h, qb, (const attn_body::bf16*)(ws + WS_QA), (const attn_body::bf16*)(ws + WS_KA), (const attn_body::bf16*)(ws + WS_VA), (unsigned char*)(ws + WS_OA), (char*)lds, kbsum, maskw, F.tid); }
            for (int i = 0; i < 8; ++i) { const int qb = (i & 1) ? (i >> 1) : 7 - (i >> 1);
                attn_unit<1, 8>(b, h, qb, (const attn_body::bf16*)(ws + WS_QB), (const attn_body::bf16*)(ws + WS_KB), (const attn_body::bf16*)(ws + WS_VB), (unsigned char*)(ws + WS_OB), (char*)lds, kbsum, maskw, F.tid); } }
    }
    SEAM(3);
    if (IN(4)) REPS(4) {
        FRESH(); unsigned char* sga = (unsigned char*)F.out; unsigned char* sgb = sga + (size_t)T * DMODEL;
        { pg8::GmPlainF8 g{(const char*)(ws + WS_OA), (const char*)(ws + WS_WA), HW}; pg8::StaticOrder S; S.init(T, DMODEL, F.G, (int)blockIdx.x);
          pg8::EpiGate<true> E{sga, (unsigned char*)(ws + WS_MIX), (unsigned char*)(ws + WS_MIX8)}; pg8::gemm_phase(F.lds, g, S, E, F.tid); }
        { pg8::GmPlainF8 g{(const char*)(ws + WS_OB), (const char*)(ws + WS_WB), HW}; pg8::StaticOrder S; S.init(T, DMODEL, F.G, (int)blockIdx.x);
          pg8::EpiGate<false> E{sgb, (unsigned char*)(ws + WS_MIX), (unsigned char*)(ws + WS_MIX8)}; pg8::gemm_phase(F.lds, g, S, E, F.tid); }
    }
    SEAM(4);
    if (IN(5)) REPS(5) {
        FRESH();
        pg8::GmPlainF8 g{(const char*)(ws + WS_MIX8), (const char*)(ws + WS_WOUT), DMODEL}; pg8::StaticOrder S; S.init(T, DMODEL, F.G, (int)blockIdx.x);
        pg8::EpiRes E{(const bf16*)(ws + WS_XB), (const float*)(ws + WS_RSTD1), (bf16*)(ws + WS_X1H), (unsigned char*)(ws + WS_X1L), (unsigned char*)(ws + WS_X1B)}; pg8::gemm_phase(F.lds, g, S, E, F.tid);
    }
    SEAM(5);
    if (IN(6)) REPS(6) { FRESH(); p6_router(F, DUMMY()); }
    SEAM(6);
    LAS int* tstart = (LAS int*)(F.lds + MISC_OFF); LAS int* ecnt = tstart + 64;
    if (IN(7) || IN(8)) {
        FRESH();
        const unsigned* gcnt = (const unsigned*)(ws + WS_CTL) + CW_CNT;
        if (F.tid < 32) ecnt[F.tid] = (int)__hip_atomic_load(gcnt + F.tid, __ATOMIC_RELAXED, __HIP_MEMORY_SCOPE_AGENT);
        __syncthreads();
        if (F.tid == 0) { int s = 0; for (int e = 0; e < NEXP; ++e) { tstart[e] = s; s += (ecnt[e] + 255) >> 8; } tstart[NEXP] = s; }
        __syncthreads();
    }
    if (IN(7)) REPS(7) {
        FRESH();
        pg8::GmMoe1F8 g{(const char*)(ws + WS_X1B), (const char*)(ws + WS_W13), (const int*)(ws + WS_TOK), DMODEL};
        pg8::MoeOrder S{tstart, ecnt, 4, F.G, (int)blockIdx.x};
        pg8::EpiSwiGlu E{(const float*)(ws + WS_RSORT), (unsigned char*)(ws + WS_HID)};
        pg8::gemm_phase(F.lds, g, S, E, F.tid);
    }
    SEAM(7);
    if (IN(8)) REPS(8) {
        FRESH();
        pg8::GmMoe2F8 g{(const char*)(ws + WS_HID), (const char*)(ws + WS_W2), EFF};
        pg8::MoeOrder S{tstart, ecnt, 4, F.G, (int)blockIdx.x};
        pg8::EpiDown E{(const int*)(ws + WS_TOK), (const float*)(ws + WS_GSORT), (unsigned char*)(ws + WS_YS)};
        pg8::gemm_phase(F.lds, g, S, E, F.tid);
    }
    SEAM(8);
    if (IN(9)) REPS(9) { FRESH(); p9_final(F, DUMMY()); }
#undef IN
#undef SEAM
}

extern "C" void kernel_launch(void* const* d_in, const int* in_sizes, int n_in, void* d_out, int out_size, void* d_ws, size_t ws_size, hipStream_t stream) {
    static int grid = 0;
    if (grid == 0) {
        if (n_in != 15 || in_sizes[0] != T * DMODEL || out_size != T * DMODEL || ws_size < WS_END) {
            fprintf(stderr, "kernel_launch: unexpected shapes: n_in %d in0 %d out %d ws %zu (need >= %zu)\n", n_in, n_in > 0 ? in_sizes[0] : -1, out_size, ws_size, (size_t)WS_END); grid = -1; return; }
        int dev = 0, cus = 0, per_cu = 0;
        if (hipGetDevice(&dev) != hipSuccess || hipDeviceGetAttribute(&cus, hipDeviceAttributeMultiprocessorCount, dev) != hipSuccess) { grid = -1; return; }
        if (hipFuncSetAttribute((const void*)skel_fwd, hipFuncAttributeMaxDynamicSharedMemorySize, LDS_BYTES) != hipSuccess) { fprintf(stderr, "kernel_launch: hipFuncSetAttribute failed\n"); grid = -1; return; }
        if (hipOccupancyMaxActiveBlocksPerMultiprocessor(&per_cu, (const void*)skel_fwd, NWAVES * 64, LDS_BYTES) != hipSuccess || per_cu < 1) { fprintf(stderr, "kernel_launch: occupancy query says %d blocks per CU\n", per_cu); grid = -1; (void)hipGetLastError(); return; }
        grid = cus;
    }
    if (grid < 0) return;
    (void)hipMemsetAsync((char*)d_ws + WS_CTL, 0, CTL_ZERO_BYTES, stream);
    Args a{};
    for (int i = 0; i < 15; ++i) a.in[i] = (const float*)d_in[i];
    a.out = (float*)d_out; a.ws = (unsigned char*)d_ws;
#if MK_N_LAUNCHES == 1
    a.ph_lo = 0; a.ph_hi = N_PHASES;
    { void* kargs[] = {&a}; hipError_t e = hipLaunchCooperativeKernel((const void*)skel_fwd, dim3(grid), dim3(NWAVES * 64), kargs, LDS_BYTES, stream);
      if (e != hipSuccess) fprintf(stderr, "kernel_launch: cooperative launch failed: %s (grid %d)\n", hipGetErrorString(e), grid); }
#else
    for (int p = 0; p < N_PHASES; ++p) { a.ph_lo = p; a.ph_hi = p + 1; hipLaunchKernelGGL(skel_fwd, dim3(grid), dim3(NWAVES * 64), LDS_BYTES, stream, a); }
#endif
}
```

```cpp
#include <hip/hip_runtime.h>
#include <hip/hip_cooperative_groups.h>
#include <hip/hip_bf16.h>
#include <cstdio>
#include <cstdint>
#include <cstddef>
#include <cmath>
namespace cg = cooperative_groups;

#ifndef MK_N_LAUNCHES
#define MK_N_LAUNCHES 1
#endif

constexpr int NBATCH = 32, SEQ = 2048, DMODEL = 1024, T = NBATCH * SEQ;
constexpr int NHEAD = 8, HD = 64, HW = NHEAD * HD;
constexpr int IN_COLS = 5704, NINA = 768, NINB = 5120;
constexpr int NEXP = 32, EFF = 512;
constexpr float RMS_EPS = 1e-6f;
constexpr float IDX_SCALE = 0.044194173824159216f;
constexpr float C2 = 0.125f * 1.4426950408889634f;
constexpr int HID_ROWS = 131072 + 8192;

namespace pg8 {
#define PG8_LAS __attribute__((address_space(3)))
typedef unsigned short bf16_t;
typedef short bf16x8 __attribute__((ext_vector_type(8)));
typedef float f32x4 __attribute__((ext_vector_type(4)));
typedef unsigned u32x4 __attribute__((ext_vector_type(4)));
typedef unsigned u32x2 __attribute__((ext_vector_type(2)));
constexpr int BM = 256, BK = 64, HALF = 128, HTB = HALF * BK * 2, STAGE_BYTES = 8 * HTB, NXCD = 8, WGM = 8;

__host__ __device__ __forceinline__ int lds_byte(int r, int c) { const int st = (r >> 4) * 2 + (c >> 5), rr = r & 15, cc = c & 31, ob = rr * 64 + cc * 2; return st * 1024 + (ob ^ (((ob >> 9) & 1) << 5)); }
__host__ __device__ __forceinline__ void stage_rc(int b, int& R, int& C) { const int st = b / 1024, sb = b % 1024, swz = sb ^ (((sb >> 9) & 1) << 5); R = (st >> 1) * 16 + swz / 64; C = (st & 1) * 32 + (swz % 64) / 2; }
__host__ __device__ __forceinline__ int perm32(int rho) { const int n = rho >> 4, i = rho & 15; return 8 * (i >> 2) + 4 * n + (i & 3); }

typedef int v8i __attribute__((ext_vector_type(8)));
__host__ __device__ __forceinline__ int swz8(int r) { return (((r >> 1) & 3) << 5) ^ (((r >> 3) & 1) << 4); }
__host__ __device__ __forceinline__ int lds_byte8(int r, int cb) { return r * 128 + (cb ^ swz8(r)); }
__host__ __device__ __forceinline__ void stage_rc8(int b, int& R, int& Cb) { R = b >> 7; Cb = (b & 127) ^ swz8(R); }
constexpr int F8_SCALE1 = 0x7f7f7f7f;
__host__ __device__ __forceinline__ int perm16(int s) { return 64 * ((s >> 5) & 3) + 16 * ((s >> 2) & 3) + 8 * (s >> 7) + 4 * ((s >> 4) & 1) + (s & 3); }
struct Unit { int pm, pn, e, lt, cnt; };

struct StaticOrder {
    int nM, nN, nwg, G, c;
    __device__ void init(int M, int N, int G_, int c_) { nM = M / BM; nN = N / BM; nwg = nM * nN; G = G_; c = c_; }
    __device__ bool next(int i, Unit& u) const {
        const long L = (long)i * G + c; if (L >= nwg) return false;
        int wgid = (int)L; { const int q = nwg / NXCD, r = nwg % NXCD, xcd = wgid % NXCD, off = wgid / NXCD; wgid = (xcd < r ? xcd * (q + 1) : r * (q + 1) + (xcd - r) * q) + off; }
        const int nig = WGM * nN, gid = wgid / nig, fm = gid * WGM, gsz = (nM - fm) < WGM ? (nM - fm) : WGM;
        u.pm = fm + ((wgid % nig) % gsz); u.pn = (wgid % nig) / gsz; u.e = 0; u.lt = 0; u.cnt = 0; return true;
    }
};
struct MoeOrder {
    const PG8_LAS int* tstart; const PG8_LAS int* cnt; int nN, G, c;
    __device__ bool next(int i, Unit& u) const {
        const long L = (long)i * G + c; const int ntiles = tstart[NEXP];
        if (L >= (long)ntiles * nN) return false;
        const int pm = (int)(L / nN); u.pm = pm; u.pn = (int)(L % nN);
        int e = 0;
#pragma unroll 1
        for (int j = 1; j < NEXP; ++j) e = (tstart[j] <= pm) ? j : e;
        u.e = e; u.lt = pm - tstart[e]; u.cnt = cnt[e]; return true;
    }
};

__device__ __forceinline__ unsigned cvt_pk_bf16(float lo, float hi) { typedef float f2 __attribute__((ext_vector_type(2))); typedef __bf16 b2 __attribute__((ext_vector_type(2))); f2 v = {lo, hi}; b2 b = __builtin_convertvector(v, b2); return __builtin_bit_cast(unsigned, b); }
__device__ __forceinline__ float bf2f(unsigned short s) { return __uint_as_float((unsigned)s << 16); }

struct GmPlain {
    static constexpr bool FP8 = false;
    const char* A; const char* Bt; int K;
    __device__ __forceinline__ const char* abase() const { return A; }
    __device__ __forceinline__ void offs(const Unit& u, const int (&R)[2], const int (&C)[2], unsigned (&o)[2][2]) const {
#pragma unroll
        for (int h = 0; h < 2; ++h)
#pragma unroll
            for (int i = 0; i < 2; ++i) o[h][i] = (unsigned)(((u.pm * 256 + h * 128 + R[i]) * K + C[i]) * 2);
    }
    __device__ __forceinline__ const char* bptr(const Unit& u) const { return Bt + (size_t)u.pn * 256 * K * 2; }
};
struct GmMoe1 {
    static constexpr bool FP8 = false;
    const char* A; const char* Bt; const int* tok; int K;
    __device__ __forceinline__ const char* abase() const { return A; }
    __device__ __forceinline__ void offs(const Unit& u, const int (&R)[2], const int (&C)[2], unsigned (&o)[2][2]) const {
#pragma unroll
        for (int h = 0; h < 2; ++h)
#pragma unroll
            for (int i = 0; i < 2; ++i) { int r = u.lt * 256 + h * 128 + R[i]; r = r < u.cnt ? r : u.cnt - 1; const int ts = tok[(size_t)u.e * 65536 + r]; o[h][i] = (unsigned)((((ts >> 1)) * K + C[i]) * 2); }
    }
    __device__ __forceinline__ const char* bptr(const Unit& u) const { return Bt + ((size_t)u.e * 1024 + (size_t)u.pn * 256) * K * 2; }
};
struct GmMoe2 {
    static constexpr bool FP8 = false;
    const char* A; const char* Bt; int K;
    __device__ __forceinline__ const char* abase() const { return A; }
    __device__ __forceinline__ void offs(const Unit& u, const int (&R)[2], const int (&C)[2], unsigned (&o)[2][2]) const {
#pragma unroll
        for (int h = 0; h < 2; ++h)
#pragma unroll
            for (int i = 0; i < 2; ++i) o[h][i] = (unsigned)(((u.pm * 256 + h * 128 + R[i]) * K + C[i]) * 2);
    }
    __device__ __forceinline__ const char* bptr(const Unit& u) const { return Bt + ((size_t)u.e * 1024 + (size_t)u.pn * 256) * K * 2; }
};

struct GmMoe1F8 {
    static constexpr bool FP8 = true;
    const char* A; const char* Bt; const int* tok; int K;
    __device__ __forceinline__ const char* abase() const { return A; }
    __device__ __forceinline__ void offs(const Unit& u, const int (&R)[2], const int (&C)[2], unsigned (&o)[2][2]) const {
#pragma unroll
        for (int h = 0; h < 2; ++h)
#pragma unroll
            for (int i = 0; i < 2; ++i) { int r = u.lt * 256 + h * 128 + R[i]; r = r < u.cnt ? r : u.cnt - 1; const int ts = tok[(size_t)u.e * 65536 + r]; o[h][i] = (unsigned)((ts >> 1) * K + C[i]); }
    }
    __device__ __forceinline__ const char* bptr(const Unit& u) const { return Bt + ((size_t)u.e * 1024 + (size_t)u.pn * 256) * K; }
};
struct GmPlainF8 {
    static constexpr bool FP8 = true;
    const char* A; const char* Bt; int K;
    __device__ __forceinline__ const char* abase() const { return A; }
    __device__ __forceinline__ void offs(const Unit& u, const int (&R)[2], const int (&C)[2], unsigned (&o)[2][2]) const {
#pragma unroll
        for (int h = 0; h < 2; ++h)
#pragma unroll
            for (int i = 0; i < 2; ++i) o[h][i] = (unsigned)((u.pm * 256 + h * 128 + R[i]) * K + C[i]);
    }
    __device__ __forceinline__ const char* bptr(const Unit& u) const { return Bt + (size_t)u.pn * 256 * K; }
};
struct GmMoe2F8 {
    static constexpr bool FP8 = true;
    const char* A; const char* Bt; int K;
    __device__ __forceinline__ const char* abase() const { return A; }
    __device__ __forceinline__ void offs(const Unit& u, const int (&R)[2], const int (&C)[2], unsigned (&o)[2][2]) const {
#pragma unroll
        for (int h = 0; h < 2; ++h)
#pragma unroll
            for (int i = 0; i < 2; ++i) o[h][i] = (unsigned)((u.pm * 256 + h * 128 + R[i]) * K + C[i]);
    }
    __device__ __forceinline__ const char* bptr(const Unit& u) const { return Bt + ((size_t)u.e * 1024 + (size_t)u.pn * 256) * K; }
};
__device__ __forceinline__ unsigned cvt4_fp8(float a, float b, float c, float d) { int w = 0; w = __builtin_amdgcn_cvt_pk_fp8_f32(a, b, w, false); w = __builtin_amdgcn_cvt_pk_fp8_f32(c, d, w, true); return (unsigned)w; }


__host__ __device__ __forceinline__ int in_tile_of(int part, int p) { return part == 0 ? (p < 2 ? 12 + p : 14) : (p < 12 ? p : p + 3); }
__device__ __forceinline__ size_t pairaddr(int row, int col) { return ((size_t)(row >> 1) << 11) + (size_t)(((col >> 6) << 7) + ((row & 1) << 6) + (col & 63)); }
template <int PART> struct EpiIn {
    bf16_t *qa, *ka, *va, *qb, *kb, *vb, *qi, *ki; float* wi; unsigned char *sga, *sgb;
    static constexpr float ASCALE = PART == 0 ? 1.0f : (1.0f / 32.0f);
    __device__ __forceinline__ void rope_rows(const f32x4 (&acc)[2][2][4][2], bf16_t* dst, int pitch, int rowb, int fq, float sc) const {
        constexpr float B8[8] = {0.15915494309189535f, 0.11934937021124886f, 0.08949940160889101f, 0.06711508300522726f, 0.050329212104487035f, 0.03774158471741977f, 0.0283021958306234f, 0.02122365276477766f};
        const float dec = fq == 0 ? 1.0f : fq == 1 ? 0.1f : fq == 2 ? 0.01f : 0.001f; const int j0 = 8 * fq;
        f32x4 c4[2][2], s4[2][2], cr[2], sr[2];
        const float p0 = (float)(rowb & (SEQ - 1)), p1 = (float)((rowb + HALF) & (SEQ - 1));
#pragma unroll
        for (int n = 0; n < 2; ++n)
#pragma unroll
            for (int k = 0; k < 4; ++k) { const float w = dec * B8[4 * n + k];
                const float r16 = __builtin_amdgcn_fractf(16.0f * w); cr[n][k] = __builtin_amdgcn_cosf(r16); sr[n][k] = __builtin_amdgcn_sinf(r16);
                const float ra = __builtin_amdgcn_fractf(p0 * w); c4[0][n][k] = __builtin_amdgcn_cosf(ra); s4[0][n][k] = __builtin_amdgcn_sinf(ra);
                const float rb = __builtin_amdgcn_fractf(p1 * w); c4[1][n][k] = __builtin_amdgcn_cosf(rb); s4[1][n][k] = __builtin_amdgcn_sinf(rb); }
#pragma unroll
        for (int ai = 0; ai < 2; ++ai) {
#pragma unroll
            for (int m = 0; m < 4; ++m) { const int row = rowb + ai * HALF + m * 16;
                u32x4 a, b;
#pragma unroll
                for (int n = 0; n < 2; ++n) { const f32x4 c = c4[ai][n], sn = s4[ai][n];
                    const f32x4 x1 = acc[ai][0][m][n] * sc, x2 = acc[ai][1][m][n] * sc; const f32x4 o1 = x1 * c - x2 * sn, o2 = x1 * sn + x2 * c;
                    a[2 * n] = cvt_pk_bf16(o1[0], o1[1]); a[2 * n + 1] = cvt_pk_bf16(o1[2], o1[3]); b[2 * n] = cvt_pk_bf16(o2[0], o2[1]); b[2 * n + 1] = cvt_pk_bf16(o2[2], o2[3]);
                    c4[ai][n] = c * cr[n] - sn * sr[n]; s4[ai][n] = sn * cr[n] + c * sr[n]; }
                bf16_t* p = dst + (size_t)row * pitch + j0; *(u32x4*)p = a; *(u32x4*)(p + 32) = b; } }
    }
    __device__ __forceinline__ void operator()(const f32x4 (&acc)[2][2][4][2], const Unit& u, int wr, int wc, int fr, int fq) const {
        const int pn = in_tile_of(PART, u.pn); const int rowb = u.pm * BM + wr * 64 + fr;
        if (pn < 14) {
            const int seg = pn >> 1;
            if (seg == 2 || seg == 5) {
                bf16_t* dst = (seg == 2) ? va : vb; const int colb = (pn & 1) * 256 + wc * 64 + 16 * fq;
#pragma unroll
                for (int ai = 0; ai < 2; ++ai) {
#pragma unroll
                    for (int m = 0; m < 4; ++m) { const int row = rowb + ai * HALF + m * 16; const float r = ASCALE;
#pragma unroll
                        for (int bj = 0; bj < 2; ++bj) { const f32x4 v0 = acc[ai][bj][m][0] * r, v1 = acc[ai][bj][m][1] * r; u32x4 w;
                            w.x = cvt_pk_bf16(v0[0], v0[1]); w.y = cvt_pk_bf16(v0[2], v0[3]); w.z = cvt_pk_bf16(v1[0], v1[1]); w.w = cvt_pk_bf16(v1[2], v1[3]);
                            *(u32x4*)(dst + (size_t)row * HW + colb + bj * 8) = w; } } }
            } else {
                bf16_t* dst = (seg == 0) ? qa : (seg == 1) ? ka : (seg == 3) ? qb : (seg == 4) ? kb : qi;
                const float sc = ((seg == 0 || seg == 3) ? C2 : 1.0f) * ASCALE; const int head = 4 * (pn & 1) + wc;
                rope_rows(acc, dst + head * 64, HW, rowb, fq, sc);
            }
        } else if (pn == 14) {
            if (wc == 0) rope_rows(acc, ki, 64, rowb, fq, 1.0f);
            else if (wc == 1 && fq < 2) {
#pragma unroll
                for (int ai = 0; ai < 2; ++ai)
#pragma unroll
                    for (int m = 0; m < 4; ++m) { const int row = rowb + ai * HALF + m * 16; const float r = IDX_SCALE;
                        *(f32x4*)(wi + (size_t)row * 8 + 4 * fq) = acc[ai][0][m][0] * r; }
            }
        } else {
            const int gi = pn - 15; unsigned char* dst = (gi < 4) ? sga : sgb; const int colb = (gi & 3) * 256 + wc * 64 + 16 * fq;
#pragma unroll
            for (int ai = 0; ai < 2; ++ai) {
#pragma unroll
                for (int m = 0; m < 4; ++m) { const int row = rowb + ai * HALF + m * 16; const float r = -1.4426950408889634f * ASCALE; u32x4 w;
#pragma unroll
                    for (int bj = 0; bj < 2; ++bj)
#pragma unroll
                        for (int n = 0; n < 2; ++n) { f32x4 v = acc[ai][bj][m][n] * r;
#pragma unroll
                            for (int k = 0; k < 4; ++k) v[k] = 256.0f * __builtin_amdgcn_rcpf(1.0f + __builtin_amdgcn_exp2f(v[k]));
                            w[2 * bj + n] = cvt4_fp8(v[0], v[1], v[2], v[3]); }
                    *(u32x4*)(dst + pairaddr(row, colb)) = w; } }
        }
    }
};
template <bool FIRST> struct EpiGate {
    const unsigned char* sg; unsigned char* tmp; unsigned char* out8;
    __device__ __forceinline__ void operator()(const f32x4 (&acc)[2][2][4][2], const Unit& u, int wr, int wc, int fr, int fq) const {
        typedef float v2f_ __attribute__((ext_vector_type(2)));
        const int rowb = u.pm * BM + wr * 64 + fr, colb = u.pn * BM + wc * 64 + 16 * fq;
#pragma unroll
        for (int ai = 0; ai < 2; ++ai) { u32x4 g[4], pv[4];
#pragma unroll
            for (int m = 0; m < 4; ++m) { const size_t off = pairaddr(rowb + ai * HALF + m * 16, colb);
                g[m] = *(const u32x4*)(sg + off); if (!FIRST) pv[m] = *(const u32x4*)(tmp + off); else pv[m] = (u32x4){0u, 0u, 0u, 0u}; }
#pragma unroll
            for (int m = 0; m < 4; ++m) { const int row = rowb + ai * HALF + m * 16; const size_t off = FIRST ? pairaddr(row, colb) : (size_t)row * DMODEL + colb; u32x4 w;
#pragma unroll
                for (int bj = 0; bj < 2; ++bj)
#pragma unroll
                    for (int n = 0; n < 2; ++n) { const f32x4 a = acc[ai][bj][m][n] * (32.0f / 65536.0f); const int q = 2 * bj + n;
                        const v2f_ g0 = __builtin_amdgcn_cvt_pk_f32_fp8((int)g[m][q], false), g1 = __builtin_amdgcn_cvt_pk_f32_fp8((int)g[m][q], true);
                        const v2f_ p0 = __builtin_amdgcn_cvt_pk_f32_fp8((int)pv[m][q], false), p1 = __builtin_amdgcn_cvt_pk_f32_fp8((int)pv[m][q], true);
                        w[q] = cvt4_fp8(a[0] * g0.x + p0.x, a[1] * g0.y + p0.y, a[2] * g1.x + p1.x, a[3] * g1.y + p1.y); }
                *(u32x4*)((FIRST ? tmp : out8) + off) = w; } }
    }
};
struct EpiRes {
    const bf16_t* xb; const float* irstd; bf16_t* xh; unsigned char* xl; unsigned char* xq;
    __device__ __forceinline__ void operator()(const f32x4 (&acc)[2][2][4][2], const Unit& u, int wr, int wc, int fr, int fq) const {
        const int rowb = u.pm * BM + wr * 64 + fr, colb = u.pn * BM + wc * 64 + 16 * fq;
#pragma unroll
        for (int ai = 0; ai < 2; ++ai) { u32x4 bs[4][2]; float ir[4];
#pragma unroll
            for (int m = 0; m < 4; ++m) { const int row = rowb + ai * HALF + m * 16; const size_t off = (size_t)row * DMODEL + colb; ir[m] = irstd[row];
#pragma unroll
                for (int bj = 0; bj < 2; ++bj) bs[m][bj] = *(const u32x4*)(xb + off + bj * 8); }
#pragma unroll
            for (int m = 0; m < 4; ++m) { const size_t off = (size_t)(rowb + ai * HALF + m * 16) * DMODEL + colb; u32x4 hw[2], lw, qw;
#pragma unroll
                for (int bj = 0; bj < 2; ++bj)
#pragma unroll
                    for (int n = 0; n < 2; ++n) { float qv[4], lo[4];
#pragma unroll
                        for (int q = 0; q < 2; ++q) { const unsigned xw = bs[m][bj][2 * n + q];
                            const float v0 = __uint_as_float(xw << 16) * ir[m] + acc[ai][bj][m][n][2 * q] * (1.0f / 1024.0f), v1 = __uint_as_float(xw & 0xffff0000u) * ir[m] + acc[ai][bj][m][n][2 * q + 1] * (1.0f / 1024.0f);
                            const unsigned h = cvt_pk_bf16(v0, v1); qv[2 * q] = v0; qv[2 * q + 1] = v1; hw[bj][2 * n + q] = h;
                            lo[2 * q] = (v0 - __uint_as_float(h << 16)) * 512.0f; lo[2 * q + 1] = (v1 - __uint_as_float(h & 0xffff0000u)) * 512.0f; }
                        qw[2 * bj + n] = cvt4_fp8(qv[0], qv[1], qv[2], qv[3]); lw[2 * bj + n] = cvt4_fp8(lo[0], lo[1], lo[2], lo[3]); }
                *(u32x4*)(xh + off) = hw[0]; *(u32x4*)(xh + off + 8) = hw[1]; *(u32x4*)(xl + off) = lw; *(u32x4*)(xq + off) = qw; } }
    }
};
struct EpiSwiGlu {
    const float* rsort; unsigned char* hid;
    __device__ __forceinline__ void operator()(const f32x4 (&acc)[2][2][4][2], const Unit& u, int wr, int wc, int fr, int fq) const {
        float rr[2][4];
#pragma unroll
        for (int ai = 0; ai < 2; ++ai)
#pragma unroll
            for (int m = 0; m < 4; ++m) { int er = u.lt * 256 + ai * HALF + wr * 64 + m * 16 + fr; er = er < u.cnt ? er : u.cnt - 1; rr[ai][m] = rsort[(size_t)u.e * 65536 + er] * (1.0f / 32.0f); }
#pragma unroll
        for (int ai = 0; ai < 2; ++ai)
#pragma unroll
            for (int m = 0; m < 4; ++m) { const int lr = ai * HALF + wr * 64 + m * 16 + fr; const int er = u.lt * 256 + lr;
                if (er < u.cnt) { const float r = rr[ai][m]; float o[8];
#pragma unroll
                    for (int n = 0; n < 2; ++n) { const f32x4 a = acc[ai][0][m][n] * r, b = acc[ai][1][m][n] * r;
#pragma unroll
                        for (int k = 0; k < 4; ++k) { const float sg = __builtin_amdgcn_rcpf(1.0f + __builtin_amdgcn_exp2f(a[k] * (-1.4426950408889634f))); o[4 * n + k] = 2.0f * a[k] * sg * b[k]; } }
                    u32x2 w; w.x = cvt4_fp8(o[0], o[1], o[2], o[3]); w.y = cvt4_fp8(o[4], o[5], o[6], o[7]);
                    *(u32x2*)(hid + (size_t)(u.pm * 256 + lr) * EFF + 128 * u.pn + 32 * wc + 8 * fq) = w; } }
    }
};
struct EpiDown {
    const int* tok; const float* gsort; unsigned char* ys;
    __device__ __forceinline__ void operator()(const f32x4 (&acc)[2][2][4][2], const Unit& u, int wr, int wc, int fr, int fq) const {
        const int colb = u.pn * BM + wc * 64 + 16 * fq;
        int ts[2][4]; float gg[2][4];
#pragma unroll
        for (int ai = 0; ai < 2; ++ai)
#pragma unroll
            for (int m = 0; m < 4; ++m) { int er = u.lt * 256 + ai * HALF + wr * 64 + m * 16 + fr; er = er < u.cnt ? er : u.cnt - 1; ts[ai][m] = tok[(size_t)u.e * 65536 + er]; gg[ai][m] = gsort[(size_t)u.e * 65536 + er]; }
#pragma unroll
        for (int ai = 0; ai < 2; ++ai)
#pragma unroll
            for (int m = 0; m < 4; ++m) { const int er = u.lt * 256 + ai * HALF + wr * 64 + m * 16 + fr;
                if (er < u.cnt) { const float g = gg[ai][m] * (16.0f / 32.0f); const int t_ = ts[ai][m]; u32x4 w;
#pragma unroll
                    for (int bj = 0; bj < 2; ++bj)
#pragma unroll
                        for (int n = 0; n < 2; ++n) { const f32x4 v = acc[ai][bj][m][n] * g; w[2 * bj + n] = cvt4_fp8(v[0], v[1], v[2], v[3]); }
                    *(u32x4*)(ys + (size_t)t_ * DMODEL + colb) = w; } }
    }
};

template <class GM, class Epi, class Sched>
__device__ __forceinline__ void gemm_phase(PG8_LAS unsigned char* lds, const GM g, const Sched& S, const Epi& E, const int tid) {
    const int wid = __builtin_amdgcn_readfirstlane(tid >> 6), lane = tid & 63, wr = wid >> 2, wc = wid & 3, fr = lane & 15, fq = lane >> 4;
    constexpr bool FP8 = GM::FP8;
    const int K = g.K, nt = FP8 ? K / 128 : K / BK;
    int sR[2], sC[2]; unsigned voffB[2];
#pragma unroll
    for (int i = 0; i < 2; ++i) { int R, C; if constexpr (FP8) { stage_rc8(tid * 16 + i * 8192, R, C); voffB[i] = (unsigned)(R * K + C); } else { stage_rc(tid * 16 + i * 8192, R, C); voffB[i] = (unsigned)(R * K + C) * 2u; }
        sR[i] = R; sC[i] = C; }
    const size_t kstep = (size_t)(BK * 2);
    const size_t hstep = FP8 ? (size_t)HALF * K : (size_t)HALF * K * 2;
    const unsigned ldsw = (unsigned)wid * 1024u;
    const int aoff = FP8 ? lds_byte8(wr * 64 + fr, fq * 32) : lds_byte(wr * 64 + fr, fq * 8), boff = FP8 ? lds_byte8(wc * 32 + fr, fq * 32) : lds_byte(wc * 32 + fr, fq * 8);
    const int aoff1 = aoff ^ 16, boff1 = boff ^ 16;
    const char* const abase = g.abase();
#define PG8_SA(b, h) (((b) * 2 + (h)) * HTB)
#define PG8_SB(b, h) ((4 + (b) * 2 + (h)) * HTB)
#define PG8_STAGE(bufoff, gbase, voff) do { _Pragma("unroll") for (int _i = 0; _i < 2; ++_i) \
        __builtin_amdgcn_global_load_lds((const unsigned*)((const char*)(gbase) + (voff)[_i]), (PG8_LAS unsigned*)(lds + (bufoff) + ldsw + _i * 8192), 16, 0, 0); } while (0)
#define PG8_STAGEA(bufoff, OFF, h, kb) do { const char* ub_ = abase + (kb);   _Pragma("unroll") for (int _i = 0; _i < 2; ++_i) \
        __builtin_amdgcn_global_load_lds((const unsigned*)(ub_ + (OFF)[h][_i]), (PG8_LAS unsigned*)(lds + (bufoff) + ldsw + _i * 8192), 16, 0, 0); } while (0)
#define PG8_LD8(off0_, off1_, cst_) ({ typedef int v4i_ __attribute__((ext_vector_type(4))); const v4i_ lo_ = *(const PG8_LAS v4i_*)(lds + (cst_) + (off0_)); const v4i_ hi_ = *(const PG8_LAS v4i_*)(lds + (cst_) + (off1_)); __builtin_shufflevector(lo_, hi_, 0, 1, 2, 3, 4, 5, 6, 7); })
#define PG8_LDA(dst, b, h) do { if constexpr (FP8) { _Pragma("unroll") for (int m = 0; m < 4; ++m) dst##8[m] = PG8_LD8(aoff, aoff1, PG8_SA(b, h) + m * 2048); } \
        else { _Pragma("unroll") for (int m = 0; m < 4; ++m) _Pragma("unroll") for (int k = 0; k < 2; ++k) dst[m][k] = *(const PG8_LAS bf16x8*)(lds + PG8_SA(b, h) + aoff + m * 2048 + k * 1024); } } while (0)
#define PG8_LDB(dst, b, h) do { if constexpr (FP8) { _Pragma("unroll") for (int n = 0; n < 2; ++n) dst##8[n] = PG8_LD8(boff, boff1, PG8_SB(b, h) + n * 2048); } \
        else { _Pragma("unroll") for (int n = 0; n < 2; ++n) _Pragma("unroll") for (int k = 0; k < 2; ++k) dst[n][k] = *(const PG8_LAS bf16x8*)(lds + PG8_SB(b, h) + boff + n * 2048 + k * 1024); } } while (0)
#define PG8_MMA(ai, bj, At, Bt) do { __builtin_amdgcn_s_setprio(1); if constexpr (FP8) { _Pragma("unroll") for (int m = 0; m < 4; ++m) _Pragma("unroll") for (int n = 0; n < 2; ++n) \
        asm volatile("v_mfma_scale_f32_16x16x128_f8f6f4 %0, %1, %2, %0, %3, %3 op_sel_hi:[0,0,0]" : "+v"(acc[ai][bj][m][n]) : "v"(Bt##8[n]), "v"(At##8[m]), "v"(f8sc)); } \
        else { _Pragma("unroll") for (int m = 0; m < 4; ++m) _Pragma("unroll") for (int n = 0; n < 2; ++n) _Pragma("unroll") for (int k = 0; k < 2; ++k) \
        acc[ai][bj][m][n] = __builtin_amdgcn_mfma_f32_16x16x32_bf16(Bt[n][k], At[m][k], acc[ai][bj][m][n], 0, 0, 0); } __builtin_amdgcn_s_setprio(0); } while (0)
#define PG8_WAIT_V(n) asm volatile("s_waitcnt vmcnt(" #n ")" ::: "memory")
#define PG8_WAIT_L(n) asm volatile("s_waitcnt lgkmcnt(" #n ")" ::: "memory")
#define PG8_BAR __builtin_amdgcn_s_barrier()
#define PG8_SCHED __builtin_amdgcn_sched_barrier(0)
    Unit cur, nxt; int ui = 0;
    if (!S.next(0, cur)) return;
    f32x4 acc[2][2][4][2];
#pragma unroll
    for (int a = 0; a < 2; ++a)
#pragma unroll
        for (int b = 0; b < 2; ++b)
#pragma unroll
            for (int m = 0; m < 4; ++m)
#pragma unroll
                for (int n = 0; n < 2; ++n) acc[a][b][m][n] = (f32x4){0.f, 0.f, 0.f, 0.f};
    bf16x8 At[4][2], B0[2][2], B1[2][2]; v8i At8[4], B08[2], B18[2];
    const int f8sc = F8_SCALE1;
    unsigned cOff[2][2], nOff[2][2];
    g.offs(cur, sR, sC, cOff);
    const char* cB = g.bptr(cur);
    PG8_STAGE(PG8_SB(0, 0), cB, voffB); PG8_STAGE(PG8_SB(0, 1), cB + hstep, voffB); PG8_STAGEA(PG8_SA(0, 0), cOff, 0, (size_t)0); PG8_STAGEA(PG8_SA(0, 1), cOff, 1, (size_t)0);
    if (wr == 1) PG8_BAR;
    PG8_WAIT_V(2); PG8_BAR;
    PG8_STAGE(PG8_SB(1, 0), cB + kstep, voffB); PG8_STAGEA(PG8_SA(1, 0), cOff, 0, kstep); PG8_STAGE(PG8_SB(1, 1), cB + hstep + kstep, voffB);
    PG8_WAIT_V(6); PG8_BAR;
    for (;;) {
        const bool has_next = S.next(ui + 1, nxt);
        const char* nB = cB;
        if (has_next) { g.offs(nxt, sR, sC, nOff); nB = g.bptr(nxt); }
        else {
#pragma unroll
            for (int h = 0; h < 2; ++h)
#pragma unroll
                for (int i = 0; i < 2; ++i) nOff[h][i] = cOff[h][i];
        }
#pragma unroll 1
        for (int t = 0; t < nt; t += 2) {
            const bool last = (t == nt - 2);
            const size_t kb1 = (size_t)(t + 1) * kstep;
            const size_t kb2 = last ? (size_t)0 : (size_t)(t + 2) * kstep, kb3 = kb2 + kstep;
            unsigned o2[2][2];
#pragma unroll
            for (int h = 0; h < 2; ++h)
#pragma unroll
                for (int i = 0; i < 2; ++i) o2[h][i] = last ? nOff[h][i] : cOff[h][i];
            const char* b2 = last ? nB : cB + (size_t)(t + 2) * kstep; const char* b3 = b2 + kstep;
            PG8_LDB(B0, 0, 0); PG8_LDB(B1, 0, 1); PG8_SCHED; PG8_LDA(At, 0, 0); PG8_STAGEA(PG8_SA(1, 1), cOff, 1, kb1);
            PG8_WAIT_V(8); PG8_WAIT_L(0); PG8_BAR; PG8_MMA(0, 0, At, B0); PG8_MMA(0, 1, At, B1); PG8_BAR; PG8_SCHED;
            PG8_LDA(At, 0, 1); PG8_STAGE(PG8_SB(0, 0), b2, voffB); PG8_STAGE(PG8_SB(0, 1), b2 + hstep, voffB); PG8_STAGEA(PG8_SA(0, 0), o2, 0, kb2);
            PG8_WAIT_V(8); PG8_WAIT_L(0); PG8_BAR; PG8_MMA(1, 0, At, B0); PG8_MMA(1, 1, At, B1); PG8_BAR; PG8_SCHED;
            PG8_LDB(B0, 1, 0); PG8_LDB(B1, 1, 1); PG8_SCHED; PG8_LDA(At, 1, 0); PG8_STAGEA(PG8_SA(0, 1), o2, 1, kb2);
            PG8_WAIT_V(8); PG8_WAIT_L(0); PG8_BAR; PG8_MMA(0, 0, At, B0); PG8_MMA(0, 1, At, B1); PG8_BAR; PG8_SCHED;
            PG8_LDA(At, 1, 1); PG8_STAGE(PG8_SB(1, 0), b3, voffB); PG8_STAGE(PG8_SB(1, 1), b3 + hstep, voffB); PG8_STAGEA(PG8_SA(1, 0), o2, 0, kb3);
            PG8_WAIT_V(8); PG8_WAIT_L(0); PG8_BAR; PG8_MMA(1, 0, At, B0); PG8_MMA(1, 1, At, B1); PG8_BAR; PG8_SCHED;
        }
        if constexpr (FP8) asm volatile("s_nop 15\n\ts_nop 15" ::: "memory");
        if (wr == 0) PG8_BAR;
        { int fr_ = fr, fq_ = fq; asm volatile("" : "+v"(fr_), "+v"(fq_));
          E(acc, cur, wr, wc, fr_, fq_); }
        if (!has_next) break;
#pragma unroll
        for (int a = 0; a < 2; ++a)
#pragma unroll
            for (int b = 0; b < 2; ++b)
#pragma unroll
                for (int m = 0; m < 4; ++m)
#pragma unroll
                    for (int n = 0; n < 2; ++n) acc[a][b][m][n] = (f32x4){0.f, 0.f, 0.f, 0.f};
        cur = nxt; cB = nB; ++ui;
#pragma unroll
        for (int h = 0; h < 2; ++h)
#pragma unroll
            for (int i = 0; i < 2; ++i) cOff[h][i] = nOff[h][i];
        if (wr == 1) PG8_BAR;
    }
    PG8_WAIT_V(0);
    PG8_BAR;
#undef PG8_SA
#undef PG8_SB
#undef PG8_STAGE
#undef PG8_STAGEA
#undef PG8_LDA
#undef PG8_LD8
#undef PG8_LDB
#undef PG8_MMA
#undef PG8_WAIT_V
#undef PG8_WAIT_L
#undef PG8_BAR
#undef PG8_SCHED
}
}

namespace attn_body {
using bf16=__hip_bfloat16;
using bf16x8=__attribute__((ext_vector_type(8)))short;
using s16x4=__attribute__((ext_vector_type(4)))short;
using f32x16=__attribute__((ext_vector_type(16)))float;
using f32x4=__attribute__((ext_vector_type(4)))float;
using u32x4=__attribute__((ext_vector_type(4)))unsigned;
using u32x2=__attribute__((ext_vector_type(2)))unsigned;
constexpr int D=64,DM=HW;
constexpr int NW=8,QBLK=32,QB=QBLK*NW,KVBLK=64;
__device__ __forceinline__ int crow(int r,int hi){return (r&3)+8*(r>>2)+4*hi;}
#define SBAR() __builtin_amdgcn_sched_barrier(0)
__device__ __forceinline__ void cmask(f32x16&p0,f32x16&p1,int jb,int qrel,int hi){
  const float NEG=-INFINITY; const int d=qrel-64*jb-4*hi;
  #pragma unroll
  for(int r=0;r<16;++r){const int c=(r&3)+8*(r>>2); if(c>d)p0[r]=NEG; if(c+32>d)p1[r]=NEG;}
}
__device__ __forceinline__ void addmask(f32x16&p0,f32x16&p1,float addv){
  #pragma unroll
  for(int r=0;r<16;++r){p0[r]+=addv;p1[r]+=addv;}
}
typedef __attribute__((address_space(3))) const char* lds_cptr;
__device__ __forceinline__ float mselect(int m,float v){ return __uint_as_float((__float_as_uint(v)&(unsigned)m)|(0xff800000u&~(unsigned)m)); }
__device__ __forceinline__ void bitmask(f32x16&p0,f32x16&p1,lds_cptr mrow,int t,int hi){
  const u32x2 w=*(const __attribute__((address_space(3))) u32x2*)(mrow+((t>>2)&1)*1024+((t>>1)&1)*512+(t&1)*8);
  const int w0=(int)(w.x>>(4*hi)),w1=(int)(w.y>>(4*hi));
  #pragma unroll
  for(int r=0;r<16;++r){const int bpos=(r&3)+8*(r>>2); p0[r]=mselect(__builtin_amdgcn_sbfe(w0,bpos,1),p0[r]); p1[r]=mselect(__builtin_amdgcn_sbfe(w1,bpos,1),p1[r]);}
}

constexpr int NSLOT=3, SLOTB=8192;
constexpr int LDS_K=0, LDS_V=NSLOT*SLOTB, LDS_WS=2*NSLOT*SLOTB, LDS_OST=LDS_WS+NW*64*4, LDS_MSK=LDS_OST+NW*4096, LDS_BYTES=LDS_MSK+NW*2048, LDS_QST=LDS_BYTES, LDS_QST_BYTES=NW*4096;
__device__ __forceinline__ void glds16(const void*gsrc,unsigned lds_dst){unsigned keep;
  asm volatile("s_mov_b32 %0, m0\n\ts_mov_b32 m0, %2\n\ts_nop 0\n\tglobal_load_lds_dwordx4 %1, off\n\ts_mov_b32 m0, %0":"=&s"(keep):"v"(gsrc),"s"(lds_dst):"memory");}
__device__ __forceinline__ float max3f(float a,float b,float c){float r;asm("v_max3_f32 %0, %1, %2, %3":"=v"(r):"v"(a),"v"(b),"v"(c));return r;}
__device__ __forceinline__ float max2f(float a,float b){float r;asm("v_max_f32_e32 %0, %1, %2":"=v"(r):"v"(a),"v"(b));return r;}
__device__ __forceinline__ float fadd_s(float a,float b){float r;asm("v_add_f32_e32 %0, %1, %2":"=v"(r):"v"(a),"v"(b));return r;}
__device__ __forceinline__ float fsub_s(float a,float b){float r;asm("v_sub_f32_e32 %0, %1, %2":"=v"(r):"v"(a),"v"(b));return r;}
typedef float f32x2_t __attribute__((ext_vector_type(2))); typedef __bf16 bf16x2_t __attribute__((ext_vector_type(2)));
__device__ __forceinline__ unsigned cvtpk_s(float lo,float hi){f32x2_t v={lo,hi};bf16x2_t b=__builtin_convertvector(v,bf16x2_t);return __builtin_bit_cast(unsigned,b);}
#define WAIT_BAR(N) asm volatile("s_waitcnt vmcnt(" #N ") lgkmcnt(0)\n\ts_barrier":::"memory")

__device__ __forceinline__ void qkt(f32x16&p0,f32x16&p1,const char*Kslot,const bf16x8*qr,int r32,int hi){
  const f32x16 negm=f32x16{};
  const char*kb=Kslot+hi*1024+r32*16;
  #pragma unroll
  for(int d0=0;d0<4;++d0){
    const bf16x8 b0=*reinterpret_cast<const bf16x8*>(kb+d0*2048);
    const bf16x8 b1=*reinterpret_cast<const bf16x8*>(kb+d0*2048+512);
    if(d0==0){p0=__builtin_amdgcn_mfma_f32_32x32x16_bf16(b0,qr[0],negm,0,0,0);p1=__builtin_amdgcn_mfma_f32_32x32x16_bf16(b1,qr[0],negm,0,0,0);}
    else{p0=__builtin_amdgcn_mfma_f32_32x32x16_bf16(b0,qr[d0],p0,0,0,0);p1=__builtin_amdgcn_mfma_f32_32x32x16_bf16(b1,qr[d0],p1,0,0,0);}}
}
typedef short v4i16_t __attribute__((ext_vector_type(4)));
__device__ __forceinline__ void kload8(bf16x8*kf,lds_cptr kp){
  kf[0]=*(const __attribute__((address_space(3))) bf16x8*)(kp);      kf[1]=*(const __attribute__((address_space(3))) bf16x8*)(kp+512);
  kf[2]=*(const __attribute__((address_space(3))) bf16x8*)(kp+2048); kf[3]=*(const __attribute__((address_space(3))) bf16x8*)(kp+2560);
  kf[4]=*(const __attribute__((address_space(3))) bf16x8*)(kp+4096); kf[5]=*(const __attribute__((address_space(3))) bf16x8*)(kp+4608);
  kf[6]=*(const __attribute__((address_space(3))) bf16x8*)(kp+6144); kf[7]=*(const __attribute__((address_space(3))) bf16x8*)(kp+6656);
}
__device__ __forceinline__ void kload2(bf16x8*kf,lds_cptr kp,int j){ kf[2*j]=*(const __attribute__((address_space(3))) bf16x8*)(kp+j*2048); kf[2*j+1]=*(const __attribute__((address_space(3))) bf16x8*)(kp+j*2048+512); }
__device__ __forceinline__ s16x4 vtr(lds_cptr p){ return __builtin_bit_cast(s16x4,__builtin_amdgcn_ds_read_tr16_b64_v4i16((__attribute__((address_space(3))) v4i16_t*)p)); }
__device__ __forceinline__ float rowmax(const f32x16&p0,const f32x16&p1){
  float a=max3f(p0[0],p0[1],p1[0]),b=max3f(p0[2],p0[3],p1[1]);a=max3f(a,p1[2],p1[3]);
  #pragma unroll
  for(int r=4;r<16;r+=4){a=max3f(a,p0[r],p0[r+1]);b=max3f(b,p0[r+2],p0[r+3]);a=max3f(a,p1[r],p1[r+1]);b=max3f(b,p1[r+2],p1[r+3]);}
  const float m=max2f(a,b);
  auto rr=__builtin_amdgcn_permlane32_swap(__float_as_uint(m),__float_as_uint(m),false,false);
  return max2f(__uint_as_float(rr[0]),__uint_as_float(rr[1]));
}
__device__ __forceinline__ void pv(f32x16*o,int vb,bf16x8 pa0,bf16x8 pa1,bf16x8 pa2,bf16x8 pa3){
  #pragma unroll
  for(int d0=0;d0<2;++d0){s16x4 lo[4],hi[4];
    #pragma unroll
    for(int ks=0;ks<4;++ks){
      asm volatile("ds_read_b64_tr_b16 %0,%1 offset:%c2":"=&v"(lo[ks]):"v"(vb),"i"(d0*4096+ks*1024):"memory");
      asm volatile("ds_read_b64_tr_b16 %0,%1 offset:%c2":"=&v"(hi[ks]):"v"(vb),"i"(d0*4096+ks*1024+512):"memory");}
    asm volatile("s_waitcnt lgkmcnt(0)":::"memory");SBAR();
    #define PK(k) (bf16x8){lo[k][0],lo[k][1],lo[k][2],lo[k][3],hi[k][0],hi[k][1],hi[k][2],hi[k][3]}
    o[d0]=__builtin_amdgcn_mfma_f32_32x32x16_bf16(pa0,PK(0),o[d0],0,0,0);
    o[d0]=__builtin_amdgcn_mfma_f32_32x32x16_bf16(pa1,PK(1),o[d0],0,0,0);
    o[d0]=__builtin_amdgcn_mfma_f32_32x32x16_bf16(pa2,PK(2),o[d0],0,0,0);
    o[d0]=__builtin_amdgcn_mfma_f32_32x32x16_bf16(pa3,PK(3),o[d0],0,0,0);
    #undef PK
  }
}
#ifndef ATTN_STORE16
#define ATTN_STORE16(p,v) (*(u32x4*)(p)=(v))
#endif
__device__ __forceinline__ float bfs(short s){ return __uint_as_float(((unsigned)(unsigned short)s)<<16); }

template<int MODE,int THRL> __device__ __forceinline__ void attn_unit(int b,int h,int qb,const bf16*Q,const bf16*__restrict__ K,const bf16*__restrict__ V,unsigned char*O,char*shm,
                                                                      const float*kbsum,const unsigned long long*maskw,const int tid_in,
                                                                      const bool pre,const bool has_next,const bf16*Qn,const bf16*Kn,const int qbn,const bool bitsn){
  int tid=tid_in; asm volatile("":"+v"(tid));
  const int lane=tid&63,r32=lane&31,hi=lane>>5; const int wid=__builtin_amdgcn_readfirstlane(tid>>6);
  const long rowbase=(long)b*SEQ; const int q0=qb*QB;
  const bf16*Qw=Q+(rowbase+q0+wid*QBLK)*DM+h*D;
  const bf16*Kh=K+rowbase*DM+h*D,*Vh=V+rowbase*DM+h*D;
  const unsigned lds0=(unsigned)(uintptr_t)shm;
  float*wsf=(float*)(shm+LDS_WS)+wid*64;
  const unsigned koff=(unsigned)((lane*DM+wid*8)*2);
  const unsigned voff=(unsigned)(((16*(wid&3)+(lane>>2))*DM+(wid>>2)*32+(lane&3)*8)*2);
  const unsigned kdst=lds0+LDS_K+wid*1024, vdst=lds0+LDS_V+wid*1024;
  #define DMA_K(t,slot) glds16((const char*)Kh+(size_t)(t)*(KVBLK*DM*2)+koff,(unsigned)__builtin_amdgcn_readfirstlane(kdst+(slot)))
  #define DMA_V(t,slot) glds16((const char*)Vh+(size_t)(t)*(KVBLK*DM*2)+voff,(unsigned)__builtin_amdgcn_readfirstlane(vdst+(slot)))
  const unsigned long long*mbase=maskw+(size_t)(rowbase+q0+wid*QBLK)*32;
  const unsigned moff=(unsigned)((r32*32+2*hi)*8);
  const unsigned mdst=lds0+LDS_MSK+wid*2048;
  #define DMA_M(tg) glds16((const char*)mbase+(size_t)(32*(tg))+moff,(unsigned)__builtin_amdgcn_readfirstlane(mdst+((tg)&1)*1024))
  const bool usebits=(MODE==1)&&(qb>0);
  const int vb0=(int)(lds0+LDS_V)+((lane>>4)&1)*32+(lane&3)*8+(4*hi+((lane&15)>>2))*64;
  const char*Kbase=shm+LDS_K; bf16x8 kf[8];
  const lds_cptr shm3=(lds_cptr)shm; const lds_cptr kp0=shm3+LDS_K+hi*1024+r32*16; const lds_cptr vp0=shm3+LDS_V+((lane>>4)&1)*32+(lane&3)*8+(4*hi+((lane&15)>>2))*64;
  const lds_cptr mrow=shm3+LDS_MSK+wid*2048+r32*16;
  const int NT=(q0+QB)/KVBLK;
  const unsigned qst=lds0+LDS_QST+wid*4096;
  bf16x8 qr[4];
  if(!pre){ if(usebits){DMA_M(0);} DMA_K(0,0);DMA_V(0,0);DMA_K(1,SLOTB);
    #pragma unroll
    for(int d0=0;d0<4;++d0)qr[d0]=*reinterpret_cast<const bf16x8*>(&Qw[(long)r32*DM+d0*16+hi*8]); }
  else { DMA_V(0,0);
    asm volatile("s_waitcnt vmcnt(7)":::"memory");
    const lds_cptr qp=shm3+LDS_QST+wid*4096+(r32>>3)*1024+(r32&7)*128;
    #pragma unroll
    for(int d0=0;d0<4;++d0)qr[d0]=*reinterpret_cast<const __attribute__((address_space(3))) bf16x8*>(qp+(((d0*2+hi)^(r32&7))*16)); }
  unsigned selbits=(1u<<qb)-1u;
  if(MODE==0&&qb>3){
    float g[7];
    #pragma unroll
    for(int j=0;j<7;++j){ g[j]=0.f;
      if(j<qb){ const float*kbp=kbsum+((size_t)(b*NHEAD+h)*8+j)*64+hi*8; float s=0.f;
        #pragma unroll
        for(int d0=0;d0<4;++d0){ const f32x4 k0=*(const f32x4*)(kbp+d0*16),k1=*(const f32x4*)(kbp+d0*16+4);
          s+=bfs(qr[d0][0])*k0[0]+bfs(qr[d0][1])*k0[1]+bfs(qr[d0][2])*k0[2]+bfs(qr[d0][3])*k0[3]+bfs(qr[d0][4])*k1[0]+bfs(qr[d0][5])*k1[1]+bfs(qr[d0][6])*k1[2]+bfs(qr[d0][7])*k1[3]; }
        s+=__shfl_xor(s,32); g[j]=s; } }
    selbits=0u;
    #pragma unroll
    for(int j=0;j<7;++j){ if(j<qb){ int rank=0;
      #pragma unroll
      for(int i=0;i<7;++i){ if(i!=j&&i<qb){ rank+=(g[i]>g[j]||(g[i]==g[j]&&i<j))?1:0; } }
      if(rank<3)selbits|=(1u<<j); } }
  }
  float mhat=0.f,l_reg=0.f;f32x16 o[2];o[0]=f32x16{};o[1]=f32x16{};const f32x16 zero16=f32x16{};
  const int qrel=wid*QBLK+r32;
  #define AMASK_PEEL(P0,P1,t) do{ const int jb_=(t)-(NT-4); \
      if(usebits){ bitmask(P0,P1,mrow,(t),hi); } \
      else if(jb_>=0){ cmask(P0,P1,jb_,qrel,hi); } }while(0)
  #define ADDV_PEEL(t) ((MODE==0&&(t)<NT-4)?(((selbits>>((t)>>2))&1u)?0.f:-INFINITY):0.f)
  #define AMASK_STEADY(P0,P1,t) do{ if(MODE==1){ bitmask(P0,P1,mrow,(t),hi); } }while(0)
  #define ADDV_STEADY(t) ((MODE==0)?(((selbits>>((t)>>2))&1u)?0.f:-INFINITY):0.f)
  #define CMASK(P0,P1,t) AMASK_PEEL(P0,P1,t)
  #define ADDV(t) ADDV_PEEL(t)
  bool resc=false;
  #define START(P0,P1) do{ const float rm=rowmax(P0,P1); resc=false; \
    { const float dl=(rm<-1e30f)?0.f:rm; mhat=fadd_s(mhat,dl); \
      _Pragma("unroll") for(int r=0;r<16;++r){P0[r]=fsub_s(P0[r],dl);P1[r]=fsub_s(P1[r],dl);} } \
    _Pragma("unroll") for(int r=0;r<16;++r)P0[r]=__builtin_amdgcn_exp2f(P0[r]); }while(0)
  #define RESC() do{ if(resc){ asm volatile("s_waitcnt lgkmcnt(0)":::"memory"); \
      _Pragma("unroll") for(int d_=0;d_<2;++d_) _Pragma("unroll") for(int r=0;r<16;++r)o[d_][r]*=wsf[crow(r,hi)]; } }while(0)
  f32x16 pA0,pA1,pB0,pB1;
  int sl_prev=0,sl_cur=0,sl_next=SLOTB;
  #define ROT() do{sl_prev=sl_cur;sl_cur=sl_next;sl_next=(sl_next==(NSLOT-1)*SLOTB)?0:sl_next+SLOTB;}while(0)
  if(!pre){ DMA_K(2,2*SLOTB); WAIT_BAR(3); } else { WAIT_BAR(7); }
  qkt(pA0,pA1,Kbase,qr,r32,hi);asm volatile("s_nop 15\n\ts_nop 7":"+v"(pA0),"+v"(pA1));CMASK(pA0,pA1,0);
  if(MODE==0){ addmask(pA0,pA1,ADDV(0)); }
  asm volatile("s_nop 7":"+v"(pA0),"+v"(pA1));
  START(pA0,pA1);
  _Pragma("unroll") for(int r=0;r<16;++r)pA1[r]=__builtin_amdgcn_exp2f(pA1[r]);
  WAIT_BAR(0);
  if(usebits&&NT>4){DMA_M(1);}
  DMA_K(3,0);DMA_V(1,SLOTB);
  ROT();
  kload8(kf,kp0+sl_cur);
  WAIT_BAR(2);
  s16x4 vlo[8],vhi[8]; u32x4 pw0,pw1,pw2,pw3;
  #define PKW(P,B) cvtpk_s(P[B],P[B+1])
  #define PAF(k) __builtin_bit_cast(bf16x8,pw##k)
  #define VFR(i) (bf16x8){vlo[i][0],vlo[i][1],vlo[i][2],vlo[i][3],vhi[i][0],vhi[i][1],vhi[i][2],vhi[i][3]}
  #define PIN(x) asm volatile("":"+v"(x))
  #define MX3(a,b,c) __builtin_fmaxf(__builtin_fmaxf((a),(b)),(c))
  #define GAPA(MF,A0,A1,A2,A3,W0,W1,PW) do{ MF; sacc+=A0; sacc+=A1; sacc+=A2; sacc+=A3; PIN(sacc); W0; W1; PIN(PW); SBAR(); }while(0)
  #define EX(v) __builtin_amdgcn_exp2f(v)
  #define GAPB(MF,X,B) do{ MF; X[B]=EX(X[B]); X[B+1]=EX(X[B+1]); X[B+2]=EX(X[B+2]); X[B+3]=EX(X[B+3]); PIN(X); SBAR(); }while(0)
  #define VRD(i) do{ vlo[i]=vtr(vp_+(((i)>>2)*4096+((i)&3)*1024)); vhi[i]=vtr(vp_+(((i)>>2)*4096+((i)&3)*1024+512)); }while(0)
  #define KRD(G,j) do{ if(G){ kload2(kf,kp0+sl_next,j); SBAR(); } }while(0)
  #define STEP(C0,C1,P0,P1,t,GK,GV,GL,GM) do{ SBAR(); \
    const lds_cptr vp_=vp0+sl_prev; \
    VRD(0); SBAR(); float sacc=(P0[0]+P0[1]); \
    GAPA(C0=__builtin_amdgcn_mfma_f32_32x32x16_bf16(kf[0],qr[0],zero16,0,0,0), P0[2],P0[3],P0[4],P0[5],     pw0[0]=PKW(P0,0), pw0[1]=PKW(P0,2), pw0); \
    VRD(4); SBAR(); GAPA(C1=__builtin_amdgcn_mfma_f32_32x32x16_bf16(kf[1],qr[0],zero16,0,0,0), P0[6],P0[7],P0[8],P0[9],     pw0[2]=PKW(P0,4), pw0[3]=PKW(P0,6), pw0); \
    VRD(1); SBAR(); GAPA(C0=__builtin_amdgcn_mfma_f32_32x32x16_bf16(kf[2],qr[1],C0,0,0,0),   P0[10],P0[11],P0[12],P0[13], pw1[0]=PKW(P0,8), pw1[1]=PKW(P0,10), pw1); \
    VRD(5); SBAR(); GAPA(C1=__builtin_amdgcn_mfma_f32_32x32x16_bf16(kf[3],qr[1],C1,0,0,0),   P0[14],P0[15],P1[0],P1[1],   pw1[2]=PKW(P0,12),pw1[3]=PKW(P0,14), pw1); \
    VRD(2); SBAR(); GAPA(C0=__builtin_amdgcn_mfma_f32_32x32x16_bf16(kf[4],qr[2],C0,0,0,0),   P1[2],P1[3],P1[4],P1[5],     pw2[0]=PKW(P1,0), pw2[1]=PKW(P1,2), pw2); \
    VRD(6); SBAR(); GAPA(C1=__builtin_amdgcn_mfma_f32_32x32x16_bf16(kf[5],qr[2],C1,0,0,0),   P1[6],P1[7],P1[8],P1[9],     pw2[2]=PKW(P1,4), pw2[3]=PKW(P1,6), pw2); \
    VRD(3); SBAR(); GAPA(C0=__builtin_amdgcn_mfma_f32_32x32x16_bf16(kf[6],qr[3],C0,0,0,0),   P1[10],P1[11],P1[12],P1[13], pw3[0]=PKW(P1,8), pw3[1]=PKW(P1,10), pw3); \
    VRD(7); SBAR(); GAPA(C1=__builtin_amdgcn_mfma_f32_32x32x16_bf16(kf[7],qr[3],C1,0,0,0),   P1[14],P1[15],0.f,0.f,       pw3[2]=PKW(P1,12),pw3[3]=PKW(P1,14), pw3); \
    l_reg+=sacc; \
    if(GM){DMA_M(((t)>>2)+1);} \
    if(GK){DMA_K((t)+3,sl_cur);} if(GV){DMA_V((t)+1,sl_next);} \
    CMASK(C0,C1,t); \
    { float a=MX3(C0[0],C0[1],C1[0]),b=MX3(C0[2],C0[3],C1[1]); a=MX3(a,C1[2],C1[3]); \
      _Pragma("unroll") for(int r=4;r<16;r+=4){a=MX3(a,C0[r],C0[r+1]);b=MX3(b,C0[r+2],C0[r+3]);a=MX3(a,C1[r],C1[r+1]);b=MX3(b,C1[r+2],C1[r+3]);} \
      float rm=__builtin_fmaxf(a,b); { auto rr=__builtin_amdgcn_permlane32_swap(__float_as_uint(rm),__float_as_uint(rm),false,false); rm=__builtin_fmaxf(__uint_as_float(rr[0]),__uint_as_float(rr[1])); } \
      const float addv_=ADDV(t); rm=(rm+addv_)-mhat; \
      resc=false; \
      if(__builtin_expect(__any(rm>(float)THRL),0)){ const float dl=__builtin_fmaxf(rm,0.f); mhat+=dl; \
        const float f=__builtin_amdgcn_exp2f(-dl); l_reg*=f; if(hi==0)wsf[r32]=f; resc=true; } \
      const float sub_=mhat-addv_; \
      _Pragma("unroll") for(int r=0;r<16;++r){C0[r]-=sub_;C1[r]-=sub_;} } \
    SBAR(); \
    GAPB(o[0]=__builtin_amdgcn_mfma_f32_32x32x16_bf16(PAF(0),VFR(0),o[0],0,0,0), C0,0); \
    GAPB(o[1]=__builtin_amdgcn_mfma_f32_32x32x16_bf16(PAF(0),VFR(4),o[1],0,0,0), C0,4); \
    KRD(GL,0); GAPB(o[0]=__builtin_amdgcn_mfma_f32_32x32x16_bf16(PAF(1),VFR(1),o[0],0,0,0), C0,8); \
    KRD(GL,1); GAPB(o[1]=__builtin_amdgcn_mfma_f32_32x32x16_bf16(PAF(1),VFR(5),o[1],0,0,0), C0,12); \
    KRD(GL,2); GAPB(o[0]=__builtin_amdgcn_mfma_f32_32x32x16_bf16(PAF(2),VFR(2),o[0],0,0,0), C1,0); \
    KRD(GL,3); GAPB(o[1]=__builtin_amdgcn_mfma_f32_32x32x16_bf16(PAF(2),VFR(6),o[1],0,0,0), C1,4); \
    GAPB(o[0]=__builtin_amdgcn_mfma_f32_32x32x16_bf16(PAF(3),VFR(3),o[0],0,0,0), C1,8); \
    GAPB(o[1]=__builtin_amdgcn_mfma_f32_32x32x16_bf16(PAF(3),VFR(7),o[1],0,0,0), C1,12); \
    }while(0)
  int t=1;
  #undef CMASK
  #undef ADDV
  #define CMASK(P0,P1,t) AMASK_STEADY(P0,P1,t)
  #define ADDV(t) ADDV_STEADY(t)
  for(;t+5<NT;t+=2){
    STEP(pB0,pB1,pA0,pA1,t,true,true,true,false);     WAIT_BAR(2); RESC(); ROT();
    STEP(pA0,pA1,pB0,pB1,t+1,true,true,true,(MODE==1&&(((t+1)&3)==0)&&(t+5<NT)));   WAIT_BAR(2); RESC(); ROT();
  }
  #undef CMASK
  #undef ADDV
  #define CMASK(P0,P1,t) AMASK_PEEL(P0,P1,t)
  #define ADDV(t) ADDV_PEEL(t)
  #define ENDW(tt) do{ if((tt)+3<NT){WAIT_BAR(2);} else if((tt)+2<NT){WAIT_BAR(1);} else {WAIT_BAR(0);} }while(0)
  for(;t+1<NT;t+=2){
    STEP(pB0,pB1,pA0,pA1,t,(t+3<NT),(t+1<NT),(t+1<NT),false);       ENDW(t);   RESC(); ROT();
    STEP(pA0,pA1,pB0,pB1,t+1,(t+4<NT),(t+2<NT),(t+2<NT),false);     ENDW(t+1); RESC(); ROT();
  }
  STEP(pB0,pB1,pA0,pA1,NT-1,false,false,false,false); RESC();
  { float sacc=pB0[0]+pB0[1]; _Pragma("unroll") for(int r=2;r<16;++r)sacc+=pB0[r]; _Pragma("unroll") for(int r=0;r<16;++r)sacc+=pB1[r]; l_reg+=sacc;
    pw0=(u32x4){PKW(pB0,0),PKW(pB0,2),PKW(pB0,4),PKW(pB0,6)};pw1=(u32x4){PKW(pB0,8),PKW(pB0,10),PKW(pB0,12),PKW(pB0,14)};pw2=(u32x4){PKW(pB1,0),PKW(pB1,2),PKW(pB1,4),PKW(pB1,6)};pw3=(u32x4){PKW(pB1,8),PKW(pB1,10),PKW(pB1,12),PKW(pB1,14)};
    SBAR(); pv(o,vb0+sl_cur,PAF(0),PAF(1),PAF(2),PAF(3)); }
  if(has_next){ const int q0n=qbn*QB; const bf16*Khn=Kn+rowbase*DM+h*D;
    glds16((const char*)Khn+koff,(unsigned)__builtin_amdgcn_readfirstlane(kdst));
    { const char*Qnw=(const char*)(Qn+(rowbase+q0n+wid*QBLK)*DM+h*D);
      #pragma unroll
      for(int j=0;j<4;++j) glds16(Qnw+(size_t)(8*j+(lane>>3))*(DM*2)+(((lane&7)^(lane>>3))*16),(unsigned)__builtin_amdgcn_readfirstlane(qst+j*1024)); }
    if(bitsn){ const unsigned long long*mbn=maskw+(size_t)(rowbase+q0n+wid*QBLK)*32; glds16((const char*)mbn+moff,(unsigned)__builtin_amdgcn_readfirstlane(mdst)); }
    glds16((const char*)Khn+(size_t)1*(KVBLK*DM*2)+koff,(unsigned)__builtin_amdgcn_readfirstlane(kdst+SLOTB));
    glds16((const char*)Khn+(size_t)2*(KVBLK*DM*2)+koff,(unsigned)__builtin_amdgcn_readfirstlane(kdst+2*SLOTB)); }
  #undef PKW
  #undef PAF
  #undef VFR
  #undef PIN
  #undef MX3
  #undef GAPA
  #undef GAPB
  #undef EX
  #undef VRD
  #undef KRD
  #undef STEP
  #undef ENDW
  {auto rr=__builtin_amdgcn_permlane32_swap(__float_as_uint(l_reg),__float_as_uint(l_reg),false,false);l_reg=__uint_as_float(rr[0])+__uint_as_float(rr[1]);}
  if(hi==0)wsf[32+r32]=l_reg;asm volatile("s_waitcnt lgkmcnt(0)":::"memory");
  float rli[16];
  #pragma unroll
  for(int r=0;r<16;++r)rli[r]=__builtin_amdgcn_rcpf(wsf[32+crow(r,hi)]);
  unsigned char*Ow=O+(rowbase+q0+wid*QBLK)*DM+h*D;
  { bf16*stg=(bf16*)(shm+LDS_OST)+wid*2048;
    #pragma unroll
    for(int r=0;r<16;++r){const int orow=crow(r,hi);
      #pragma unroll
      for(int d0=0;d0<2;++d0)stg[orow*64+d0*32+r32]=__float2bfloat16(o[d0][r]*rli[r]);}
    asm volatile("s_waitcnt lgkmcnt(0)":::"memory");
    #pragma unroll
    for(int i=0;i<4;++i){const int row=i*8+(lane>>3),ch=lane&7; const u32x4 v=*(const u32x4*)(stg+row*64+ch*8); u32x2 w;
      w.x=pg8::cvt4_fp8(16.f*__uint_as_float(v.x<<16),16.f*__uint_as_float(v.x&0xffff0000u),16.f*__uint_as_float(v.y<<16),16.f*__uint_as_float(v.y&0xffff0000u));
      w.y=pg8::cvt4_fp8(16.f*__uint_as_float(v.z<<16),16.f*__uint_as_float(v.z&0xffff0000u),16.f*__uint_as_float(v.w<<16),16.f*__uint_as_float(v.w&0xffff0000u));
      *(u32x2*)(Ow+(long)row*DM+ch*8)=w;} }
  asm volatile("s_waitcnt lgkmcnt(0)\n\ts_barrier":::"memory");
  #undef DMA_K
  #undef DMA_V
  #undef DMA_M
  #undef CMASK
  #undef AMASK_PEEL
  #undef AMASK_STEADY
  #undef ADDV
  #undef ADDV_PEEL
  #undef ADDV_STEADY
  #undef START
  #undef RESC
  #undef ROT
}
constexpr int ATTN_LDS_BYTES=LDS_BYTES;
#undef SBAR
#undef WAIT_BAR
}

constexpr int NWAVES = 8;
constexpr size_t MiB = 1u << 20;
constexpr size_t WS_CTL = 0, CTL_ZERO_BYTES = 1 * MiB;
constexpr size_t WS_WIN = 1 * MiB, WS_WA = 13 * MiB, WS_WB = 14 * MiB, WS_WOUT = 15 * MiB, WS_W13 = 17 * MiB, WS_W2 = 81 * MiB;
constexpr size_t WS_WR = 113 * MiB, WS_ROPE = 113 * MiB + 512 * 1024;
constexpr size_t WS_RSTD1 = 114 * MiB, WS_RSTD2 = 114 * MiB + 256 * 1024, WS_KBSUM = 114 * MiB + 512 * 1024;
constexpr size_t WS_KI = 115 * MiB, WS_WI = 123 * MiB, WS_MASK = 125 * MiB, WS_TOK = 141 * MiB, WS_GATE = 149 * MiB;
constexpr size_t WS_RSORT = WS_KI, WS_GSORT = WS_MASK;
constexpr size_t WS_QA = 152 * MiB, WS_KA = 216 * MiB, WS_VA = 280 * MiB, WS_QB = 344 * MiB, WS_KB = 408 * MiB, WS_VB = 472 * MiB, WS_QI = 536 * MiB;
constexpr size_t WS_XB = 600 * MiB, WS_OA = 928 * MiB, WS_OB = 960 * MiB, WS_MIX = 216 * MiB, WS_X1B = 728 * MiB, WS_HID = 856 * MiB, WS_YS = 152 * MiB, WS_END = 1024 * MiB;
constexpr size_t WS_WR8 = 113 * MiB + 256 * 1024;
constexpr size_t WS_X1H = 280 * MiB, WS_X1L = 408 * MiB;
static_assert(WS_HID + (size_t)HID_ROWS * EFF <= WS_OA, "ws map");
constexpr size_t WS_MIX8 = 152 * MiB;
constexpr size_t WS_WIN8 = WS_WIN + 6 * MiB, WS_X8 = 728 * MiB;
static_assert(WS_WIN + (size_t)NINA * DMODEL * 2 <= WS_WIN8 && WS_WIN8 + (size_t)NINB * DMODEL <= WS_WA, "ws map");
constexpr int CW_CNT = 64;
constexpr int CW_BAR = 4096;
constexpr int RING_BYTES = 131072, SCR_BYTES = 132096, MISC_OFF = SCR_BYTES, LDS_BYTES = 155648;
constexpr int QSTG_OFF = MISC_OFF + 4096, QSTG_STRIDE = 1056, WSTG_OFF = QSTG_OFF + 16 * QSTG_STRIDE;
static_assert(WSTG_OFF + 512 <= LDS_BYTES, "lds map");
constexpr int SC_STRIDE = 2052;
static_assert(16 * SC_STRIDE * 4 <= SCR_BYTES && attn_body::ATTN_LDS_BYTES <= RING_BYTES && attn_body::LDS_QST + attn_body::LDS_QST_BYTES <= MISC_OFF + 1024, "lds map");

#define GAS __attribute__((address_space(1)))
#define LAS __attribute__((address_space(3)))
typedef unsigned short bf16;
typedef unsigned v4u __attribute__((ext_vector_type(4)));
typedef unsigned v2u __attribute__((ext_vector_type(2)));
typedef float f32x4 __attribute__((ext_vector_type(4)));
typedef short bf16x8 __attribute__((ext_vector_type(8)));
#define LDS_WAIT() asm volatile("s_waitcnt lgkmcnt(0)" ::: "memory")
__device__ __forceinline__ unsigned f2bf(float f) { unsigned u = __builtin_bit_cast(unsigned, f); return (u + 0x7fffu + ((u >> 16) & 1u)) >> 16; }
__device__ __forceinline__ unsigned pk2(float lo, float hi) { return f2bf(lo) | (f2bf(hi) << 16); }
__device__ __forceinline__ float bf2f(unsigned s) { return __uint_as_float(s << 16); }

#define XB_TMO      128
#define XB_XCNT(j)  (256  + 64 * (j))
#define XB_XSUB(j)  (1280 + 64 * (j))
#define XB_XGEN(j)  (2304 + 64 * (j))
#define XB_TOP      3328
#define XB_TOPGEN   3392
#define XCD_BAR_WORDS 3456
#define XB_SPIN_CAP (1u << 22)
__device__ __forceinline__ unsigned xb_ld(unsigned* p)              { return __hip_atomic_load(p, __ATOMIC_RELAXED, __HIP_MEMORY_SCOPE_AGENT); }
__device__ __forceinline__ unsigned xb_add(unsigned* p, unsigned v) { return __hip_atomic_fetch_add(p, v, __ATOMIC_RELAXED, __HIP_MEMORY_SCOPE_AGENT); }
__device__ __forceinline__ unsigned xb_xcc_id() { return (unsigned)__builtin_amdgcn_s_getreg((3 << 11) | 20) & 0xFu; }
#define XB_SPIN(cond, bar) do { unsigned _sp = 0; while (cond) { __builtin_amdgcn_s_sleep(1); \
    if ((++_sp & 255u) == 0u) { if (xb_ld(&(bar)[XB_TMO])) break; if (_sp > XB_SPIN_CAP) { atomicAdd(&(bar)[XB_TMO], 1u); break; } } } } while (0)
struct XcdBarrier { unsigned* bar; unsigned x; volatile LAS unsigned* st; };
__device__ __forceinline__ XcdBarrier xcd_barrier_post(unsigned* bar, volatile LAS unsigned* st, int tid) {
    XcdBarrier b; b.bar = bar; b.x = xb_xcc_id(); b.st = st;
    if (tid == 0) (void)xb_add(&bar[XB_XCNT(b.x)], 1u);
    return b;
}
__device__ __forceinline__ void xcd_barrier_complete(unsigned* bar, unsigned x, unsigned G, unsigned& nloc, unsigned& nx) {
    unsigned sum, cnt, mine, sp = 0u;
    for (;;) {
        sum = 0u; cnt = 0u; mine = 0u;
#pragma unroll
        for (unsigned j = 0; j < 16; ++j) { const unsigned c = xb_ld(&bar[XB_XCNT(j)]); sum += c; cnt += (c > 0u) ? 1u : 0u; mine = (j == x) ? c : mine; }
        if (sum == G) break;
        __builtin_amdgcn_s_sleep(1);
        if ((++sp & 255u) == 0u) { if (xb_ld(&bar[XB_TMO])) break; if (sp > XB_SPIN_CAP) { atomicAdd(&bar[XB_TMO], 1u); break; } }
    }
    nloc = mine > 0u ? mine : 1u; nx = cnt > 0u ? cnt : 1u;
}
__device__ __forceinline__ void xcd_barrier(const XcdBarrier& b, int tid, unsigned G) {
    asm volatile("s_waitcnt vmcnt(0)" ::: "memory");
    __syncthreads();
    if (tid == 0) {
        unsigned* bar = b.bar;
        __builtin_amdgcn_s_waitcnt(0);
        unsigned nloc = b.st[0], nx = b.st[1];
        if (nloc == 0u) { xcd_barrier_complete(bar, b.x, G, nloc, nx); b.st[0] = nloc; b.st[1] = nx; }
        const unsigned old = xb_add(&bar[XB_XSUB(b.x)], 1u);
        const unsigned gen = old / nloc;
        if (old + 1u == (gen + 1u) * nloc) {
            __builtin_amdgcn_fence(__ATOMIC_RELEASE, "agent");
            asm volatile("s_waitcnt vmcnt(0)" ::: "memory");
            const unsigned og = xb_add(&bar[XB_TOP], 1u);
            const unsigned tg = og / nx;
            if (og + 1u == (tg + 1u) * nx) xb_add(&bar[XB_TOPGEN], 1u);
            else XB_SPIN(xb_ld(&bar[XB_TOPGEN]) == tg, bar);
            __builtin_amdgcn_fence(__ATOMIC_ACQUIRE, "agent");
            xb_add(&bar[XB_XGEN(b.x)], 1u);
            asm volatile("s_waitcnt vmcnt(0)" ::: "memory");
        } else {
            XB_SPIN(xb_ld(&bar[XB_XGEN(b.x)]) == gen, bar);
            __builtin_amdgcn_fence(__ATOMIC_ACQUIRE, "agent");
            asm volatile("s_waitcnt vmcnt(0)" ::: "memory");
        }
    }
    __syncthreads();
}

struct Frame {
    LAS unsigned char* lds; unsigned char* ldsg;
    int tid, lane, wave, vcu, G;
    const float *x, *g_mix, *w_in, *w_pa, *w_pb, *w_out, *g_ffn, *w_group, *b_group, *w_expert, *b_expert, *w1, *w3, *w2, *g_final;
    float* out; unsigned char* ws;
};

__device__ __forceinline__ int lane_id_v() { int l; asm volatile("v_mbcnt_lo_u32_b32 %0, -1, 0\n\tv_mbcnt_hi_u32_b32 %0, -1, %0" : "=v"(l)); return l; }
__device__ __forceinline__ float wave_sum(float v) {
#pragma unroll
    for (int o = 1; o < 64; o <<= 1) v += __shfl_xor(v, o);
    return v;
}

struct P0Item { const float* sp; const float* kscale; bf16* WT; unsigned sstride; int K, nrow0, k0; float mulz; float f8scale; };
__device__ __forceinline__ void p0_load(const P0Item& d, int lane, float (&v)[32], f32x4& g0, f32x4& g1) {
    const int c = lane & 7; g0 = (f32x4){1.f, 1.f, 1.f, 1.f}; g1 = g0;
    if (d.kscale) { g0 = *(const GAS f32x4*)(d.kscale + d.k0 + 8 * c); g1 = *(const GAS f32x4*)(d.kscale + d.k0 + 8 * c + 4); }
#pragma unroll
    for (int i = 0; i < 32; ++i) { const int kk = 2 * i + (lane >> 5); v[i] = d.sp[(size_t)(d.k0 + kk) * d.sstride]; }
}
__device__ __forceinline__ void p0_finish(const P0Item& d, int lane, const float (&v)[32], LAS float* scr, f32x4 g0, f32x4 g1) {
#pragma unroll
    for (int i = 0; i < 32; ++i) { const int kk = 2 * i + (lane >> 5); scr[kk * 33 + (lane & 31)] = v[i] * d.mulz; }
    LDS_WAIT(); asm volatile("" ::: "memory");
    const int c = lane & 7;
    if (d.f8scale != 0.f) { g0 = g0 * d.f8scale; g1 = g1 * d.f8scale;
#pragma unroll
        for (int j = 0; j < 4; ++j) { const int n = (lane >> 3) + 8 * j; const LAS float* s = scr + (8 * c) * 33 + n;
            v2u o; o.x = pg8::cvt4_fp8(s[0 * 33] * g0[0], s[1 * 33] * g0[1], s[2 * 33] * g0[2], s[3 * 33] * g0[3]); o.y = pg8::cvt4_fp8(s[4 * 33] * g1[0], s[5 * 33] * g1[1], s[6 * 33] * g1[2], s[7 * 33] * g1[3]);
            *(GAS v2u*)((unsigned char*)d.WT + (size_t)(d.nrow0 + n) * d.K + d.k0 + 8 * c) = o; }
        LDS_WAIT(); asm volatile("" ::: "memory"); return; }
#pragma unroll
    for (int j = 0; j < 4; ++j) { const int n = (lane >> 3) + 8 * j; const LAS float* s = scr + (8 * c) * 33 + n;
        v4u o; o.x = pk2(s[0 * 33] * g0[0], s[1 * 33] * g0[1]); o.y = pk2(s[2 * 33] * g0[2], s[3 * 33] * g0[3]); o.z = pk2(s[4 * 33] * g1[0], s[5 * 33] * g1[1]); o.w = pk2(s[6 * 33] * g1[2], s[7 * 33] * g1[3]);
        *(GAS v4u*)(d.WT + (size_t)(d.nrow0 + n) * d.K + d.k0 + 8 * c) = o; }
    LDS_WAIT(); asm volatile("" ::: "memory");
}
__device__ __forceinline__ int cmap_in(int np) {
    const int tile = np >> 8, sl = np & 255, bj = sl >> 7, wc = (sl >> 5) & 3, rho = sl & 31;
    if (tile < 14) { const int seg = tile >> 1;
        if (seg == 2 || seg == 5) return (np & ~255) + pg8::perm16(sl);
        return (np & ~255) + 64 * wc + 32 * bj + pg8::perm32(rho); }
    if (tile == 14) { if (wc == 0) return 3584 + 32 * bj + pg8::perm32(rho); if (bj == 0 && wc == 1 && rho < 8) return 3648 + rho; return -1; }
    return 3656 + (tile - 15) * 256 + pg8::perm16(sl);
}
__device__ const double INV_FREQ[32] = {1.0, 0.7498942093324559, 0.5623413251903491, 0.4216965034285822, 0.31622776601683794, 0.23713737056616552, 0.1778279410038923, 0.1333521432163324, 0.09999999999999999, 0.07498942093324558, 0.056234132519034905, 0.042169650342858224, 0.03162277660168379, 0.023713737056616554, 0.01778279410038923, 0.013335214321633239, 0.01, 0.007498942093324559, 0.005623413251903491, 0.004216965034285822, 0.0031622776601683794, 0.002371373705661655, 0.0017782794100389228, 0.0013335214321633238, 0.001, 0.0007498942093324559, 0.000562341325190349, 0.00042169650342858224, 0.00031622776601683794, 0.00023713737056616554, 0.0001778279410038923, 0.0001333521432163324};
__device__ __forceinline__ void sincos_d(double a, float& c, float& s) {
    const double TWO_OVER_PI = 0.63661977236758134308, PIO2_HI = 1.57079632679489655800e+00, PIO2_LO = 6.12323399573676603587e-17;
    const double kf = __builtin_rint(a * TWO_OVER_PI); const long k = (long)kf;
    const double y = (a - kf * PIO2_HI) - kf * PIO2_LO, y2 = y * y;
    const double sp = y * (1.0 + y2 * (-1.0 / 6 + y2 * (1.0 / 120 + y2 * (-1.0 / 5040 + y2 * (1.0 / 362880 + y2 * (-1.0 / 39916800 + y2 * (1.0 / 6227020800.0)))))));
    const double cp = 1.0 + y2 * (-0.5 + y2 * (1.0 / 24 + y2 * (-1.0 / 720 + y2 * (1.0 / 40320 + y2 * (-1.0 / 3628800 + y2 * (1.0 / 479001600.0 + y2 * (-1.0 / 87178291200.0)))))));
    double sv, cv; switch (k & 3) { case 0: sv = sp; cv = cp; break; case 1: sv = cp; cv = -sp; break; case 2: sv = -sp; cv = -cp; break; default: sv = -cp; cv = sp; break; }
    c = (float)cv; s = (float)sv;
}

__device__ __forceinline__ void p0_prologue(Frame& F) {
    unsigned char* ws = F.ws;
    LAS float* scr = (LAS float*)(F.lds + F.wave * 16384);
    const int gw = F.vcu * NWAVES + F.wave, NGW = F.G * NWAVES, lane = F.lane;
    bf16* WinT = (bf16*)(ws + WS_WIN); bf16* WaT = (bf16*)(ws + WS_WA); bf16* WbT = (bf16*)(ws + WS_WB); bf16* WoutT = (bf16*)(ws + WS_WOUT);
    bf16* W13T = (bf16*)(ws + WS_W13); bf16* W2T = (bf16*)(ws + WS_W2);
    constexpr int I_INA = 16 * (NINA / 32), I_INB = 16 * (NINB / 32), I_IN = I_INA + I_INB, I_PA = 8 * 32, I_OUT = 16 * 32, I_13 = 16 * 32 * NEXP, I_2 = 8 * 32 * NEXP;
    constexpr int NITEMS = I_IN + 2 * I_PA + I_OUT;
    (void)I_13; (void)I_2; (void)W13T; (void)W2T;
    auto decode = [&](int it) -> P0Item { P0Item d; d.mulz = 1.0f; d.kscale = nullptr; d.f8scale = 0.f; int r = it;
        if (r < I_IN) { const int part = r >= I_INA ? 1 : 0; if (part) r -= I_INA; const int ng = (part ? NINB : NINA) / 32, nb = r % ng, kb = r / ng;
            const int col = cmap_in(pg8::in_tile_of(part, nb >> 3) * 256 + (nb & 7) * 32 + (lane & 31));
            d.sp = F.w_in + (col >= 0 ? col : 0); d.mulz = col >= 0 ? 1.0f : 0.0f; d.sstride = IN_COLS; d.kscale = F.g_mix; d.K = DMODEL; d.nrow0 = nb * 32; d.k0 = kb * 64;
            if (part) { d.WT = (bf16*)(ws + WS_WIN8); d.f8scale = 32.0f; } else d.WT = WinT; return d; } r -= I_IN;
        if (r < 2 * I_PA) { const bool second = r >= I_PA; if (second) r -= I_PA; const int nb = r % 32, kb = r / 32; const int col = (nb >> 3) * 256 + pg8::perm16((nb & 7) * 32 + (lane & 31));
            d.sp = (second ? F.w_pb : F.w_pa) + col; d.sstride = DMODEL; d.WT = second ? WbT : WaT; d.K = HW; d.f8scale = 16.0f; d.nrow0 = nb * 32; d.k0 = kb * 64; return d; } r -= 2 * I_PA;
        if (r < I_OUT) { const int nb = r % 32, kb = r / 32; d.sp = F.w_out + (nb >> 3) * 256 + pg8::perm16((nb & 7) * 32 + (lane & 31)); d.sstride = DMODEL; d.WT = WoutT; d.K = DMODEL; d.f8scale = 32.0f; d.nrow0 = nb * 32; d.k0 = kb * 64; return d; } r -= I_OUT;
        return d; };
    if (gw < NITEMS) { P0Item dA = decode(gw), dB = dA; float vA[32], vB[32]; f32x4 gA0, gA1, gB0, gB1; p0_load(dA, lane, vA, gA0, gA1);
        for (int it = gw;;) {
            const int itB = it + NGW; const bool hasB = itB < NITEMS; if (hasB) { dB = decode(itB); p0_load(dB, lane, vB, gB0, gB1); }
            p0_finish(dA, lane, vA, scr, gA0, gA1); if (!hasB) break;
            const int itA = itB + NGW; const bool hasA = itA < NITEMS; if (hasA) { dA = decode(itA); p0_load(dA, lane, vA, gA0, gA1); }
            p0_finish(dB, lane, vB, scr, gB0, gB1); if (!hasA) break;
            it = itA; } }
    { bf16* Wh = (bf16*)(ws + WS_WR); bf16* Wl = Wh + 48 * DMODEL;
      for (int i = (F.vcu * NWAVES * 64) + F.tid; i < 48 * DMODEL; i += F.G * NWAVES * 64) { const int n = i / DMODEL, k = i % DMODEL;
          float w = 0.f; if (n < 4) w = F.w_group[k * 4 + n]; else if (n < 36) w = F.w_expert[k * 32 + (n - 4)]; w *= F.g_ffn[k];
          const unsigned h = f2bf(w); const float lo = w - bf2f(h); Wh[i] = (bf16)h; Wl[i] = (bf16)f2bf(lo);
          ((unsigned char*)(ws + WS_WR8))[i] = (unsigned char)(pg8::cvt4_fp8(lo * 16384.0f, 0.f, 0.f, 0.f) & 0xffu); } }
    { bf16* XB = (bf16*)(ws + WS_XB); float* irstd1 = (float*)(ws + WS_RSTD1);
#define P0X_LOAD(V, M0) do { _Pragma("unroll") for (int r = 0; r < 4; ++r) { const GAS f32x4* xr = (const GAS f32x4*)(F.x + (size_t)((M0) + r) * DMODEL) + lane; \
          _Pragma("unroll") for (int j = 0; j < 4; ++j) V[r][j] = xr[64 * j]; } } while (0)
#define P0X_DONE(V, M0) do { _Pragma("unroll") for (int r = 0; r < 4; ++r) { float s = 0.f; \
          _Pragma("unroll") for (int j = 0; j < 4; ++j) s += (V[r][j].x * V[r][j].x + V[r][j].y * V[r][j].y) + (V[r][j].z * V[r][j].z + V[r][j].w * V[r][j].w); \
          s = wave_sum(s); const float irs = sqrtf(s * (1.0f / DMODEL) + RMS_EPS), rs = 1.0f / irs; if (lane == 0) irstd1[(M0) + r] = irs; \
          GAS unsigned long long* o8 = (GAS unsigned long long*)(XB + (size_t)((M0) + r) * DMODEL) + lane; GAS unsigned* q8 = (GAS unsigned*)(ws + WS_X8 + (size_t)((M0) + r) * DMODEL) + lane; \
          _Pragma("unroll") for (int j = 0; j < 4; ++j) { const f32x4 w = V[r][j] * rs; \
              o8[64 * j] = (unsigned long long)pk2(w.x, w.y) | ((unsigned long long)pk2(w.z, w.w) << 32); q8[64 * j] = pg8::cvt4_fp8(w.x, w.y, w.z, w.w); } } } while (0)
      const int mstep = NGW * 4; int m0 = gw * 4;
      if (m0 < T) { f32x4 va[4][4], vb[4][4]; P0X_LOAD(va, m0);
          for (;;) {
              const int m1 = m0 + mstep; const bool h1 = m1 < T; if (h1) P0X_LOAD(vb, m1);
              P0X_DONE(va, m0); if (!h1) break;
              const int m2 = m1 + mstep; const bool h2 = m2 < T; if (h2) P0X_LOAD(va, m2);
              P0X_DONE(vb, m1); if (!h2) break;
              m0 = m2; } }
#undef P0X_LOAD
#undef P0X_DONE
    }
}

__device__ __forceinline__ void p2_kbsum(Frame& F) {
    const bf16* KA = (const bf16*)(F.ws + WS_KA); float* kbsum = (float*)(F.ws + WS_KBSUM);
    const int gw = F.vcu * NWAVES + F.wave, NGW = F.G * NWAVES, lane = F.lane;
    for (int it = gw; it < NBATCH * NHEAD * 8; it += NGW) { const int j = it & 7, h = (it >> 3) & 7, b = it >> 6;
        const bf16* base = KA + ((size_t)(b * SEQ + j * 256 + (lane >> 3))) * HW + h * 64 + (lane & 7) * 8; float s[8];
#pragma unroll
        for (int k = 0; k < 8; ++k) s[k] = 0.f;
#pragma unroll 4
        for (int i = 0; i < 32; ++i) { const v4u w = *(const GAS v4u*)(base + (size_t)i * 8 * HW);
#pragma unroll
            for (int k = 0; k < 4; ++k) { s[2 * k] += bf2f(w[k] & 0xffffu); s[2 * k + 1] += __uint_as_float(w[k] & 0xffff0000u); } }
#pragma unroll
        for (int k = 0; k < 8; ++k) { s[k] += __shfl_xor(s[k], 8); s[k] += __shfl_xor(s[k], 16); s[k] += __shfl_xor(s[k], 32); }
        if (lane < 8) { float* o = kbsum + (size_t)it * 64 + lane * 8; *(f32x4*)o = (f32x4){s[0], s[1], s[2], s[3]}; *(f32x4*)(o + 4) = (f32x4){s[4], s[5], s[6], s[7]}; } }
}

__device__ __forceinline__ int wsum6(int c) { int tot = 0;
#pragma unroll
    for (int b = 0; b < 6; ++b) tot += __popcll(__ballot((c >> b) & 1)) << b;
    return tot; }
__device__ __forceinline__ int sel_cnt_ge(const unsigned (&key)[32], int nq, unsigned cand) { int c = 0;
    const unsigned cs = (unsigned)__builtin_amdgcn_readfirstlane((int)cand);
#pragma unroll
    for (int q = 0; q < 8; ++q) { if (q < nq) { unsigned long long m0, m1, m2, m3;
        asm volatile("v_cmp_le_u32_e64 %0, %4, %5\n\tv_cmp_le_u32_e64 %1, %4, %6\n\tv_cmp_le_u32_e64 %2, %4, %7\n\tv_cmp_le_u32_e64 %3, %4, %8"
                     : "=&s"(m0), "=&s"(m1), "=&s"(m2), "=&s"(m3) : "s"(cs), "v"(key[4 * q]), "v"(key[4 * q + 1]), "v"(key[4 * q + 2]), "v"(key[4 * q + 3]));
        c += (__popcll(m0) + __popcll(m1)) + (__popcll(m2) + __popcll(m3)); } }
    return c; }
#define SEL_CMP4(q) asm volatile("v_cmp_le_u32_e64 %0, %4, %5\n\tv_cmp_le_u32_e64 %1, %4, %6\n\tv_cmp_le_u32_e64 %2, %4, %7\n\tv_cmp_le_u32_e64 %3, %4, %8" \
        : "=&s"(m[q][0]), "=&s"(m[q][1]), "=&s"(m[q][2]), "=&s"(m[q][3]) : "s"(cs), "v"(key[4 * (q)]), "v"(key[4 * (q) + 1]), "v"(key[4 * (q) + 2]), "v"(key[4 * (q) + 3]))
template <int NQ> __device__ __forceinline__ int sel_cnt_ge_t(const unsigned (&key)[32], unsigned cand) {
    const unsigned cs = (unsigned)__builtin_amdgcn_readfirstlane((int)cand); unsigned long long m[NQ][4]; int c = 0;
    SEL_CMP4(0);
#pragma unroll
    for (int q = 0; q < NQ; ++q) { if (q + 1 < NQ) SEL_CMP4(q + 1); c += (__popcll(m[q][0]) + __popcll(m[q][1])) + (__popcll(m[q][2]) + __popcll(m[q][3])); }
    return c; }
template <int NQ> __device__ __forceinline__ void sel_bisect_full(const unsigned (&key)[32], const unsigned M, unsigned& lo, unsigned& hi, int& clo, int& chi, bool& exact) {
    { const unsigned lo0 = (M > (4u << 23)) ? M - (4u << 23) : 0u;
      if (lo0 > 0u) { const int c0 = sel_cnt_ge_t<NQ>(key, lo0); if (c0 >= 256) { lo = lo0; clo = c0; exact = (c0 == 256); } else { hi = lo0; chi = c0; } } }
#pragma unroll 1
    while (!exact && hi - lo > 1u && clo - chi > 64) { const unsigned mid = lo + ((hi - lo) >> 1);
        const int tot = sel_cnt_ge_t<NQ>(key, mid);
        if (tot >= 256) { lo = mid; clo = tot; exact = (tot == 256); } else { hi = mid; chi = tot; } }
}
__device__ __forceinline__ int sel_cnt_eq_lt(const unsigned (&key)[32], int nq, unsigned val, int cx, int lane) { int c = 0;
#pragma unroll
    for (int q = 0; q < 8; ++q) { if (q < nq) {
#pragma unroll
        for (int k = 0; k < 4; ++k) c += __popcll(__ballot(key[4 * q + k] == val && (64 * (4 * q + k) + lane) < cx)); } }
    return c; }
__device__ __forceinline__ unsigned wave_max_u32(unsigned v) {
    int x = (int)v;
    { const int t = __builtin_amdgcn_update_dpp(x, x, 0xB1, 0xF, 0xF, false); x = (int)max((unsigned)x, (unsigned)t); }
    { const int t = __builtin_amdgcn_update_dpp(x, x, 0x4E, 0xF, 0xF, false); x = (int)max((unsigned)x, (unsigned)t); }
    { const int t = __builtin_amdgcn_update_dpp(x, x, 0x141, 0xF, 0xF, false); x = (int)max((unsigned)x, (unsigned)t); }
    { const int t = __builtin_amdgcn_update_dpp(x, x, 0x140, 0xF, 0xF, false); x = (int)max((unsigned)x, (unsigned)t); }
    const unsigned a = (unsigned)__builtin_amdgcn_readlane(x, 0), b = (unsigned)__builtin_amdgcn_readlane(x, 16), c = (unsigned)__builtin_amdgcn_readlane(x, 32), d = (unsigned)__builtin_amdgcn_readlane(x, 48);
    return max(max(a, b), max(c, d));
}
struct SelStep { int b, g, half; };
__device__ __forceinline__ void sel_load_q(Frame& F, const SelStep st, bf16x8 (&bq)[8][2], float (&w8)[8]) {
    const bf16* QI = (const bf16*)(F.ws + WS_QI); const float* WI = (const float*)(F.ws + WS_WI);
    const int qidx = F.lane & 15, kc = F.lane >> 4; const size_t qrow = (size_t)(st.b * SEQ + st.g * 32 + st.half * 16 + qidx);
#pragma unroll
    for (int h = 0; h < 8; ++h) {
#pragma unroll
        for (int ks = 0; ks < 2; ++ks) bq[h][ks] = *(const GAS bf16x8*)(QI + qrow * HW + h * 64 + ks * 32 + kc * 8); }
    const f32x4 a = *(const GAS f32x4*)(WI + qrow * 8), c = *(const GAS f32x4*)(WI + qrow * 8 + 4); w8[0] = a[0]; w8[1] = a[1]; w8[2] = a[2]; w8[3] = a[3]; w8[4] = c[0]; w8[5] = c[1]; w8[6] = c[2]; w8[7] = c[3];
}
__device__ __forceinline__ void sel_stage_q(Frame& F, const SelStep st) {
    const size_t qrow0 = (size_t)(st.b * SEQ + st.g * 32 + st.half * 16); const unsigned lds0 = (unsigned)(uintptr_t)F.lds;
#pragma unroll
    for (int rr = 0; rr < 2; ++rr) { const int row = 2 * F.wave + rr;
        attn_body::glds16((const char*)(F.ws + WS_QI) + (qrow0 + row) * (HW * 2) + F.lane * 16, (unsigned)__builtin_amdgcn_readfirstlane((int)(lds0 + QSTG_OFF + row * QSTG_STRIDE))); }
    if (F.wave == 0 && F.lane < 32) attn_body::glds16((const char*)(F.ws + WS_WI) + qrow0 * 32 + F.lane * 16, (unsigned)__builtin_amdgcn_readfirstlane((int)(lds0 + WSTG_OFF)));
}
__device__ __forceinline__ void sel_load_q_lds(Frame& F, bf16x8 (&bq)[8][2], float (&w8)[8]) {
    const int qidx = F.lane & 15, kc = F.lane >> 4; LAS char* q = (LAS char*)(F.lds + QSTG_OFF + qidx * QSTG_STRIDE + kc * 16);
#pragma unroll
    for (int h = 0; h < 8; ++h) {
#pragma unroll
        for (int ks = 0; ks < 2; ++ks) bq[h][ks] = *(const LAS bf16x8*)(q + h * 128 + ks * 64); }
    const f32x4 a = *(const LAS f32x4*)(F.lds + WSTG_OFF + qidx * 32), c = *(const LAS f32x4*)(F.lds + WSTG_OFF + qidx * 32 + 16); w8[0] = a[0]; w8[1] = a[1]; w8[2] = a[2]; w8[3] = a[3]; w8[4] = c[0]; w8[5] = c[1]; w8[6] = c[2]; w8[7] = c[3];
}
__device__ __forceinline__ void sel_scores(Frame& F, const SelStep st, const bf16x8 (&bq)[8][2], const float (&w8)[8]) {
    const bf16* KI = (const bf16*)(F.ws + WS_KI); LAS float* sc = (LAS float*)F.lds;
    const int lane = F.lane, wave = F.wave, qidx = lane & 15, kc = lane >> 4, b = st.b;
    const int ntg = __builtin_amdgcn_readfirstlane((st.g + 2) >> 1), nsub = ntg * 4;
    const int nit = (nsub + 7) >> 3, ngrp = (nit + 3) >> 2;
    bf16x8 A0[4], A1[4], B0[4], B1[4];
#define SEL_LOADG(X0, X1, gi) do { _Pragma("unroll") for (int u = 0; u < 4; ++u) { int st_ = wave + 8 * (4 * (gi) + u); st_ = st_ < nsub ? st_ : nsub - 1; \
        const bf16* kp_ = KI + (size_t)(b * SEQ + st_ * 16 + qidx) * 64 + kc * 8; X0[u] = *(const GAS bf16x8*)kp_; X1[u] = *(const GAS bf16x8*)(kp_ + 32); } } while (0)
#define SEL_COMPG(X0, X1, gi) do { _Pragma("unroll") for (int u = 0; u < 4; ++u) { const int st_ = wave + 8 * (4 * (gi) + u); if (st_ < nsub) { f32x4 s_ = {0.f, 0.f, 0.f, 0.f}; \
        _Pragma("unroll") for (int h = 0; h < 8; ++h) { f32x4 d_ = __builtin_amdgcn_mfma_f32_16x16x32_bf16(X0[u], bq[h][0], (f32x4){0.f, 0.f, 0.f, 0.f}, 0, 0, 0); \
            d_ = __builtin_amdgcn_mfma_f32_16x16x32_bf16(X1[u], bq[h][1], d_, 0, 0, 0); \
            _Pragma("unroll") for (int k = 0; k < 4; ++k) s_[k] += w8[h] * __int_as_float(max(__float_as_int(d_[k]), 0)); }   \
        *(LAS f32x4*)(sc + qidx * SC_STRIDE + st_ * 16 + 4 * kc) = s_; } } } while (0)
    SEL_LOADG(A0, A1, 0);
    for (int gi = 0; gi < ngrp; gi += 2) {
        if (gi + 1 < ngrp) SEL_LOADG(B0, B1, gi + 1);
        SEL_COMPG(A0, A1, gi);
        if (gi + 1 < ngrp) { if (gi + 2 < ngrp) SEL_LOADG(A0, A1, gi + 2); SEL_COMPG(B0, B1, gi + 1); }
    }
#undef SEL_LOADG
#undef SEL_COMPG
}
__device__ __forceinline__ void sel_rows(Frame& F, const SelStep st) {
    unsigned long long* maskw = (unsigned long long*)(F.ws + WS_MASK); LAS float* sc = (LAS float*)F.lds;
    const int lane = F.lane, wave = F.wave, b = st.b;
    const int ntg = __builtin_amdgcn_readfirstlane((st.g + 2) >> 1), nq = (ntg + 3) >> 2; const int qh = st.g * 32 + st.half * 16;
    LAS int* rowctr = (LAS int*)(F.lds + MISC_OFF + 3072);
    for (;;) { int row_ = 0; if (lane == 0) row_ = __hip_atomic_fetch_add(rowctr, 1, __ATOMIC_RELAXED, __HIP_MEMORY_SCOPE_WORKGROUP);
        const int row = __builtin_amdgcn_readfirstlane(row_); if (row >= 16) break;
        const int t = __builtin_amdgcn_readfirstlane(qh + row);
        unsigned key[32]; unsigned mx = 0u;
#pragma unroll
        for (int q = 0; q < 8; ++q) {
#pragma unroll
            for (int k = 0; k < 4; ++k) key[4 * q + k] = 0u;
            if (q < nq) {
#pragma unroll
                for (int k = 0; k < 4; ++k) { const int j = 4 * q + k; const float v = sc[row * SC_STRIDE + 64 * j + lane]; const unsigned u = __float_as_uint(v);
                    const unsigned kk = (u & 0x80000000u) ? ~u : (u | 0x80000000u); key[j] = (64 * j + lane <= t) ? kk : 0u; mx = max(mx, key[j]); } } }
        const unsigned M = wave_max_u32(mx);
        unsigned lo = 0u, hi = M + 1u; int clo = 1 << 20, chi = 0; bool exact = false;
        switch (nq) { case 2: sel_bisect_full<2>(key, M, lo, hi, clo, chi, exact); break; case 3: sel_bisect_full<3>(key, M, lo, hi, clo, chi, exact); break;
            case 4: sel_bisect_full<4>(key, M, lo, hi, clo, chi, exact); break; case 5: sel_bisect_full<5>(key, M, lo, hi, clo, chi, exact); break;
            case 6: sel_bisect_full<6>(key, M, lo, hi, clo, chi, exact); break; case 7: sel_bisect_full<7>(key, M, lo, hi, clo, chi, exact); break;
            default: sel_bisect_full<8>(key, M, lo, hi, clo, chi, exact); break; }
        if (!exact && hi - lo > 1u) {
            LAS unsigned* cb = (LAS unsigned*)(sc + row * SC_STRIDE); int base = 0; const unsigned wdt = hi - lo;
#pragma unroll
            for (int q = 0; q < 8; ++q) { if (q < nq) {
#pragma unroll
                for (int k = 0; k < 4; ++k) { const int j = 4 * q + k; const bool inb = (key[j] - lo) < wdt; const unsigned long long m = __ballot(inb);
                    const int pos = base + (int)__builtin_amdgcn_mbcnt_hi((unsigned)(m >> 32), __builtin_amdgcn_mbcnt_lo((unsigned)m, 0u));
                    cb[inb ? pos : 64 + lane] = key[j]; base += __popcll(m); } } }
            LDS_WAIT(); asm volatile("" ::: "memory");
            unsigned cand = cb[lane]; LDS_WAIT(); cand = (lane < base) ? cand : 0u;
#pragma unroll 1
            while (!exact && hi - lo > 1u) { const unsigned mid = lo + ((hi - lo) >> 1);
                const int tot = chi + __popcll(__ballot(cand >= mid));
                if (tot >= 256) { lo = mid; exact = (tot == 256); } else hi = mid; } }
        unsigned P; int xcut;
        if (exact) { P = lo - 1u; xcut = -1; }
        else {
            const int need = 256 - sel_cnt_ge(key, nq, lo + 1u); int xx = 0;
#pragma unroll 1
            for (int bit = 10; bit >= 0; --bit) { const int cx = xx | (1 << bit);
                if (sel_cnt_eq_lt(key, nq, lo, cx, lane) < need) xx = cx; }
            P = lo; xcut = xx; }
        int mlo = 0, mhi = 0;
        if (exact) {
            const unsigned cs = (unsigned)__builtin_amdgcn_readfirstlane((int)lo); unsigned long long m[8][4];
#define SEL_WL(q, k) do { const int a_ = (int)(unsigned)m[q][k], b_ = (int)(unsigned)(m[q][k] >> 32); \
                asm volatile("v_writelane_b32 %0, %1, %2" : "+v"(mlo) : "s"(a_), "n"(4 * (q) + (k))); asm volatile("v_writelane_b32 %0, %1, %2" : "+v"(mhi) : "s"(b_), "n"(4 * (q) + (k))); } while (0)
#define SEL_EX4(q) do { if ((q) < nq) { SEL_CMP4(q); SEL_WL(q, 0); SEL_WL(q, 1); SEL_WL(q, 2); SEL_WL(q, 3); } } while (0)
            SEL_EX4(0); SEL_EX4(1); SEL_EX4(2); SEL_EX4(3); SEL_EX4(4); SEL_EX4(5); SEL_EX4(6); SEL_EX4(7);
#undef SEL_EX4
#undef SEL_WL
        } else {
#define SEL_EMIT(j) do { const bool al = (key[j] > P) || (key[j] == P && (64 * (j) + lane) <= xcut); \
            const unsigned long long m = __ballot(al); const int m0_ = (int)(unsigned)m, m1_ = (int)(unsigned)(m >> 32); \
            asm volatile("v_writelane_b32 %0, %1, %2" : "+v"(mlo) : "s"(m0_), "n"(j)); asm volatile("v_writelane_b32 %0, %1, %2" : "+v"(mhi) : "s"(m1_), "n"(j)); } while (0)
#define SEL_EMIT4(q) do { if ((q) < nq) { SEL_EMIT(4 * (q)); SEL_EMIT(4 * (q) + 1); SEL_EMIT(4 * (q) + 2); SEL_EMIT(4 * (q) + 3); } } while (0)
        SEL_EMIT4(0); SEL_EMIT4(1); SEL_EMIT4(2); SEL_EMIT4(3); SEL_EMIT4(4); SEL_EMIT4(5); SEL_EMIT4(6); SEL_EMIT4(7);
#undef SEL_EMIT4
#undef SEL_EMIT
        }
        if (lane < 32) maskw[(size_t)(b * SEQ + t) * 32 + lane] = ((unsigned long long)(unsigned)mhi << 32) | (unsigned long long)(unsigned)mlo;
    }
}
constexpr int MW_I13 = 16 * 32 * NEXP, MW_I2 = 8 * 32 * NEXP, MW_ITEMS = MW_I13 + MW_I2;
struct MwItem { const float* sp; unsigned sstride; unsigned char* wt; const float* ks; float f8; };
__device__ __forceinline__ MwItem mw_decode(Frame& F, int it, int lane) { MwItem d; asm volatile("" : "+v"(lane));
    const int h = lane >> 5;
    if (it < MW_I13) { const int e = it / 512, r = it % 512, nb = r % 32, kb = r / 32;
        d.sp = (((nb >> 2) & 1) ? F.w3 : F.w1) + (size_t)e * DMODEL * EFF + 128 * (nb >> 3) + 32 * (nb & 3) + pg8::perm32(lane & 31) + (size_t)(kb * 64 + 32 * h) * EFF; d.sstride = EFF;
        d.wt = F.ws + WS_W13 + (size_t)e * 1024 * DMODEL + (size_t)(nb * 32 + (lane & 31)) * DMODEL + kb * 64 + 32 * h; d.ks = F.g_ffn + kb * 64; d.f8 = 32.0f; }
    else { const int r0 = it - MW_I13, e = r0 / 256, r = r0 % 256, nb = r % 32, kb = r / 32; const int col = (nb >> 3) * 256 + pg8::perm16((nb & 7) * 32 + (lane & 31));
        d.sp = F.w2 + (size_t)e * EFF * DMODEL + col + (size_t)(kb * 64 + 32 * h) * DMODEL; d.sstride = DMODEL;
        d.wt = F.ws + WS_W2 + (size_t)e * DMODEL * EFF + (size_t)(nb * 32 + (lane & 31)) * EFF + kb * 64 + 32 * h; d.ks = nullptr; d.f8 = 16.0f; }
    return d; }
__device__ __forceinline__ void mw_load(const MwItem& d, int lane, float (&v)[32], float& gv) {
#pragma unroll
    for (int i = 0; i < 32; ++i) v[i] = d.sp[(size_t)i * d.sstride];
    gv = d.ks ? d.ks[lane] : 1.0f; }
__device__ __forceinline__ void mw_finish(const MwItem& d, int lane, const float (&v)[32], float gv) {
    asm volatile("" : "+v"(lane)); const int src = (lane & 32); gv *= d.f8; unsigned w[8];
#pragma unroll
    for (int c = 0; c < 8; ++c) { float t[4];
#pragma unroll
        for (int k = 0; k < 4; ++k) t[k] = v[4 * c + k] * __shfl(gv, src + 4 * c + k);
        w[c] = pg8::cvt4_fp8(t[0], t[1], t[2], t[3]); }
    v4u o0, o1; o0.x = w[0]; o0.y = w[1]; o0.z = w[2]; o0.w = w[3]; o1.x = w[4]; o1.y = w[5]; o1.z = w[6]; o1.w = w[7];
    *(GAS v4u*)d.wt = o0; *(GAS v4u*)(d.wt + 16) = o1; }
__device__ __forceinline__ void p2_select(Frame& F) {
    const int nitems = (F.G == 256) ? 7 : ((NBATCH * 56 - F.vcu + F.G - 1) / F.G), nsteps = 2 * nitems;
    auto decode = [&](int s) -> SelStep { SelStep st; const int r = s >> 1; st.half = s & 1;
        if (F.G == 256) { st.b = F.vcu >> 3; const int c = F.vcu & 7; st.g = 8 + 8 * r + ((r & 1) ? 7 - c : c); }
        else { const int I = F.vcu + r * F.G; st.b = I / 56; st.g = 8 + I % 56; }
        return st; };
    if (nsteps <= 0) return;
    const int gw = F.vcu * NWAVES + F.wave, NGW = F.G * NWAVES;
    sel_stage_q(F, decode(0)); asm volatile("s_waitcnt vmcnt(0)" ::: "memory"); __syncthreads();
    for (int s = 0; s < nsteps; ++s) {
        { int l_ = F.lane; asm volatile("" : "+v"(l_)); F.lane = l_; }
        const SelStep st = decode(s); bf16x8 qA[8][2]; float wA[8];
        const int mit = gw + NGW * s; const bool mw = mit < MW_ITEMS; float mv[32], mg = 1.0f;
        if (F.tid == 0) *(LAS int*)(F.lds + MISC_OFF + 3072) = 0;
        sel_load_q_lds(F, qA, wA); sel_scores(F, st, qA, wA); __syncthreads();
        if (s + 1 < nsteps) sel_stage_q(F, decode(s + 1));
        if (mw) { const MwItem md = mw_decode(F, mit, F.lane); mw_load(md, F.lane, mv, mg); }
        sel_rows(F, st);
        if (mw) { const MwItem md = mw_decode(F, mit, F.lane); mw_finish(md, F.lane, mv, mg); }
        asm volatile("s_waitcnt vmcnt(0)" ::: "memory");
        __syncthreads(); }
    for (int mit = gw + NGW * nsteps; mit < MW_ITEMS; mit += NGW) { float mv[32], mg; const MwItem md = mw_decode(F, mit, F.lane); mw_load(md, F.lane, mv, mg); mw_finish(md, F.lane, mv, mg); }
}

__device__ __forceinline__ void p6_router(Frame& F, bool dummy) {
    const bf16* XH = (const bf16*)(F.ws + WS_X1H); const unsigned char* XL = (const unsigned char*)(F.ws + WS_X1L); float* rstd2 = (float*)(F.ws + WS_RSTD2);
    const bf16* Wh = (const bf16*)(F.ws + WS_WR); const bf16* Wl = Wh + 48 * DMODEL;
    int* tokl = (int*)(F.ws + WS_TOK); float* gate = (float*)(F.ws + WS_GATE); unsigned* gcnt = (unsigned*)(F.ws + WS_CTL) + CW_CNT + (dummy ? 32 : 0);
    LAS float* lg = (LAS float*)F.lds + F.wave * (16 * 48);
    LAS int* hist = (LAS int*)(F.lds + 32768); LAS int* base = hist + 32;
    LAS int* aE = (LAS int*)(F.lds + 36864); LAS int* aP = aE + 512; LAS float* aG = (LAS float*)(aP + 512); LAS float* aR = aG + 512;
    float* rsort = (float*)(F.ws + WS_RSORT); float* gsort = (float*)(F.ws + WS_GSORT);
    const int lane = F.lane, wave = F.wave, tk = lane & 15, kc = lane >> 4;
    constexpr int WLDS_OFF = 49152, WLDS_STRIDE = 2080;
    { LAS char* wl_ = (LAS char*)(F.lds + WLDS_OFF);
      for (int i = F.tid; i < 37 * 128; i += NWAVES * 64) { const int row = i >> 7, ch = i & 127; v4u v = {0u, 0u, 0u, 0u};
          if (row < 36) v = *(const GAS v4u*)((const GAS char*)Wh + (size_t)(row * 2048 + ch * 16));
          *(LAS v4u*)(wl_ + row * WLDS_STRIDE + ch * 16) = v; } }
    for (int st = F.vcu; st < T / 256; st += F.G) {
        if (F.tid < 32) hist[F.tid] = 0;
        __syncthreads();
        const int rbase = st * 256 + wave * 32;
        f32x4 acc[2][3], accs[2];
#pragma unroll
        for (int tt = 0; tt < 2; ++tt) { accs[tt] = (f32x4){0.f, 0.f, 0.f, 0.f};
#pragma unroll
            for (int nt = 0; nt < 3; ++nt) acc[tt][nt] = (f32x4){0.f, 0.f, 0.f, 0.f}; }
        unsigned w8o[3], xof[2], lof[2]; const unsigned char* W8 = (const unsigned char*)(F.ws + WS_WR8);
#pragma unroll
        for (int nt = 0; nt < 3; ++nt) { w8o[nt] = (unsigned)((nt * 16 + tk) * DMODEL + kc * 8); asm volatile("" : "+v"(w8o[nt])); }
#pragma unroll
        for (int tt = 0; tt < 2; ++tt) { lof[tt] = (unsigned)((rbase + tt * 16 + tk) * DMODEL + kc * 8); xof[tt] = lof[tt] * 2u; asm volatile("" : "+v"(xof[tt])); asm volatile("" : "+v"(lof[tt])); }
        bf16x8 whA[3]; v2u w80[3], w81[3], w82[3], w83[3], w84[3], w85[3], w86[3], w87[3]; bf16x8 xh0[2], xh1[2], xh2[2], xh3[2], xh4[2], xh5[2], xh6[2], xh7[2]; v2u xl0[2], xl1[2], xl2[2], xl3[2], xl4[2], xl5[2], xl6[2], xl7[2];
#define P6_LOADW(WH, kk) do { _Pragma("unroll") for (int nt = 0; nt < 3; ++nt) WH[nt] = *(const LAS bf16x8*)(F.lds + (WLDS_OFF + ((nt * 16 + tk) < 36 ? (nt * 16 + tk) : 36) * WLDS_STRIDE + kc * 16) + (kk) * 64); } while (0)
#define P6_LOADWL(W8r, kk) do { _Pragma("unroll") for (int nt = 0; nt < 3; ++nt) W8r[nt] = *(const GAS v2u*)((const GAS char*)W8 + (size_t)(w8o[nt] + (unsigned)((kk) * 32))); } while (0)
#define P6_LOADX(XHr, XLr, kk) do { _Pragma("unroll") for (int tt = 0; tt < 2; ++tt) { \
            XHr[tt] = *(const GAS bf16x8*)((const GAS char*)XH + (size_t)(xof[tt] + (unsigned)((kk) * 64))); XLr[tt] = *(const GAS v2u*)((const GAS char*)XL + (size_t)(lof[tt] + (unsigned)((kk) * 32))); } } while (0)
#define P6_COMP(WH, W8r, XHr, XLr, kk) do { bf16x8 WL[3]; \
        _Pragma("unroll") for (int nt = 0; nt < 3; ++nt) { typedef float v2f_ __attribute__((ext_vector_type(2))); const v2u l8 = W8r[nt]; v4u lw_; \
            const v2f_ a0 = __builtin_amdgcn_cvt_pk_f32_fp8((int)l8.x, false), a1 = __builtin_amdgcn_cvt_pk_f32_fp8((int)l8.x, true), c0 = __builtin_amdgcn_cvt_pk_f32_fp8((int)l8.y, false), c1 = __builtin_amdgcn_cvt_pk_f32_fp8((int)l8.y, true); \
            lw_.x = pg8::cvt_pk_bf16(a0.x * (1.0f / 16384.0f), a0.y * (1.0f / 16384.0f)); lw_.y = pg8::cvt_pk_bf16(a1.x * (1.0f / 16384.0f), a1.y * (1.0f / 16384.0f)); \
            lw_.z = pg8::cvt_pk_bf16(c0.x * (1.0f / 16384.0f), c0.y * (1.0f / 16384.0f)); lw_.w = pg8::cvt_pk_bf16(c1.x * (1.0f / 16384.0f), c1.y * (1.0f / 16384.0f)); WL[nt] = __builtin_bit_cast(bf16x8, lw_); } \
        _Pragma("unroll") for (int tt = 0; tt < 2; ++tt) { const bf16x8 xh = XHr[tt]; bf16x8 xl; \
            { typedef float v2f_ __attribute__((ext_vector_type(2))); const v2u l8 = XLr[tt]; v4u lw_; \
              const v2f_ a0 = __builtin_amdgcn_cvt_pk_f32_fp8((int)l8.x, false), a1 = __builtin_amdgcn_cvt_pk_f32_fp8((int)l8.x, true), c0 = __builtin_amdgcn_cvt_pk_f32_fp8((int)l8.y, false), c1 = __builtin_amdgcn_cvt_pk_f32_fp8((int)l8.y, true); \
              lw_.x = pg8::cvt_pk_bf16(a0.x * (1.0f / 512.0f), a0.y * (1.0f / 512.0f)); lw_.y = pg8::cvt_pk_bf16(a1.x * (1.0f / 512.0f), a1.y * (1.0f / 512.0f)); \
              lw_.z = pg8::cvt_pk_bf16(c0.x * (1.0f / 512.0f), c0.y * (1.0f / 512.0f)); lw_.w = pg8::cvt_pk_bf16(c1.x * (1.0f / 512.0f), c1.y * (1.0f / 512.0f)); xl = __builtin_bit_cast(bf16x8, lw_); } \
            accs[tt] = __builtin_amdgcn_mfma_f32_16x16x32_bf16(xh, xh, accs[tt], 0, 0, 0); \
            _Pragma("unroll") for (int nt = 0; nt < 3; ++nt) { \
                acc[tt][nt] = __builtin_amdgcn_mfma_f32_16x16x32_bf16(WH[nt], xh, acc[tt][nt], 0, 0, 0); \
                acc[tt][nt] = __builtin_amdgcn_mfma_f32_16x16x32_bf16(WL[nt], xh, acc[tt][nt], 0, 0, 0); \
                acc[tt][nt] = __builtin_amdgcn_mfma_f32_16x16x32_bf16(WH[nt], xl, acc[tt][nt], 0, 0, 0); } } } while (0)
        P6_LOADWL(w80, 0); P6_LOADX(xh0, xl0, 0); P6_LOADWL(w81, 1); P6_LOADX(xh1, xl1, 1); P6_LOADWL(w82, 2); P6_LOADX(xh2, xl2, 2); P6_LOADWL(w83, 3); P6_LOADX(xh3, xl3, 3);
        P6_LOADWL(w84, 4); P6_LOADX(xh4, xl4, 4); P6_LOADWL(w85, 5); P6_LOADX(xh5, xl5, 5); P6_LOADWL(w86, 6); P6_LOADX(xh6, xl6, 6);
#define P6_SLOT(WHc, WHn, W8c, W8n, XHc, XLc, XHn, XLn, k) do { P6_LOADW(whA, k); if ((k) + 7 < 32) { P6_LOADWL(W8n, (k) + 7); P6_LOADX(XHn, XLn, (k) + 7); } P6_COMP(whA, W8c, XHc, XLc, k); } while (0)
#pragma unroll 1
        for (int kk = 0; kk < 32; kk += 8) {
            P6_SLOT(whA, whA, w80, w87, xh0, xl0, xh7, xl7, kk);     P6_SLOT(whA, whA, w81, w80, xh1, xl1, xh0, xl0, kk + 1);
            P6_SLOT(whA, whA, w82, w81, xh2, xl2, xh1, xl1, kk + 2); P6_SLOT(whA, whA, w83, w82, xh3, xl3, xh2, xl2, kk + 3);
            P6_SLOT(whA, whA, w84, w83, xh4, xl4, xh3, xl3, kk + 4); P6_SLOT(whA, whA, w85, w84, xh5, xl5, xh4, xl4, kk + 5);
            P6_SLOT(whA, whA, w86, w85, xh6, xl6, xh5, xl5, kk + 6); P6_SLOT(whA, whA, w87, w86, xh7, xl7, xh6, xl6, kk + 7);
        }
#undef P6_SLOT
#undef P6_LOADW
#undef P6_LOADWL
#undef P6_LOADX
#undef P6_COMP
        for (int tt = 0; tt < 2; ++tt) { const int r0 = rbase + tt * 16;
            const f32x4 dg = tt == 0 ? accs[0] : accs[1]; const int rsel = tk & 3;
            float sst = rsel == 0 ? dg[0] : rsel == 1 ? dg[1] : rsel == 2 ? dg[2] : dg[3]; sst = (kc == (tk >> 2)) ? sst : 0.f;
            sst += __shfl_xor(sst, 16); sst += __shfl_xor(sst, 32);
            const float rs = 1.0f / sqrtf(sst * (1.0f / DMODEL) + RMS_EPS);
#pragma unroll
            for (int nt = 0; nt < 3; ++nt)
#pragma unroll
                for (int k = 0; k < 4; ++k) lg[tk * 48 + nt * 16 + 4 * kc + k] = (tt == 0 ? acc[0][nt][k] : acc[1][nt][k]) * rs;
            LDS_WAIT(); asm volatile("" ::: "memory");
            if (lane < 16) { const int tokid = r0 + lane; rstd2[tokid] = rs; aR[wave * 32 + tt * 16 + lane] = rs;
                const LAS float* L = lg + lane * 48;
                float gl[4];
#pragma unroll
                for (int k = 0; k < 4; ++k) gl[k] = L[k] + F.b_group[k];
                int gs = 0; float gm = gl[0];
#pragma unroll
                for (int k = 1; k < 4; ++k) if (gl[k] > gm) { gm = gl[k]; gs = k; }
                float gz = 0.f;
#pragma unroll
                for (int k = 0; k < 4; ++k) gz += __expf(gl[k] - gm);
                const float gwt = 1.0f / gz;
                float el[8];
#pragma unroll
                for (int k = 0; k < 8; ++k) el[k] = L[4 + 8 * gs + k] + F.b_expert[8 * gs + k];
                int ia = 0; float ea = el[0];
#pragma unroll
                for (int k = 1; k < 8; ++k) if (el[k] > ea) { ea = el[k]; ia = k; }
                int ib = -1; float eb = -INFINITY;
#pragma unroll
                for (int k = 0; k < 8; ++k) if (k != ia && el[k] > eb) { eb = el[k]; ib = k; }
                const float pa = 1.0f, pb = __expf(eb - ea); const float inv = gwt / (pa + pb);
                const int e0 = 8 * gs + ia, e1 = 8 * gs + ib;
                const int l0 = __hip_atomic_fetch_add(hist + e0, 1, __ATOMIC_RELAXED, __HIP_MEMORY_SCOPE_WORKGROUP);
                const int l1 = __hip_atomic_fetch_add(hist + e1, 1, __ATOMIC_RELAXED, __HIP_MEMORY_SCOPE_WORKGROUP);
                const int ai = (wave * 32 + tt * 16 + lane) * 2;
                aE[ai] = e0; aP[ai] = l0; aG[ai] = pa * inv; aE[ai + 1] = e1; aP[ai + 1] = l1; aG[ai + 1] = pb * inv; }
            LDS_WAIT(); asm volatile("" ::: "memory");
        }
        __syncthreads();
        { int t32 = F.tid; asm volatile("" : "+v"(t32)); if (t32 < 32) base[t32] = (int)__hip_atomic_fetch_add(gcnt + t32, (unsigned)hist[t32], __ATOMIC_RELAXED, __HIP_MEMORY_SCOPE_AGENT); }
        __syncthreads();
        { int ai = F.tid; asm volatile("" : "+v"(ai));
          const int e = aE[ai]; const int pos = base[e] + aP[ai]; const int ts = (st * 256) * 2 + ai;
          tokl[(size_t)e * 65536 + pos] = ts; gate[ts] = aG[ai]; if (!dummy) { rsort[(size_t)e * 65536 + pos] = aR[ai >> 1]; gsort[(size_t)e * 65536 + pos] = aG[ai]; } }
        __syncthreads();
    }
}

__device__ __forceinline__ void p9_final(Frame& F, bool dummy) {
    const unsigned char* YS = (const unsigned char*)(F.ws + WS_YS); const int gw = F.vcu * NWAVES + F.wave, NGW = F.G * NWAVES, lane = F.lane;
    f32x4 gf[4];
#pragma unroll
    for (int j = 0; j < 4; ++j) gf[j] = *((const GAS f32x4*)F.g_final + lane + 64 * j);
    float* dst = dummy ? (float*)(F.ws + WS_XB) : F.out;
    for (int m = gw; m < T; m += NGW) { const GAS v2u* xr = (const GAS v2u*)(F.ws + WS_X1H + (size_t)m * DMODEL * 2) + lane; GAS f32x4* xw = (GAS f32x4*)(dst + (size_t)m * DMODEL) + lane;
        const GAS unsigned* y0 = (const GAS unsigned*)(YS + (size_t)(2 * m) * DMODEL) + lane; const GAS unsigned* y1 = (const GAS unsigned*)(YS + (size_t)(2 * m + 1) * DMODEL) + lane;
        f32x4 v[4]; float s = 0.f;
#pragma unroll
        for (int j = 0; j < 4; ++j) { const v2u hx = xr[64 * j]; v[j] = (f32x4){__uint_as_float(hx.x << 16), __uint_as_float(hx.x & 0xffff0000u), __uint_as_float(hx.y << 16), __uint_as_float(hx.y & 0xffff0000u)}; const unsigned a = y0[64 * j], c = y1[64 * j];
            typedef float v2f_ __attribute__((ext_vector_type(2)));
            const v2f_ a0 = __builtin_amdgcn_cvt_pk_f32_fp8((int)a, false), a1 = __builtin_amdgcn_cvt_pk_f32_fp8((int)a, true), c0 = __builtin_amdgcn_cvt_pk_f32_fp8((int)c, false), c1 = __builtin_amdgcn_cvt_pk_f32_fp8((int)c, true);
            v[j].x += (a0.x + c0.x) * (1.0f / 16.0f); v[j].y += (a0.y + c0.y) * (1.0f / 16.0f); v[j].z += (a1.x + c1.x) * (1.0f / 16.0f); v[j].w += (a1.y + c1.y) * (1.0f / 16.0f);
            s += (v[j].x * v[j].x + v[j].y * v[j].y) + (v[j].z * v[j].z + v[j].w * v[j].w); }
        s = wave_sum(s); const float rs = 1.0f / sqrtf(s * (1.0f / DMODEL) + RMS_EPS);
#pragma unroll
        for (int j = 0; j < 4; ++j) xw[64 * j] = v[j] * rs * gf[j]; }
}

template <class T_> struct KArgPtr { typedef T_ V; typedef const V __attribute__((address_space(4)))* type; };
struct Args { const float* in[15]; float* out; unsigned char* ws; int ph_lo, ph_hi; };
static_assert(sizeof(Args) == 144 && offsetof(Args, out) == 120 && offsetof(Args, ws) == 128 && offsetof(Args, ph_lo) == 136, "Args layout is read by offset (KARG)");
constexpr int N_PHASES = 10;

__global__ void __launch_bounds__(NWAVES * 64, 2) skel_fwd(Args args) {
    extern __shared__ __attribute__((aligned(16))) unsigned char lds[];
    Frame F;
    F.lds = (LAS unsigned char*)lds; F.ldsg = lds;
    F.wave = __builtin_amdgcn_readfirstlane(threadIdx.x >> 6); F.lane = lane_id_v(); F.tid = F.wave * 64 + F.lane;
    F.G = gridDim.x; { const int bx = blockIdx.x; F.vcu = (F.G % 8 == 0) ? (bx % 8) * (F.G / 8) + bx / 8 : bx; }
    typedef __attribute__((address_space(4))) const char* kptr_t;
    kptr_t ka = (kptr_t)__builtin_amdgcn_kernarg_segment_ptr();
#define KARG(T_, off) (*(KArgPtr<T_>::type)(ka + (off)))
#define LOADARGS() do { asm volatile("" : "+s"(ka)); \
    F.x = KARG(const float*, 0); F.g_mix = KARG(const float*, 8); F.w_in = KARG(const float*, 16); F.w_pa = KARG(const float*, 24); F.w_pb = KARG(const float*, 32); F.w_out = KARG(const float*, 40); \
    F.g_ffn = KARG(const float*, 48); F.w_group = KARG(const float*, 56); F.b_group = KARG(const float*, 64); F.w_expert = KARG(const float*, 72); F.b_expert = KARG(const float*, 80); \
    F.w1 = KARG(const float*, 88); F.w3 = KARG(const float*, 96); F.w2 = KARG(const float*, 104); F.g_final = KARG(const float*, 112); F.out = KARG(float*, 120); F.ws = KARG(unsigned char*, 128); ws = F.ws; \
    F.lane = lane_id_v(); F.tid = F.wave * 64 + F.lane; } while (0)
    unsigned char* ws;
    const int lo = KARG(int, 136), hi = KARG(int, 140);
    LOADARGS();
    for (int u = F.tid; u < (LDS_BYTES - MISC_OFF) / 4; u += NWAVES * 64) ((LAS unsigned*)(F.lds + MISC_OFF))[u] = 0u;
    __syncthreads();
    XcdBarrier bar = xcd_barrier_post((unsigned*)(ws + WS_CTL) + CW_BAR, (volatile LAS unsigned*)(F.lds + MISC_OFF + 1024), F.tid);
    cg::grid_group grid = cg::this_grid();
#define FRESH() LOADARGS()
#ifndef PHASE_MASK
#define PHASE_MASK 0x3ff
#endif
#define IN(k) (((PHASE_MASK >> (k)) & 1) && lo <= (k) && (k) < hi)
#ifndef DUP_PHASE
#define DUP_PHASE -1
#endif
#define REPS(k) for (int rep_ = 0, nrep_ = ((k) == DUP_PHASE ? 2 : 1); rep_ < nrep_; ++rep_, (rep_ < nrep_ ? (xcd_barrier(bar, F.tid, (unsigned)F.G), 0) : 0))
#define DUMMY() (rep_ + 1 < nrep_)
#define SEAM(k) do { if (IN(k) && IN((k) + 1)) { if ((k) == 0 && lo < 0) { grid.sync(); } xcd_barrier(bar, F.tid, (unsigned)F.G); } } while (0)

    if (IN(0)) REPS(0) { FRESH(); p0_prologue(F); }
    SEAM(0);
    if (IN(1)) REPS(1) {
        FRESH(); unsigned char* sga = (unsigned char*)F.out; unsigned char* sgb = sga + (size_t)T * DMODEL;
        { pg8::GmPlain g{(const char*)(ws + WS_XB), (const char*)(ws + WS_WIN), DMODEL};
          pg8::StaticOrder S; S.init(T, NINA, F.G, (int)blockIdx.x);
          pg8::EpiIn<0> E{
                     (bf16*)(ws + WS_QA), (bf16*)(ws + WS_KA), (bf16*)(ws + WS_VA), (bf16*)(ws + WS_QB), (bf16*)(ws + WS_KB), (bf16*)(ws + WS_VB), (bf16*)(ws + WS_QI), (bf16*)(ws + WS_KI),
                     (float*)(ws + WS_WI), sga, sgb};
          pg8::gemm_phase(F.lds, g, S, E, F.tid); }
        FRESH();
        { unsigned char* sga2 = (unsigned char*)F.out; unsigned char* sgb2 = sga2 + (size_t)T * DMODEL;
          pg8::GmPlainF8 g{(const char*)(ws + WS_X8), (const char*)(ws + WS_WIN8), DMODEL};
          pg8::StaticOrder S; S.init(T, NINB, F.G, (int)blockIdx.x);
          pg8::EpiIn<1> E{
                     (bf16*)(ws + WS_QA), (bf16*)(ws + WS_KA), (bf16*)(ws + WS_VA), (bf16*)(ws + WS_QB), (bf16*)(ws + WS_KB), (bf16*)(ws + WS_VB), (bf16*)(ws + WS_QI), (bf16*)(ws + WS_KI),
                     (float*)(ws + WS_WI), sga2, sgb2};
          pg8::gemm_phase(F.lds, g, S, E, F.tid); }
    }
    SEAM(1);
    if (IN(2)) REPS(2) { FRESH(); p2_kbsum(F); p2_select(F); }
    SEAM(2);
    if (IN(3)) REPS(3) {
        FRESH(); using namespace attn_body;
        const float* kbsum = (const float*)(ws + WS_KBSUM); const unsigned long long* maskw = (const unsigned long long*)(ws + WS_MASK);
        for (int bh = F.vcu; bh < NBATCH * NHEAD; bh += F.G) { const int b = bh >> 3, h = bh & 7;
            const attn_body::bf16* QAp = (const attn_body::bf16*)(ws + WS_QA); const attn_body::bf16* KAp = (const attn_body::bf16*)(ws + WS_KA);
            const attn_body::bf16* QBp = (const attn_body::bf16*)(ws + WS_QB); const attn_body::bf16* KBp = (const attn_body::bf16*)(ws + WS_KB);
            for (int i = 0; i < 8; ++i) { const int qb = (i & 1) ? (i >> 1) : 7 - (i >> 1); const int i1 = (i + 1) & 7; const int qbn = (i1 & 1) ? (i1 >> 1) : 7 - (i1 >> 1);
                attn_unit<0, 8>(b, h, qb, QAp, KAp, (const attn_body::bf16*)(ws + WS_VA), (unsigned char*)(ws + WS_OA), (char*)lds, kbsum, maskw, F.tid,
                                i > 0, true, i < 7 ? QAp : QBp, i < 7 ? KAp : KBp, qbn, i == 7 && qbn > 0); }
            for (int i = 0; i < 8; ++i) { const int qb = (i & 1) ? (i >> 1) : 7 - (i >> 1); const int i1 = (i + 1) & 7; const int qbn = (i1 & 1) ? (i1 >> 1) : 7 - (i1 >> 1);
                attn_unit<1, 8>(b, h, qb, QBp, KBp, (const attn_body::bf16*)(ws + WS_VB), (unsigned char*)(ws + WS_OB), (char*)lds, kbsum, maskw, F.tid,
                                true, i < 7, QBp, KBp, qbn, qbn > 0); } }
    }
    SEAM(3);
    if (IN(4)) REPS(4) {
        FRESH(); unsigned char* sga = (unsigned char*)F.out; unsigned char* sgb = sga + (size_t)T * DMODEL;
        { pg8::GmPlainF8 g{(const char*)(ws + WS_OA), (const char*)(ws + WS_WA), HW}; pg8::StaticOrder S; S.init(T, DMODEL, F.G, (int)blockIdx.x);
          pg8::EpiGate<true> E{sga, (unsigned char*)(ws + WS_MIX), (unsigned char*)(ws + WS_MIX8)}; pg8::gemm_phase(F.lds, g, S, E, F.tid); }
        { pg8::GmPlainF8 g{(const char*)(ws + WS_OB), (const char*)(ws + WS_WB), HW}; pg8::StaticOrder S; S.init(T, DMODEL, F.G, (int)blockIdx.x);
          pg8::EpiGate<false> E{sgb, (unsigned char*)(ws + WS_MIX), (unsigned char*)(ws + WS_MIX8)}; pg8::gemm_phase(F.lds, g, S, E, F.tid); }
    }
    SEAM(4);
    if (IN(5)) REPS(5) {
        FRESH();
        pg8::GmPlainF8 g{(const char*)(ws + WS_MIX8), (const char*)(ws + WS_WOUT), DMODEL}; pg8::StaticOrder S; S.init(T, DMODEL, F.G, (int)blockIdx.x);
        pg8::EpiRes E{(const bf16*)(ws + WS_XB), (const float*)(ws + WS_RSTD1), (bf16*)(ws + WS_X1H), (unsigned char*)(ws + WS_X1L), (unsigned char*)(ws + WS_X1B)}; pg8::gemm_phase(F.lds, g, S, E, F.tid);
    }
    SEAM(5);
    if (IN(6)) REPS(6) { FRESH(); p6_router(F, DUMMY()); }
    SEAM(6);
    LAS int* tstart = (LAS int*)(F.lds + MISC_OFF); LAS int* ecnt = tstart + 64;
    if (IN(7) || IN(8)) {
        FRESH();
        const unsigned* gcnt = (const unsigned*)(ws + WS_CTL) + CW_CNT;
        if (F.tid < 32) ecnt[F.tid] = (int)__hip_atomic_load(gcnt + F.tid, __ATOMIC_RELAXED, __HIP_MEMORY_SCOPE_AGENT);
        __syncthreads();
        if (F.tid == 0) { int s = 0; for (int e = 0; e < NEXP; ++e) { tstart[e] = s; s += (ecnt[e] + 255) >> 8; } tstart[NEXP] = s; }
        __syncthreads();
    }
    if (IN(7)) REPS(7) {
        FRESH();
        pg8::GmMoe1F8 g{(const char*)(ws + WS_X1B), (const char*)(ws + WS_W13), (const int*)(ws + WS_TOK), DMODEL};
        pg8::MoeOrder S{tstart, ecnt, 4, F.G, (int)blockIdx.x};
        pg8::EpiSwiGlu E{(const float*)(ws + WS_RSORT), (unsigned char*)(ws + WS_HID)};
        pg8::gemm_phase(F.lds, g, S, E, F.tid);
    }
    SEAM(7);
    if (IN(8)) REPS(8) {
        FRESH();
        pg8::GmMoe2F8 g{(const char*)(ws + WS_HID), (const char*)(ws + WS_W2), EFF};
        pg8::MoeOrder S{tstart, ecnt, 4, F.G, (int)blockIdx.x};
        pg8::EpiDown E{(const int*)(ws + WS_TOK), (const float*)(ws + WS_GSORT), (unsigned char*)(ws + WS_YS)};
        pg8::gemm_phase(F.lds, g, S, E, F.tid);
    }
    SEAM(8);
    if (IN(9)) REPS(9) { FRESH(); p9_final(F, DUMMY()); }
#undef IN
#undef SEAM
}

extern "C" void kernel_launch(void* const* d_in, const int* in_sizes, int n_in, void* d_out, int out_size, void* d_ws, size_t ws_size, hipStream_t stream) {
    static int grid = 0;
    if (grid == 0) {
        if (n_in != 15 || in_sizes[0] != T * DMODEL || out_size != T * DMODEL || ws_size < WS_END) {
            fprintf(stderr, "kernel_launch: unexpected shapes: n_in %d in0 %d out %d ws %zu (need >= %zu)\n", n_in, n_in > 0 ? in_sizes[0] : -1, out_size, ws_size, (size_t)WS_END); grid = -1; return; }
        int dev = 0, cus = 0, per_cu = 0;
        if (hipGetDevice(&dev) != hipSuccess || hipDeviceGetAttribute(&cus, hipDeviceAttributeMultiprocessorCount, dev) != hipSuccess) { grid = -1; return; }
        if (hipFuncSetAttribute((const void*)skel_fwd, hipFuncAttributeMaxDynamicSharedMemorySize, LDS_BYTES) != hipSuccess) { fprintf(stderr, "kernel_launch: hipFuncSetAttribute failed\n"); grid = -1; return; }
        if (hipOccupancyMaxActiveBlocksPerMultiprocessor(&per_cu, (const void*)skel_fwd, NWAVES * 64, LDS_BYTES) != hipSuccess || per_cu < 1) { fprintf(stderr, "kernel_launch: occupancy query says %d blocks per CU\n", per_cu); grid = -1; (void)hipGetLastError(); return; }
        grid = cus;
    }
    if (grid < 0) return;
    (void)hipMemsetAsync((char*)d_ws + WS_CTL, 0, CTL_ZERO_BYTES, stream);
    Args a{};
    for (int i = 0; i < 15; ++i) a.in[i] = (const float*)d_in[i];
    a.out = (float*)d_out; a.ws = (unsigned char*)d_ws;
#if MK_N_LAUNCHES == 1
    a.ph_lo = 0; a.ph_hi = N_PHASES;
    { void* kargs[] = {&a}; hipError_t e = hipLaunchCooperativeKernel((const void*)skel_fwd, dim3(grid), dim3(NWAVES * 64), kargs, LDS_BYTES, stream);
      if (e != hipSuccess) fprintf(stderr, "kernel_launch: cooperative launch failed: %s (grid %d)\n", hipGetErrorString(e), grid); }
#else
    for (int p = 0; p < N_PHASES; ++p) { a.ph_lo = p; a.ph_hi = p + 1; hipLaunchKernelGGL(skel_fwd, dim3(grid), dim3(NWAVES * 64), LDS_BYTES, stream, a); }
#endif
}
```

```cpp
#include <hip/hip_runtime.h>
#include <hip/hip_cooperative_groups.h>
#include <hip/hip_bf16.h>
#include <cstdio>
#include <cstdint>
#include <cstddef>
#include <cmath>
namespace cg = cooperative_groups;

#ifndef MK_N_LAUNCHES
#define MK_N_LAUNCHES 1
#endif

constexpr int NBATCH = 32, SEQ = 2048, DMODEL = 1024, T = NBATCH * SEQ;
constexpr int NHEAD = 8, HD = 64, HW = NHEAD * HD;
constexpr int IN_COLS = 5704, NINA = 768, NINB = 5120;
constexpr int NEXP = 32, EFF = 512;
constexpr float RMS_EPS = 1e-6f;
constexpr float IDX_SCALE = 0.044194173824159216f;
constexpr float C2 = 0.125f * 1.4426950408889634f;
constexpr int HID_ROWS = 131072 + 8192;

namespace pg8 {
#define PG8_LAS __attribute__((address_space(3)))
typedef unsigned short bf16_t;
typedef short bf16x8 __attribute__((ext_vector_type(8)));
typedef float f32x4 __attribute__((ext_vector_type(4)));
typedef unsigned u32x4 __attribute__((ext_vector_type(4)));
typedef unsigned u32x2 __attribute__((ext_vector_type(2)));
constexpr int BM = 256, BK = 64, HALF = 128, HTB = HALF * BK * 2, STAGE_BYTES = 8 * HTB, NXCD = 8, WGM = 8;

__host__ __device__ __forceinline__ int lds_byte(int r, int c) { const int st = (r >> 4) * 2 + (c >> 5), rr = r & 15, cc = c & 31, ob = rr * 64 + cc * 2; return st * 1024 + (ob ^ (((ob >> 9) & 1) << 5)); }
__host__ __device__ __forceinline__ void stage_rc(int b, int& R, int& C) { const int st = b / 1024, sb = b % 1024, swz = sb ^ (((sb >> 9) & 1) << 5); R = (st >> 1) * 16 + swz / 64; C = (st & 1) * 32 + (swz % 64) / 2; }
__host__ __device__ __forceinline__ int perm32(int rho) { const int n = rho >> 4, i = rho & 15; return 8 * (i >> 2) + 4 * n + (i & 3); }

typedef int v8i __attribute__((ext_vector_type(8)));
__host__ __device__ __forceinline__ int swz8(int r) { return (((r >> 1) & 3) << 5) ^ (((r >> 3) & 1) << 4); }
__host__ __device__ __forceinline__ int lds_byte8(int r, int cb) { return r * 128 + (cb ^ swz8(r)); }
__host__ __device__ __forceinline__ void stage_rc8(int b, int& R, int& Cb) { R = b >> 7; Cb = (b & 127) ^ swz8(R); }
constexpr int F8_SCALE1 = 0x7f7f7f7f;
__host__ __device__ __forceinline__ int perm16(int s) { return 64 * ((s >> 5) & 3) + 16 * ((s >> 2) & 3) + 8 * (s >> 7) + 4 * ((s >> 4) & 1) + (s & 3); }
struct Unit { int pm, pn, e, lt, cnt; };

struct StaticOrder {
    int nM, nN, nwg, G, c;
    __device__ void init(int M, int N, int G_, int c_) { nM = M / BM; nN = N / BM; nwg = nM * nN; G = G_; c = c_; }
    __device__ bool next(int i, Unit& u) const {
        const long L = (long)i * G + c; if (L >= nwg) return false;
        int wgid = (int)L; { const int q = nwg / NXCD, r = nwg % NXCD, xcd = wgid % NXCD, off = wgid / NXCD; wgid = (xcd < r ? xcd * (q + 1) : r * (q + 1) + (xcd - r) * q) + off; }
        const int nig = WGM * nN, gid = wgid / nig, fm = gid * WGM, gsz = (nM - fm) < WGM ? (nM - fm) : WGM;
        u.pm = fm + ((wgid % nig) % gsz); u.pn = (wgid % nig) / gsz; u.e = 0; u.lt = 0; u.cnt = 0; return true;
    }
};
struct MoeOrder {
    const PG8_LAS int* tstart; const PG8_LAS int* cnt; int nN, G, c;
    __device__ bool next(int i, Unit& u) const {
        const long L = (long)i * G + c; const int ntiles = tstart[NEXP];
        if (L >= (long)ntiles * nN) return false;
        const int pm = (int)(L / nN); u.pm = pm; u.pn = (int)(L % nN);
        int e = 0;
#pragma unroll 1
        for (int j = 1; j < NEXP; ++j) e = (tstart[j] <= pm) ? j : e;
        u.e = e; u.lt = pm - tstart[e]; u.cnt = cnt[e]; return true;
    }
};

__device__ __forceinline__ unsigned cvt_pk_bf16(float lo, float hi) { typedef float f2 __attribute__((ext_vector_type(2))); typedef __bf16 b2 __attribute__((ext_vector_type(2))); f2 v = {lo, hi}; b2 b = __builtin_convertvector(v, b2); return __builtin_bit_cast(unsigned, b); }
__device__ __forceinline__ float bf2f(unsigned short s) { return __uint_as_float((unsigned)s << 16); }

struct GmPlain {
    static constexpr bool FP8 = false;
    const char* A; const char* Bt; int K;
    __device__ __forceinline__ const char* abase() const { return A; }
    __device__ __forceinline__ void offs(const Unit& u, const int (&R)[2], const int (&C)[2], unsigned (&o)[2][2]) const {
#pragma unroll
        for (int h = 0; h < 2; ++h)
#pragma unroll
            for (int i = 0; i < 2; ++i) o[h][i] = (unsigned)(((u.pm * 256 + h * 128 + R[i]) * K + C[i]) * 2);
    }
    __device__ __forceinline__ const char* bptr(const Unit& u) const { return Bt + (size_t)u.pn * 256 * K * 2; }
};
struct GmMoe1 {
    static constexpr bool FP8 = false;
    const char* A; const char* Bt; const int* tok; int K;
    __device__ __forceinline__ const char* abase() const { return A; }
    __device__ __forceinline__ void offs(const Unit& u, const int (&R)[2], const int (&C)[2], unsigned (&o)[2][2]) const {
#pragma unroll
        for (int h = 0; h < 2; ++h)
#pragma unroll
            for (int i = 0; i < 2; ++i) { int r = u.lt * 256 + h * 128 + R[i]; r = r < u.cnt ? r : u.cnt - 1; const int ts = tok[(size_t)u.e * 65536 + r]; o[h][i] = (unsigned)((((ts >> 1)) * K + C[i]) * 2); }
    }
    __device__ __forceinline__ const char* bptr(const Unit& u) const { return Bt + ((size_t)u.e * 1024 + (size_t)u.pn * 256) * K * 2; }
};
struct GmMoe2 {
    static constexpr bool FP8 = false;
    const char* A; const char* Bt; int K;
    __device__ __forceinline__ const char* abase() const { return A; }
    __device__ __forceinline__ void offs(const Unit& u, const int (&R)[2], const int (&C)[2], unsigned (&o)[2][2]) const {
#pragma unroll
        for (int h = 0; h < 2; ++h)
#pragma unroll
            for (int i = 0; i < 2; ++i) o[h][i] = (unsigned)(((u.pm * 256 + h * 128 + R[i]) * K + C[i]) * 2);
    }
    __device__ __forceinline__ const char* bptr(const Unit& u) const { return Bt + ((size_t)u.e * 1024 + (size_t)u.pn * 256) * K * 2; }
};

struct GmMoe1F8 {
    static constexpr bool FP8 = true;
    const char* A; const char* Bt; const int* tok; int K;
    __device__ __forceinline__ const char* abase() const { return A; }
    __device__ __forceinline__ void offs(const Unit& u, const int (&R)[2], const int (&C)[2], unsigned (&o)[2][2]) const {
#pragma unroll
        for (int h = 0; h < 2; ++h)
#pragma unroll
            for (int i = 0; i < 2; ++i) { int r = u.lt * 256 + h * 128 + R[i]; r = r < u.cnt ? r : u.cnt - 1; const int ts = tok[(size_t)u.e * 65536 + r]; o[h][i] = (unsigned)((ts >> 1) * K + C[i]); }
    }
    __device__ __forceinline__ const char* bptr(const Unit& u) const { return Bt + ((size_t)u.e * 1024 + (size_t)u.pn * 256) * K; }
};
struct GmPlainF8 {
    static constexpr bool FP8 = true;
    const char* A; const char* Bt; int K;
    __device__ __forceinline__ const char* abase() const { return A; }
    __device__ __forceinline__ void offs(const Unit& u, const int (&R)[2], const int (&C)[2], unsigned (&o)[2][2]) const {
#pragma unroll
        for (int h = 0; h < 2; ++h)
#pragma unroll
            for (int i = 0; i < 2; ++i) o[h][i] = (unsigned)((u.pm * 256 + h * 128 + R[i]) * K + C[i]);
    }
    __device__ __forceinline__ const char* bptr(const Unit& u) const { return Bt + (size_t)u.pn * 256 * K; }
};
struct GmMoe2F8 {
    static constexpr bool FP8 = true;
    const char* A; const char* Bt; int K;
    __device__ __forceinline__ const char* abase() const { return A; }
    __device__ __forceinline__ void offs(const Unit& u, const int (&R)[2], const int (&C)[2], unsigned (&o)[2][2]) const {
#pragma unroll
        for (int h = 0; h < 2; ++h)
#pragma unroll
            for (int i = 0; i < 2; ++i) o[h][i] = (unsigned)((u.pm * 256 + h * 128 + R[i]) * K + C[i]);
    }
    __device__ __forceinline__ const char* bptr(const Unit& u) const { return Bt + ((size_t)u.e * 1024 + (size_t)u.pn * 256) * K; }
};
__device__ __forceinline__ unsigned cvt4_fp8(float a, float b, float c, float d) { int w = 0; w = __builtin_amdgcn_cvt_pk_fp8_f32(a, b, w, false); w = __builtin_amdgcn_cvt_pk_fp8_f32(c, d, w, true); return (unsigned)w; }


__host__ __device__ __forceinline__ int in_tile_of(int part, int p) { return part == 0 ? (p < 2 ? 12 + p : 14) : (p < 12 ? p : p + 3); }
__device__ __forceinline__ size_t pairaddr(int row, int col) { return ((size_t)(row >> 1) << 11) + (size_t)(((col >> 6) << 7) + ((row & 1) << 6) + (col & 63)); }
template <int PART> struct EpiIn {
    bf16_t *qa, *ka, *va, *qb, *kb, *vb, *qi, *ki; float* wi; unsigned char *sga, *sgb;
    static constexpr float ASCALE = PART == 0 ? 1.0f : (1.0f / 32.0f);
    __device__ __forceinline__ void rope_rows(const f32x4 (&acc)[2][2][4][2], bf16_t* dst, int pitch, int rowb, int fq, float sc) const {
        constexpr float B8[8] = {0.15915494309189535f, 0.11934937021124886f, 0.08949940160889101f, 0.06711508300522726f, 0.050329212104487035f, 0.03774158471741977f, 0.0283021958306234f, 0.02122365276477766f};
        const float dec = fq == 0 ? 1.0f : fq == 1 ? 0.1f : fq == 2 ? 0.01f : 0.001f; const int j0 = 8 * fq;
        f32x4 c4[2][2], s4[2][2], cr[2], sr[2];
        const float p0 = (float)(rowb & (SEQ - 1)), p1 = (float)((rowb + HALF) & (SEQ - 1));
#pragma unroll
        for (int n = 0; n < 2; ++n)
#pragma unroll
            for (int k = 0; k < 4; ++k) { const float w = dec * B8[4 * n + k];
                const float r16 = __builtin_amdgcn_fractf(16.0f * w); cr[n][k] = __builtin_amdgcn_cosf(r16); sr[n][k] = __builtin_amdgcn_sinf(r16);
                const float ra = __builtin_amdgcn_fractf(p0 * w); c4[0][n][k] = __builtin_amdgcn_cosf(ra); s4[0][n][k] = __builtin_amdgcn_sinf(ra);
                const float rb = __builtin_amdgcn_fractf(p1 * w); c4[1][n][k] = __builtin_amdgcn_cosf(rb); s4[1][n][k] = __builtin_amdgcn_sinf(rb); }
#pragma unroll
        for (int ai = 0; ai < 2; ++ai) {
#pragma unroll
            for (int m = 0; m < 4; ++m) { const int row = rowb + ai * HALF + m * 16;
                u32x4 a, b;
#pragma unroll
                for (int n = 0; n < 2; ++n) { const f32x4 c = c4[ai][n], sn = s4[ai][n];
                    const f32x4 x1 = acc[ai][0][m][n] * sc, x2 = acc[ai][1][m][n] * sc; const f32x4 o1 = x1 * c - x2 * sn, o2 = x1 * sn + x2 * c;
                    a[2 * n] = cvt_pk_bf16(o1[0], o1[1]); a[2 * n + 1] = cvt_pk_bf16(o1[2], o1[3]); b[2 * n] = cvt_pk_bf16(o2[0], o2[1]); b[2 * n + 1] = cvt_pk_bf16(o2[2], o2[3]);
                    c4[ai][n] = c * cr[n] - sn * sr[n]; s4[ai][n] = sn * cr[n] + c * sr[n]; }
                bf16_t* p = dst + (size_t)row * pitch + j0; *(u32x4*)p = a; *(u32x4*)(p + 32) = b; } }
    }
    __device__ __forceinline__ void operator()(const f32x4 (&acc)[2][2][4][2], const Unit& u, int wr, int wc, int fr, int fq) const {
        const int pn = in_tile_of(PART, u.pn); const int rowb = u.pm * BM + wr * 64 + fr;
        if (pn < 14) {
            const int seg = pn >> 1;
            if (seg == 2 || seg == 5) {
                bf16_t* dst = (seg == 2) ? va : vb; const int colb = (pn & 1) * 256 + wc * 64 + 16 * fq;
#pragma unroll
                for (int ai = 0; ai < 2; ++ai) {
#pragma unroll
                    for (int m = 0; m < 4; ++m) { const int row = rowb + ai * HALF + m * 16; const float r = ASCALE;
#pragma unroll
                        for (int bj = 0; bj < 2; ++bj) { const f32x4 v0 = acc[ai][bj][m][0] * r, v1 = acc[ai][bj][m][1] * r; u32x4 w;
                            w.x = cvt_pk_bf16(v0[0], v0[1]); w.y = cvt_pk_bf16(v0[2], v0[3]); w.z = cvt_pk_bf16(v1[0], v1[1]); w.w = cvt_pk_bf16(v1[2], v1[3]);
                            *(u32x4*)(dst + (size_t)row * HW + colb + bj * 8) = w; } } }
            } else {
                bf16_t* dst = (seg == 0) ? qa : (seg == 1) ? ka : (seg == 3) ? qb : (seg == 4) ? kb : qi;
                const float sc = ((seg == 0 || seg == 3) ? C2 : 1.0f) * ASCALE; const int head = 4 * (pn & 1) + wc;
                rope_rows(acc, dst + head * 64, HW, rowb, fq, sc);
            }
        } else if (pn == 14) {
            if (wc == 0) rope_rows(acc, ki, 64, rowb, fq, 1.0f);
            else if (wc == 1 && fq < 2) {
#pragma unroll
                for (int ai = 0; ai < 2; ++ai)
#pragma unroll
                    for (int m = 0; m < 4; ++m) { const int row = rowb + ai * HALF + m * 16; const float r = IDX_SCALE;
                        *(f32x4*)(wi + (size_t)row * 8 + 4 * fq) = acc[ai][0][m][0] * r; }
            }
        } else {
            const int gi = pn - 15; unsigned char* dst = (gi < 4) ? sga : sgb; const int colb = (gi & 3) * 256 + wc * 64 + 16 * fq;
#pragma unroll
            for (int ai = 0; ai < 2; ++ai) {
#pragma unroll
                for (int m = 0; m < 4; ++m) { const int row = rowb + ai * HALF + m * 16; const float r = -1.4426950408889634f * ASCALE; u32x4 w;
#pragma unroll
                    for (int bj = 0; bj < 2; ++bj)
#pragma unroll
                        for (int n = 0; n < 2; ++n) { f32x4 v = acc[ai][bj][m][n] * r;
#pragma unroll
                            for (int k = 0; k < 4; ++k) v[k] = 256.0f * __builtin_amdgcn_rcpf(1.0f + __builtin_amdgcn_exp2f(v[k]));
                            w[2 * bj + n] = cvt4_fp8(v[0], v[1], v[2], v[3]); }
                    *(u32x4*)(dst + pairaddr(row, colb)) = w; } }
        }
    }
};
template <bool FIRST> struct EpiGate {
    const unsigned char* sg; unsigned char* tmp; unsigned char* out8;
    __device__ __forceinline__ void operator()(const f32x4 (&acc)[2][2][4][2], const Unit& u, int wr, int wc, int fr, int fq) const {
        typedef float v2f_ __attribute__((ext_vector_type(2)));
        const int rowb = u.pm * BM + wr * 64 + fr, colb = u.pn * BM + wc * 64 + 16 * fq;
#pragma unroll
        for (int ai = 0; ai < 2; ++ai) { u32x4 g[4], pv[4];
#pragma unroll
            for (int m = 0; m < 4; ++m) { const size_t off = pairaddr(rowb + ai * HALF + m * 16, colb);
                g[m] = *(const u32x4*)(sg + off); if (!FIRST) pv[m] = *(const u32x4*)(tmp + off); else pv[m] = (u32x4){0u, 0u, 0u, 0u}; }
#pragma unroll
            for (int m = 0; m < 4; ++m) { const int row = rowb + ai * HALF + m * 16; const size_t off = FIRST ? pairaddr(row, colb) : (size_t)row * DMODEL + colb; u32x4 w;
#pragma unroll
                for (int bj = 0; bj < 2; ++bj)
#pragma unroll
                    for (int n = 0; n < 2; ++n) { const f32x4 a = acc[ai][bj][m][n] * (32.0f / 65536.0f); const int q = 2 * bj + n;
                        const v2f_ g0 = __builtin_amdgcn_cvt_pk_f32_fp8((int)g[m][q], false), g1 = __builtin_amdgcn_cvt_pk_f32_fp8((int)g[m][q], true);
                        const v2f_ p0 = __builtin_amdgcn_cvt_pk_f32_fp8((int)pv[m][q], false), p1 = __builtin_amdgcn_cvt_pk_f32_fp8((int)pv[m][q], true);
                        w[q] = cvt4_fp8(a[0] * g0.x + p0.x, a[1] * g0.y + p0.y, a[2] * g1.x + p1.x, a[3] * g1.y + p1.y); }
                *(u32x4*)((FIRST ? tmp : out8) + off) = w; } }
    }
};
struct EpiRes {
    const bf16_t* xb; const float* irstd; bf16_t* xh; unsigned char* xl; unsigned char* xq;
    __device__ __forceinline__ void operator()(const f32x4 (&acc)[2][2][4][2], const Unit& u, int wr, int wc, int fr, int fq) const {
        const int rowb = u.pm * BM + wr * 64 + fr, colb = u.pn * BM + wc * 64 + 16 * fq;
#pragma unroll
        for (int ai = 0; ai < 2; ++ai) { u32x4 bs[4][2]; float ir[4];
#pragma unroll
            for (int m = 0; m < 4; ++m) { const int row = rowb + ai * HALF + m * 16; const size_t off = (size_t)row * DMODEL + colb; ir[m] = irstd[row];
#pragma unroll
                for (int bj = 0; bj < 2; ++bj) bs[m][bj] = *(const u32x4*)(xb + off + bj * 8); }
#pragma unroll
            for (int m = 0; m < 4; ++m) { const size_t off = (size_t)(rowb + ai * HALF + m * 16) * DMODEL + colb; u32x4 hw[2], lw, qw;
#pragma unroll
                for (int bj = 0; bj < 2; ++bj)
#pragma unroll
                    for (int n = 0; n < 2; ++n) { float qv[4], lo[4];
#pragma unroll
                        for (int q = 0; q < 2; ++q) { const unsigned xw = bs[m][bj][2 * n + q];
                            const float v0 = __uint_as_float(xw << 16) * ir[m] + acc[ai][bj][m][n][2 * q] * (1.0f / 1024.0f), v1 = __uint_as_float(xw & 0xffff0000u) * ir[m] + acc[ai][bj][m][n][2 * q + 1] * (1.0f / 1024.0f);
                            const unsigned h = cvt_pk_bf16(v0, v1); qv[2 * q] = v0; qv[2 * q + 1] = v1; hw[bj][2 * n + q] = h;
                            lo[2 * q] = (v0 - __uint_as_float(h << 16)) * 512.0f; lo[2 * q + 1] = (v1 - __uint_as_float(h & 0xffff0000u)) * 512.0f; }
                        qw[2 * bj + n] = cvt4_fp8(qv[0], qv[1], qv[2], qv[3]); lw[2 * bj + n] = cvt4_fp8(lo[0], lo[1], lo[2], lo[3]); }
                *(u32x4*)(xh + off) = hw[0]; *(u32x4*)(xh + off + 8) = hw[1]; *(u32x4*)(xl + off) = lw; *(u32x4*)(xq + off) = qw; } }
    }
};
struct EpiSwiGlu {
    const float* rsort; unsigned char* hid;
    __device__ __forceinline__ void operator()(const f32x4 (&acc)[2][2][4][2], const Unit& u, int wr, int wc, int fr, int fq) const {
        float rr[2][4];
#pragma unroll
        for (int ai = 0; ai < 2; ++ai)
#pragma unroll
            for (int m = 0; m < 4; ++m) { int er = u.lt * 256 + ai * HALF + wr * 64 + m * 16 + fr; er = er < u.cnt ? er : u.cnt - 1; rr[ai][m] = rsort[(size_t)u.e * 65536 + er] * (1.0f / 32.0f); }
#pragma unroll
        for (int ai = 0; ai < 2; ++ai)
#pragma unroll
            for (int m = 0; m < 4; ++m) { const int lr = ai * HALF + wr * 64 + m * 16 + fr; const int er = u.lt * 256 + lr;
                if (er < u.cnt) { const float r = rr[ai][m]; float o[8];
#pragma unroll
                    for (int n = 0; n < 2; ++n) { const f32x4 a = acc[ai][0][m][n] * r, b = acc[ai][1][m][n] * r;
#pragma unroll
                        for (int k = 0; k < 4; ++k) { const float sg = __builtin_amdgcn_rcpf(1.0f + __builtin_amdgcn_exp2f(a[k] * (-1.4426950408889634f))); o[4 * n + k] = 2.0f * a[k] * sg * b[k]; } }
                    u32x2 w; w.x = cvt4_fp8(o[0], o[1], o[2], o[3]); w.y = cvt4_fp8(o[4], o[5], o[6], o[7]);
                    *(u32x2*)(hid + (size_t)(u.pm * 256 + lr) * EFF + 128 * u.pn + 32 * wc + 8 * fq) = w; } }
    }
};
struct EpiDown {
    const int* tok; const float* gsort; unsigned char* ys;
    __device__ __forceinline__ void operator()(const f32x4 (&acc)[2][2][4][2], const Unit& u, int wr, int wc, int fr, int fq) const {
        const int colb = u.pn * BM + wc * 64 + 16 * fq;
        int ts[2][4]; float gg[2][4];
#pragma unroll
        for (int ai = 0; ai < 2; ++ai)
#pragma unroll
            for (int m = 0; m < 4; ++m) { int er = u.lt * 256 + ai * HALF + wr * 64 + m * 16 + fr; er = er < u.cnt ? er : u.cnt - 1; ts[ai][m] = tok[(size_t)u.e * 65536 + er]; gg[ai][m] = gsort[(size_t)u.e * 65536 + er]; }
#pragma unroll
        for (int ai = 0; ai < 2; ++ai)
#pragma unroll
            for (int m = 0; m < 4; ++m) { const int er = u.lt * 256 + ai * HALF + wr * 64 + m * 16 + fr;
                if (er < u.cnt) { const float g = gg[ai][m] * (16.0f / 32.0f); const int t_ = ts[ai][m]; u32x4 w;
#pragma unroll
                    for (int bj = 0; bj < 2; ++bj)
#pragma unroll
                        for (int n = 0; n < 2; ++n) { const f32x4 v = acc[ai][bj][m][n] * g; w[2 * bj + n] = cvt4_fp8(v[0], v[1], v[2], v[3]); }
                    *(u32x4*)(ys + (size_t)t_ * DMODEL + colb) = w; } }
    }
};

template <class GM, class Epi, class Sched>
__device__ __forceinline__ void gemm_phase(PG8_LAS unsigned char* lds, const GM g, const Sched& S, const Epi& E, const int tid) {
    const int wid = __builtin_amdgcn_readfirstlane(tid >> 6), lane = tid & 63, wr = wid >> 2, wc = wid & 3, fr = lane & 15, fq = lane >> 4;
    constexpr bool FP8 = GM::FP8;
    const int K = g.K, nt = FP8 ? K / 128 : K / BK;
    int sR[2], sC[2]; unsigned voffB[2];
#pragma unroll
    for (int i = 0; i < 2; ++i) { int R, C; if constexpr (FP8) { stage_rc8(tid * 16 + i * 8192, R, C); voffB[i] = (unsigned)(R * K + C); } else { stage_rc(tid * 16 + i * 8192, R, C); voffB[i] = (unsigned)(R * K + C) * 2u; }
        sR[i] = R; sC[i] = C; }
    const size_t kstep = (size_t)(BK * 2);
    const size_t hstep = FP8 ? (size_t)HALF * K : (size_t)HALF * K * 2;
    const unsigned ldsw = (unsigned)wid * 1024u;
    const int aoff = FP8 ? lds_byte8(wr * 64 + fr, fq * 32) : lds_byte(wr * 64 + fr, fq * 8), boff = FP8 ? lds_byte8(wc * 32 + fr, fq * 32) : lds_byte(wc * 32 + fr, fq * 8);
    const int aoff1 = aoff ^ 16, boff1 = boff ^ 16;
    const char* const abase = g.abase();
#define PG8_SA(b, h) (((b) * 2 + (h)) * HTB)
#define PG8_SB(b, h) ((4 + (b) * 2 + (h)) * HTB)
#define PG8_STAGE(bufoff, gbase, voff) do { _Pragma("unroll") for (int _i = 0; _i < 2; ++_i) \
        __builtin_amdgcn_global_load_lds((const unsigned*)((const char*)(gbase) + (voff)[_i]), (PG8_LAS unsigned*)(lds + (bufoff) + ldsw + _i * 8192), 16, 0, 0); } while (0)
#define PG8_STAGEA(bufoff, OFF, h, kb) do { const char* ub_ = abase + (kb);   _Pragma("unroll") for (int _i = 0; _i < 2; ++_i) \
        __builtin_amdgcn_global_load_lds((const unsigned*)(ub_ + (OFF)[h][_i]), (PG8_LAS unsigned*)(lds + (bufoff) + ldsw + _i * 8192), 16, 0, 0); } while (0)
#define PG8_LD8(off0_, off1_, cst_) ({ typedef int v4i_ __attribute__((ext_vector_type(4))); const v4i_ lo_ = *(const PG8_LAS v4i_*)(lds + (cst_) + (off0_)); const v4i_ hi_ = *(const PG8_LAS v4i_*)(lds + (cst_) + (off1_)); __builtin_shufflevector(lo_, hi_, 0, 1, 2, 3, 4, 5, 6, 7); })
#define PG8_LDA(dst, b, h) do { if constexpr (FP8) { _Pragma("unroll") for (int m = 0; m < 4; ++m) dst##8[m] = PG8_LD8(aoff, aoff1, PG8_SA(b, h) + m * 2048); } \
        else { _Pragma("unroll") for (int m = 0; m < 4; ++m) _Pragma("unroll") for (int k = 0; k < 2; ++k) dst[m][k] = *(const PG8_LAS bf16x8*)(lds + PG8_SA(b, h) + aoff + m * 2048 + k * 1024); } } while (0)
#define PG8_LDB(dst, b, h) do { if constexpr (FP8) { _Pragma("unroll") for (int n = 0; n < 2; ++n) dst##8[n] = PG8_LD8(boff, boff1, PG8_SB(b, h) + n * 2048); } \
        else { _Pragma("unroll") for (int n = 0; n < 2; ++n) _Pragma("unroll") for (int k = 0; k < 2; ++k) dst[n][k] = *(const PG8_LAS bf16x8*)(lds + PG8_SB(b, h) + boff + n * 2048 + k * 1024); } } while (0)
#define PG8_MMA(ai, bj, At, Bt) do { __builtin_amdgcn_s_setprio(1); if constexpr (FP8) { _Pragma("unroll") for (int m = 0; m < 4; ++m) _Pragma("unroll") for (int n = 0; n < 2; ++n) \
        asm volatile("v_mfma_scale_f32_16x16x128_f8f6f4 %0, %1, %2, %0, %3, %3 op_sel_hi:[0,0,0]" : "+v"(acc[ai][bj][m][n]) : "v"(Bt##8[n]), "v"(At##8[m]), "v"(f8sc)); } \
        else { _Pragma("unroll") for (int m = 0; m < 4; ++m) _Pragma("unroll") for (int n = 0; n < 2; ++n) _Pragma("unroll") for (int k = 0; k < 2; ++k) \
        acc[ai][bj][m][n] = __builtin_amdgcn_mfma_f32_16x16x32_bf16(Bt[n][k], At[m][k], acc[ai][bj][m][n], 0, 0, 0); } __builtin_amdgcn_s_setprio(0); } while (0)
#define PG8_WAIT_V(n) asm volatile("s_waitcnt vmcnt(" #n ")" ::: "memory")
#define PG8_WAIT_L(n) asm volatile("s_waitcnt lgkmcnt(" #n ")" ::: "memory")
#define PG8_BAR __builtin_amdgcn_s_barrier()
#define PG8_SCHED __builtin_amdgcn_sched_barrier(0)
    Unit cur, nxt; int ui = 0;
    if (!S.next(0, cur)) return;
    f32x4 acc[2][2][4][2];
#pragma unroll
    for (int a = 0; a < 2; ++a)
#pragma unroll
        for (int b = 0; b < 2; ++b)
#pragma unroll
            for (int m = 0; m < 4; ++m)
#pragma unroll
                for (int n = 0; n < 2; ++n) acc[a][b][m][n] = (f32x4){0.f, 0.f, 0.f, 0.f};
    bf16x8 At[4][2], B0[2][2], B1[2][2]; v8i At8[4], B08[2], B18[2];
    const int f8sc = F8_SCALE1;
    unsigned cOff[2][2], nOff[2][2];
    g.offs(cur, sR, sC, cOff);
    const char* cB = g.bptr(cur);
    PG8_STAGE(PG8_SB(0, 0), cB, voffB); PG8_STAGE(PG8_SB(0, 1), cB + hstep, voffB); PG8_STAGEA(PG8_SA(0, 0), cOff, 0, (size_t)0); PG8_STAGEA(PG8_SA(0, 1), cOff, 1, (size_t)0);
    if (wr == 1) PG8_BAR;
    PG8_WAIT_V(2); PG8_BAR;
    PG8_STAGE(PG8_SB(1, 0), cB + kstep, voffB); PG8_STAGEA(PG8_SA(1, 0), cOff, 0, kstep); PG8_STAGE(PG8_SB(1, 1), cB + hstep + kstep, voffB);
    PG8_WAIT_V(6); PG8_BAR;
    for (;;) {
        const bool has_next = S.next(ui + 1, nxt);
        const char* nB = cB;
        if (has_next) { g.offs(nxt, sR, sC, nOff); nB = g.bptr(nxt); }
        else {
#pragma unroll
            for (int h = 0; h < 2; ++h)
#pragma unroll
                for (int i = 0; i < 2; ++i) nOff[h][i] = cOff[h][i];
        }
#pragma unroll 1
        for (int t = 0; t < nt; t += 2) {
            const bool last = (t == nt - 2);
            const size_t kb1 = (size_t)(t + 1) * kstep;
            const size_t kb2 = last ? (size_t)0 : (size_t)(t + 2) * kstep, kb3 = kb2 + kstep;
            unsigned o2[2][2];
#pragma unroll
            for (int h = 0; h < 2; ++h)
#pragma unroll
                for (int i = 0; i < 2; ++i) o2[h][i] = last ? nOff[h][i] : cOff[h][i];
            const char* b2 = last ? nB : cB + (size_t)(t + 2) * kstep; const char* b3 = b2 + kstep;
            PG8_LDB(B0, 0, 0); PG8_LDB(B1, 0, 1); PG8_SCHED; PG8_LDA(At, 0, 0); PG8_STAGEA(PG8_SA(1, 1), cOff, 1, kb1);
            PG8_WAIT_V(8); PG8_WAIT_L(0); PG8_BAR; PG8_MMA(0, 0, At, B0); PG8_MMA(0, 1, At, B1); PG8_BAR; PG8_SCHED;
            PG8_LDA(At, 0, 1); PG8_STAGE(PG8_SB(0, 0), b2, voffB); PG8_STAGE(PG8_SB(0, 1), b2 + hstep, voffB); PG8_STAGEA(PG8_SA(0, 0), o2, 0, kb2);
            PG8_WAIT_V(8); PG8_WAIT_L(0); PG8_BAR; PG8_MMA(1, 0, At, B0); PG8_MMA(1, 1, At, B1); PG8_BAR; PG8_SCHED;
            PG8_LDB(B0, 1, 0); PG8_LDB(B1, 1, 1); PG8_SCHED; PG8_LDA(At, 1, 0); PG8_STAGEA(PG8_SA(0, 1), o2, 1, kb2);
            PG8_WAIT_V(8); PG8_WAIT_L(0); PG8_BAR; PG8_MMA(0, 0, At, B0); PG8_MMA(0, 1, At, B1); PG8_BAR; PG8_SCHED;
            PG8_LDA(At, 1, 1); PG8_STAGE(PG8_SB(1, 0), b3, voffB); PG8_STAGE(PG8_SB(1, 1), b3 + hstep, voffB); PG8_STAGEA(PG8_SA(1, 0), o2, 0, kb3);
            PG8_WAIT_V(8); PG8_WAIT_L(0); PG8_BAR; PG8_MMA(1, 0, At, B0); PG8_MMA(1, 1, At, B1); PG8_BAR; PG8_SCHED;
        }
        if constexpr (FP8) asm volatile("s_nop 15\n\ts_nop 15" ::: "memory");
        if (wr == 0) PG8_BAR;
        { int fr_ = fr, fq_ = fq; asm volatile("" : "+v"(fr_), "+v"(fq_));
          E(acc, cur, wr, wc, fr_, fq_); }
        if (!has_next) break;
#pragma unroll
        for (int a = 0; a < 2; ++a)
#pragma unroll
            for (int b = 0; b < 2; ++b)
#pragma unroll
                for (int m = 0; m < 4; ++m)
#pragma unroll
                    for (int n = 0; n < 2; ++n) acc[a][b][m][n] = (f32x4){0.f, 0.f, 0.f, 0.f};
        cur = nxt; cB = nB; ++ui;
#pragma unroll
        for (int h = 0; h < 2; ++h)
#pragma unroll
            for (int i = 0; i < 2; ++i) cOff[h][i] = nOff[h][i];
        if (wr == 1) PG8_BAR;
    }
    PG8_WAIT_V(0);
    PG8_BAR;
#undef PG8_SA
#undef PG8_SB
#undef PG8_STAGE
#undef PG8_STAGEA
#undef PG8_LDA
#undef PG8_LD8
#undef PG8_LDB
#undef PG8_MMA
#undef PG8_WAIT_V
#undef PG8_WAIT_L
#undef PG8_BAR
#undef PG8_SCHED
}
}

namespace attn_body {
using bf16=__hip_bfloat16;
using bf16x8=__attribute__((ext_vector_type(8)))short;
using s16x4=__attribute__((ext_vector_type(4)))short;
using f32x16=__attribute__((ext_vector_type(16)))float;
using f32x4=__attribute__((ext_vector_type(4)))float;
using u32x4=__attribute__((ext_vector_type(4)))unsigned;
using u32x2=__attribute__((ext_vector_type(2)))unsigned;
constexpr int D=64,DM=HW;
constexpr int NW=8,QBLK=32,QB=QBLK*NW,KVBLK=64;
__device__ __forceinline__ int crow(int r,int hi){return (r&3)+8*(r>>2)+4*hi;}
#define SBAR() __builtin_amdgcn_sched_barrier(0)
__device__ __forceinline__ void cmask(f32x16&p0,f32x16&p1,int jb,int qrel,int hi){
  const float NEG=-INFINITY; const int d=qrel-64*jb-4*hi;
  #pragma unroll
  for(int r=0;r<16;++r){const int c=(r&3)+8*(r>>2); if(c>d)p0[r]=NEG; if(c+32>d)p1[r]=NEG;}
}
__device__ __forceinline__ void addmask(f32x16&p0,f32x16&p1,float addv){
  #pragma unroll
  for(int r=0;r<16;++r){p0[r]+=addv;p1[r]+=addv;}
}
typedef __attribute__((address_space(3))) const char* lds_cptr;
__device__ __forceinline__ float mselect(int m,float v){ return __uint_as_float((__float_as_uint(v)&(unsigned)m)|(0xff800000u&~(unsigned)m)); }
__device__ __forceinline__ void bitmask(f32x16&p0,f32x16&p1,lds_cptr mrow,int t,int hi){
  const u32x2 w=*(const __attribute__((address_space(3))) u32x2*)(mrow+((t>>2)&1)*1024+((t>>1)&1)*512+(t&1)*8);
  const int w0=(int)(w.x>>(4*hi)),w1=(int)(w.y>>(4*hi));
  #pragma unroll
  for(int r=0;r<16;++r){const int bpos=(r&3)+8*(r>>2); p0[r]=mselect(__builtin_amdgcn_sbfe(w0,bpos,1),p0[r]); p1[r]=mselect(__builtin_amdgcn_sbfe(w1,bpos,1),p1[r]);}
}

constexpr int NSLOT=3, SLOTB=8192;
constexpr int LDS_K=0, LDS_V=NSLOT*SLOTB, LDS_WS=2*NSLOT*SLOTB, LDS_OST=LDS_WS+NW*64*4, LDS_MSK=LDS_OST+NW*4096, LDS_BYTES=LDS_MSK+NW*2048, LDS_QST=LDS_BYTES, LDS_QST_BYTES=NW*4096;
__device__ __forceinline__ void glds16(const void*gsrc,unsigned lds_dst){unsigned keep;
  asm volatile("s_mov_b32 %0, m0\n\ts_mov_b32 m0, %2\n\ts_nop 0\n\tglobal_load_lds_dwordx4 %1, off\n\ts_mov_b32 m0, %0":"=&s"(keep):"v"(gsrc),"s"(lds_dst):"memory");}
__device__ __forceinline__ float max3f(float a,float b,float c){float r;asm("v_max3_f32 %0, %1, %2, %3":"=v"(r):"v"(a),"v"(b),"v"(c));return r;}
__device__ __forceinline__ float max2f(float a,float b){float r;asm("v_max_f32_e32 %0, %1, %2":"=v"(r):"v"(a),"v"(b));return r;}
__device__ __forceinline__ float fadd_s(float a,float b){float r;asm("v_add_f32_e32 %0, %1, %2":"=v"(r):"v"(a),"v"(b));return r;}
__device__ __forceinline__ float fsub_s(float a,float b){float r;asm("v_sub_f32_e32 %0, %1, %2":"=v"(r):"v"(a),"v"(b));return r;}
typedef float f32x2_t __attribute__((ext_vector_type(2))); typedef __bf16 bf16x2_t __attribute__((ext_vector_type(2)));
__device__ __forceinline__ unsigned cvtpk_s(float lo,float hi){f32x2_t v={lo,hi};bf16x2_t b=__builtin_convertvector(v,bf16x2_t);return __builtin_bit_cast(unsigned,b);}
#define WAIT_BAR(N) asm volatile("s_waitcnt vmcnt(" #N ") lgkmcnt(0)\n\ts_barrier":::"memory")

__device__ __forceinline__ void qkt(f32x16&p0,f32x16&p1,const char*Kslot,const bf16x8*qr,int r32,int hi){
  const f32x16 negm=f32x16{};
  const char*kb=Kslot+hi*1024+r32*16;
  #pragma unroll
  for(int d0=0;d0<4;++d0){
    const bf16x8 b0=*reinterpret_cast<const bf16x8*>(kb+d0*2048);
    const bf16x8 b1=*reinterpret_cast<const bf16x8*>(kb+d0*2048+512);
    if(d0==0){p0=__builtin_amdgcn_mfma_f32_32x32x16_bf16(b0,qr[0],negm,0,0,0);p1=__builtin_amdgcn_mfma_f32_32x32x16_bf16(b1,qr[0],negm,0,0,0);}
    else{p0=__builtin_amdgcn_mfma_f32_32x32x16_bf16(b0,qr[d0],p0,0,0,0);p1=__builtin_amdgcn_mfma_f32_32x32x16_bf16(b1,qr[d0],p1,0,0,0);}}
}
typedef short v4i16_t __attribute__((ext_vector_type(4)));
__device__ __forceinline__ void kload8(bf16x8*kf,lds_cptr kp){
  kf[0]=*(const __attribute__((address_space(3))) bf16x8*)(kp);      kf[1]=*(const __attribute__((address_space(3))) bf16x8*)(kp+512);
  kf[2]=*(const __attribute__((address_space(3))) bf16x8*)(kp+2048); kf[3]=*(const __attribute__((address_space(3))) bf16x8*)(kp+2560);
  kf[4]=*(const __attribute__((address_space(3))) bf16x8*)(kp+4096); kf[5]=*(const __attribute__((address_space(3))) bf16x8*)(kp+4608);
  kf[6]=*(const __attribute__((address_space(3))) bf16x8*)(kp+6144); kf[7]=*(const __attribute__((address_space(3))) bf16x8*)(kp+6656);
}
__device__ __forceinline__ void kload2(bf16x8*kf,lds_cptr kp,int j){ kf[2*j]=*(const __attribute__((address_space(3))) bf16x8*)(kp+j*2048); kf[2*j+1]=*(const __attribute__((address_space(3))) bf16x8*)(kp+j*2048+512); }
__device__ __forceinline__ s16x4 vtr(lds_cptr p){ return __builtin_bit_cast(s16x4,__builtin_amdgcn_ds_read_tr16_b64_v4i16((__attribute__((address_space(3))) v4i16_t*)p)); }
__device__ __forceinline__ float rowmax(const f32x16&p0,const f32x16&p1){
  float a=max3f(p0[0],p0[1],p1[0]),b=max3f(p0[2],p0[3],p1[1]);a=max3f(a,p1[2],p1[3]);
  #pragma unroll
  for(int r=4;r<16;r+=4){a=max3f(a,p0[r],p0[r+1]);b=max3f(b,p0[r+2],p0[r+3]);a=max3f(a,p1[r],p1[r+1]);b=max3f(b,p1[r+2],p1[r+3]);}
  const float m=max2f(a,b);
  auto rr=__builtin_amdgcn_permlane32_swap(__float_as_uint(m),__float_as_uint(m),false,false);
  return max2f(__uint_as_float(rr[0]),__uint_as_float(rr[1]));
}
__device__ __forceinline__ void pv(f32x16*o,int vb,bf16x8 pa0,bf16x8 pa1,bf16x8 pa2,bf16x8 pa3){
  #pragma unroll
  for(int d0=0;d0<2;++d0){s16x4 lo[4],hi[4];
    #pragma unroll
    for(int ks=0;ks<4;++ks){
      asm volatile("ds_read_b64_tr_b16 %0,%1 offset:%c2":"=&v"(lo[ks]):"v"(vb),"i"(d0*4096+ks*1024):"memory");
      asm volatile("ds_read_b64_tr_b16 %0,%1 offset:%c2":"=&v"(hi[ks]):"v"(vb),"i"(d0*4096+ks*1024+512):"memory");}
    asm volatile("s_waitcnt lgkmcnt(0)":::"memory");SBAR();
    #define PK(k) (bf16x8){lo[k][0],lo[k][1],lo[k][2],lo[k][3],hi[k][0],hi[k][1],hi[k][2],hi[k][3]}
    o[d0]=__builtin_amdgcn_mfma_f32_32x32x16_bf16(pa0,PK(0),o[d0],0,0,0);
    o[d0]=__builtin_amdgcn_mfma_f32_32x32x16_bf16(pa1,PK(1),o[d0],0,0,0);
    o[d0]=__builtin_amdgcn_mfma_f32_32x32x16_bf16(pa2,PK(2),o[d0],0,0,0);
    o[d0]=__builtin_amdgcn_mfma_f32_32x32x16_bf16(pa3,PK(3),o[d0],0,0,0);
    #undef PK
  }
}
#ifndef ATTN_STORE16
#define ATTN_STORE16(p,v) (*(u32x4*)(p)=(v))
#endif
__device__ __forceinline__ float bfs(short s){ return __uint_as_float(((unsigned)(unsigned short)s)<<16); }

template<int MODE,int THRL> __device__ __forceinline__ void attn_unit(int b,int h,int qb,const bf16*Q,const bf16*__restrict__ K,const bf16*__restrict__ V,unsigned char*O,char*shm,
                                                                      const float*kbsum,const unsigned long long*maskw,const int tid_in,
                                                                      const bool pre,const bool has_next,const bf16*Qn,const bf16*Kn,const int qbn,const bool bitsn){
  int tid=tid_in; asm volatile("":"+v"(tid));
  const int lane=tid&63,r32=lane&31,hi=lane>>5; const int wid=__builtin_amdgcn_readfirstlane(tid>>6);
  const long rowbase=(long)b*SEQ; const int q0=qb*QB;
  const bf16*Qw=Q+(rowbase+q0+wid*QBLK)*DM+h*D;
  const bf16*Kh=K+rowbase*DM+h*D,*Vh=V+rowbase*DM+h*D;
  const unsigned lds0=(unsigned)(uintptr_t)shm;
  float*wsf=(float*)(shm+LDS_WS)+wid*64;
  const unsigned koff=(unsigned)((lane*DM+wid*8)*2);
  const unsigned voff=(unsigned)(((16*(wid&3)+(lane>>2))*DM+(wid>>2)*32+(lane&3)*8)*2);
  const unsigned kdst=lds0+LDS_K+wid*1024, vdst=lds0+LDS_V+wid*1024;
  #define DMA_K(t,slot) glds16((const char*)Kh+(size_t)(t)*(KVBLK*DM*2)+koff,(unsigned)__builtin_amdgcn_readfirstlane(kdst+(slot)))
  #define DMA_V(t,slot) glds16((const char*)Vh+(size_t)(t)*(KVBLK*DM*2)+voff,(unsigned)__builtin_amdgcn_readfirstlane(vdst+(slot)))
  const unsigned long long*mbase=maskw+(size_t)(rowbase+q0+wid*QBLK)*32;
  const unsigned moff=(unsigned)((r32*32+2*hi)*8);
  const unsigned mdst=lds0+LDS_MSK+wid*2048;
  #define DMA_M(tg) glds16((const char*)mbase+(size_t)(32*(tg))+moff,(unsigned)__builtin_amdgcn_readfirstlane(mdst+((tg)&1)*1024))
  const bool usebits=(MODE==1)&&(qb>0);
  const int vb0=(int)(lds0+LDS_V)+((lane>>4)&1)*32+(lane&3)*8+(4*hi+((lane&15)>>2))*64;
  const char*Kbase=shm+LDS_K; bf16x8 kf[8];
  const lds_cptr shm3=(lds_cptr)shm; const lds_cptr kp0=shm3+LDS_K+hi*1024+r32*16; const lds_cptr vp0=shm3+LDS_V+((lane>>4)&1)*32+(lane&3)*8+(4*hi+((lane&15)>>2))*64;
  const lds_cptr mrow=shm3+LDS_MSK+wid*2048+r32*16;
  const int NT=(q0+QB)/KVBLK;
  const unsigned qst=lds0+LDS_QST+wid*4096;
  bf16x8 qr[4];
  if(!pre){ if(usebits){DMA_M(0);} DMA_K(0,0);DMA_V(0,0);DMA_K(1,SLOTB);
    #pragma unroll
    for(int d0=0;d0<4;++d0)qr[d0]=*reinterpret_cast<const bf16x8*>(&Qw[(long)r32*DM+d0*16+hi*8]); }
  else { DMA_V(0,0);
    asm volatile("s_waitcnt vmcnt(7)":::"memory");
    const lds_cptr qp=shm3+LDS_QST+wid*4096+(r32>>3)*1024+(r32&7)*128;
    #pragma unroll
    for(int d0=0;d0<4;++d0)qr[d0]=*reinterpret_cast<const __attribute__((address_space(3))) bf16x8*>(qp+(((d0*2+hi)^(r32&7))*16)); }
  unsigned selbits=(1u<<qb)-1u;
  if(MODE==0&&qb>3){
    float g[7];
    #pragma unroll
    for(int j=0;j<7;++j){ g[j]=0.f;
      if(j<qb){ const float*kbp=kbsum+((size_t)(b*NHEAD+h)*8+j)*64+hi*8; float s=0.f;
        #pragma unroll
        for(int d0=0;d0<4;++d0){ const f32x4 k0=*(const f32x4*)(kbp+d0*16),k1=*(const f32x4*)(kbp+d0*16+4);
          s+=bfs(qr[d0][0])*k0[0]+bfs(qr[d0][1])*k0[1]+bfs(qr[d0][2])*k0[2]+bfs(qr[d0][3])*k0[3]+bfs(qr[d0][4])*k1[0]+bfs(qr[d0][5])*k1[1]+bfs(qr[d0][6])*k1[2]+bfs(qr[d0][7])*k1[3]; }
        s+=__shfl_xor(s,32); g[j]=s; } }
    selbits=0u;
    #pragma unroll
    for(int j=0;j<7;++j){ if(j<qb){ int rank=0;
      #pragma unroll
      for(int i=0;i<7;++i){ if(i!=j&&i<qb){ rank+=(g[i]>g[j]||(g[i]==g[j]&&i<j))?1:0; } }
      if(rank<3)selbits|=(1u<<j); } }
  }
  float mhat=0.f,l_reg=0.f;f32x16 o[2];o[0]=f32x16{};o[1]=f32x16{};const f32x16 zero16=f32x16{};
  const int qrel=wid*QBLK+r32;
  #define AMASK_PEEL(P0,P1,t) do{ const int jb_=(t)-(NT-4); \
      if(usebits){ bitmask(P0,P1,mrow,(t),hi); } \
      else if(jb_>=0){ cmask(P0,P1,jb_,qrel,hi); } }while(0)
  #define ADDV_PEEL(t) ((MODE==0&&(t)<NT-4)?(((selbits>>((t)>>2))&1u)?0.f:-INFINITY):0.f)
  #define AMASK_STEADY(P0,P1,t) do{ if(MODE==1){ bitmask(P0,P1,mrow,(t),hi); } }while(0)
  #define ADDV_STEADY(t) ((MODE==0)?(((selbits>>((t)>>2))&1u)?0.f:-INFINITY):0.f)
  #define CMASK(P0,P1,t) AMASK_PEEL(P0,P1,t)
  #define ADDV(t) ADDV_PEEL(t)
  bool resc=false;
  #define START(P0,P1) do{ const float rm=rowmax(P0,P1); resc=false; \
    { const float dl=(rm<-1e30f)?0.f:rm; mhat=fadd_s(mhat,dl); \
      _Pragma("unroll") for(int r=0;r<16;++r){P0[r]=fsub_s(P0[r],dl);P1[r]=fsub_s(P1[r],dl);} } \
    _Pragma("unroll") for(int r=0;r<16;++r)P0[r]=__builtin_amdgcn_exp2f(P0[r]); }while(0)
  #define RESC() do{ if(resc){ asm volatile("s_waitcnt lgkmcnt(0)":::"memory"); \
      _Pragma("unroll") for(int d_=0;d_<2;++d_) _Pragma("unroll") for(int r=0;r<16;++r)o[d_][r]*=wsf[crow(r,hi)]; } }while(0)
  f32x16 pA0,pA1,pB0,pB1;
  int sl_prev=0,sl_cur=0,sl_next=SLOTB;
  #define ROT() do{sl_prev=sl_cur;sl_cur=sl_next;sl_next=(sl_next==(NSLOT-1)*SLOTB)?0:sl_next+SLOTB;}while(0)
  if(!pre){ DMA_K(2,2*SLOTB); WAIT_BAR(3); } else { WAIT_BAR(7); }
  qkt(pA0,pA1,Kbase,qr,r32,hi);asm volatile("s_nop 15\n\ts_nop 7":"+v"(pA0),"+v"(pA1));CMASK(pA0,pA1,0);
  if(MODE==0){ addmask(pA0,pA1,ADDV(0)); }
  asm volatile("s_nop 7":"+v"(pA0),"+v"(pA1));
  START(pA0,pA1);
  _Pragma("unroll") for(int r=0;r<16;++r)pA1[r]=__builtin_amdgcn_exp2f(pA1[r]);
  WAIT_BAR(0);
  if(usebits&&NT>4){DMA_M(1);}
  DMA_K(3,0);DMA_V(1,SLOTB);
  ROT();
  kload8(kf,kp0+sl_cur);
  WAIT_BAR(2);
  s16x4 vlo[8],vhi[8]; u32x4 pw0,pw1,pw2,pw3;
  #define PKW(P,B) cvtpk_s(P[B],P[B+1])
  #define PAF(k) __builtin_bit_cast(bf16x8,pw##k)
  #define VFR(i) (bf16x8){vlo[i][0],vlo[i][1],vlo[i][2],vlo[i][3],vhi[i][0],vhi[i][1],vhi[i][2],vhi[i][3]}
  #define PIN(x) asm volatile("":"+v"(x))
  #define MX3(a,b,c) __builtin_fmaxf(__builtin_fmaxf((a),(b)),(c))
  #define GAPA(MF,A0,A1,A2,A3,W0,W1,PW) do{ MF; sacc+=A0; sacc+=A1; sacc+=A2; sacc+=A3; PIN(sacc); W0; W1; PIN(PW); SBAR(); }while(0)
  #define EX(v) __builtin_amdgcn_exp2f(v)
  #define GAPB(MF,X,B) do{ MF; X[B]=EX(X[B]); X[B+1]=EX(X[B+1]); X[B+2]=EX(X[B+2]); X[B+3]=EX(X[B+3]); PIN(X); SBAR(); }while(0)
  #define VRD(i) do{ vlo[i]=vtr(vp_+(((i)>>2)*4096+((i)&3)*1024)); vhi[i]=vtr(vp_+(((i)>>2)*4096+((i)&3)*1024+512)); }while(0)
  #define KRD(G,j) do{ if(G){ kload2(kf,kp0+sl_next,j); SBAR(); } }while(0)
  #define STEP(C0,C1,P0,P1,t,GK,GV,GL,GM) do{ SBAR(); \
    const lds_cptr vp_=vp0+sl_prev; \
    VRD(0); SBAR(); float sacc=(P0[0]+P0[1]); \
    GAPA(C0=__builtin_amdgcn_mfma_f32_32x32x16_bf16(kf[0],qr[0],zero16,0,0,0), P0[2],P0[3],P0[4],P0[5],     pw0[0]=PKW(P0,0), pw0[1]=PKW(P0,2), pw0); \
    VRD(4); SBAR(); GAPA(C1=__builtin_amdgcn_mfma_f32_32x32x16_bf16(kf[1],qr[0],zero16,0,0,0), P0[6],P0[7],P0[8],P0[9],     pw0[2]=PKW(P0,4), pw0[3]=PKW(P0,6), pw0); \
    VRD(1); SBAR(); GAPA(C0=__builtin_amdgcn_mfma_f32_32x32x16_bf16(kf[2],qr[1],C0,0,0,0),   P0[10],P0[11],P0[12],P0[13], pw1[0]=PKW(P0,8), pw1[1]=PKW(P0,10), pw1); \
    VRD(5); SBAR(); GAPA(C1=__builtin_amdgcn_mfma_f32_32x32x16_bf16(kf[3],qr[1],C1,0,0,0),   P0[14],P0[15],P1[0],P1[1],   pw1[2]=PKW(P0,12),pw1[3]=PKW(P0,14), pw1); \
    VRD(2); SBAR(); GAPA(C0=__builtin_amdgcn_mfma_f32_32x32x16_bf16(kf[4],qr[2],C0,0,0,0),   P1[2],P1[3],P1[4],P1[5],     pw2[0]=PKW(P1,0), pw2[1]=PKW(P1,2), pw2); \
    VRD(6); SBAR(); GAPA(C1=__builtin_amdgcn_mfma_f32_32x32x16_bf16(kf[5],qr[2],C1,0,0,0),   P1[6],P1[7],P1[8],P1[9],     pw2[2]=PKW(P1,4), pw2[3]=PKW(P1,6), pw2); \
    VRD(3); SBAR(); GAPA(C0=__builtin_amdgcn_mfma_f32_32x32x16_bf16(kf[6],qr[3],C0,0,0,0),   P1[10],P1[11],P1[12],P1[13], pw3[0]=PKW(P1,8), pw3[1]=PKW(P1,10), pw3); \
    VRD(7); SBAR(); GAPA(C1=__builtin_amdgcn_mfma_f32_32x32x16_bf16(kf[7],qr[3],C1,0,0,0),   P1[14],P1[15],0.f,0.f,       pw3[2]=PKW(P1,12),pw3[3]=PKW(P1,14), pw3); \
    l_reg+=sacc; \
    if(GM){DMA_M(((t)>>2)+1);} \
    if(GK){DMA_K((t)+3,sl_cur);} if(GV){DMA_V((t)+1,sl_next);} \
    CMASK(C0,C1,t); \
    { float a=MX3(C0[0],C0[1],C1[0]),b=MX3(C0[2],C0[3],C1[1]); a=MX3(a,C1[2],C1[3]); \
      _Pragma("unroll") for(int r=4;r<16;r+=4){a=MX3(a,C0[r],C0[r+1]);b=MX3(b,C0[r+2],C0[r+3]);a=MX3(a,C1[r],C1[r+1]);b=MX3(b,C1[r+2],C1[r+3]);} \
      float rm=__builtin_fmaxf(a,b); { auto rr=__builtin_amdgcn_permlane32_swap(__float_as_uint(rm),__float_as_uint(rm),false,false); rm=__builtin_fmaxf(__uint_as_float(rr[0]),__uint_as_float(rr[1])); } \
      const float addv_=ADDV(t); rm=(rm+addv_)-mhat; \
      resc=false; \
      if(__builtin_expect(__any(rm>(float)THRL),0)){ const float dl=__builtin_fmaxf(rm,0.f); mhat+=dl; \
        const float f=__builtin_amdgcn_exp2f(-dl); l_reg*=f; if(hi==0)wsf[r32]=f; resc=true; } \
      const float sub_=mhat-addv_; \
      _Pragma("unroll") for(int r=0;r<16;++r){C0[r]-=sub_;C1[r]-=sub_;} } \
    SBAR(); \
    GAPB(o[0]=__builtin_amdgcn_mfma_f32_32x32x16_bf16(PAF(0),VFR(0),o[0],0,0,0), C0,0); \
    GAPB(o[1]=__builtin_amdgcn_mfma_f32_32x32x16_bf16(PAF(0),VFR(4),o[1],0,0,0), C0,4); \
    KRD(GL,0); GAPB(o[0]=__builtin_amdgcn_mfma_f32_32x32x16_bf16(PAF(1),VFR(1),o[0],0,0,0), C0,8); \
    KRD(GL,1); GAPB(o[1]=__builtin_amdgcn_mfma_f32_32x32x16_bf16(PAF(1),VFR(5),o[1],0,0,0), C0,12); \
    KRD(GL,2); GAPB(o[0]=__builtin_amdgcn_mfma_f32_32x32x16_bf16(PAF(2),VFR(2),o[0],0,0,0), C1,0); \
    KRD(GL,3); GAPB(o[1]=__builtin_amdgcn_mfma_f32_32x32x16_bf16(PAF(2),VFR(6),o[1],0,0,0), C1,4); \
    GAPB(o[0]=__builtin_amdgcn_mfma_f32_32x32x16_bf16(PAF(3),VFR(3),o[0],0,0,0), C1,8); \
    GAPB(o[1]=__builtin_amdgcn_mfma_f32_32x32x16_bf16(PAF(3),VFR(7),o[1],0,0,0), C1,12); \
    }while(0)
  int t=1;
  #undef CMASK
  #undef ADDV
  #define CMASK(P0,P1,t) AMASK_STEADY(P0,P1,t)
  #define ADDV(t) ADDV_STEADY(t)
  for(;t+5<NT;t+=2){
    STEP(pB0,pB1,pA0,pA1,t,true,true,true,false);     WAIT_BAR(2); RESC(); ROT();
    STEP(pA0,pA1,pB0,pB1,t+1,true,true,true,(MODE==1&&(((t+1)&3)==0)&&(t+5<NT)));   WAIT_BAR(2); RESC(); ROT();
  }
  #undef CMASK
  #undef ADDV
  #define CMASK(P0,P1,t) AMASK_PEEL(P0,P1,t)
  #define ADDV(t) ADDV_PEEL(t)
  #define ENDW(tt) do{ if((tt)+3<NT){WAIT_BAR(2);} else if((tt)+2<NT){WAIT_BAR(1);} else {WAIT_BAR(0);} }while(0)
  for(;t+1<NT;t+=2){
    STEP(pB0,pB1,pA0,pA1,t,(t+3<NT),(t+1<NT),(t+1<NT),false);       ENDW(t);   RESC(); ROT();
    STEP(pA0,pA1,pB0,pB1,t+1,(t+4<NT),(t+2<NT),(t+2<NT),false);     ENDW(t+1); RESC(); ROT();
  }
  STEP(pB0,pB1,pA0,pA1,NT-1,false,false,false,false); RESC();
  { float sacc=pB0[0]+pB0[1]; _Pragma("unroll") for(int r=2;r<16;++r)sacc+=pB0[r]; _Pragma("unroll") for(int r=0;r<16;++r)sacc+=pB1[r]; l_reg+=sacc;
    pw0=(u32x4){PKW(pB0,0),PKW(pB0,2),PKW(pB0,4),PKW(pB0,6)};pw1=(u32x4){PKW(pB0,8),PKW(pB0,10),PKW(pB0,12),PKW(pB0,14)};pw2=(u32x4){PKW(pB1,0),PKW(pB1,2),PKW(pB1,4),PKW(pB1,6)};pw3=(u32x4){PKW(pB1,8),PKW(pB1,10),PKW(pB1,12),PKW(pB1,14)};
    SBAR(); pv(o,vb0+sl_cur,PAF(0),PAF(1),PAF(2),PAF(3)); }
  if(has_next){ const int q0n=qbn*QB; const bf16*Khn=Kn+rowbase*DM+h*D;
    glds16((const char*)Khn+koff,(unsigned)__builtin_amdgcn_readfirstlane(kdst));
    { const char*Qnw=(const char*)(Qn+(rowbase+q0n+wid*QBLK)*DM+h*D);
      #pragma unroll
      for(int j=0;j<4;++j) glds16(Qnw+(size_t)(8*j+(lane>>3))*(DM*2)+(((lane&7)^(lane>>3))*16),(unsigned)__builtin_amdgcn_readfirstlane(qst+j*1024)); }
    if(bitsn){ const unsigned long long*mbn=maskw+(size_t)(rowbase+q0n+wid*QBLK)*32; glds16((const char*)mbn+moff,(unsigned)__builtin_amdgcn_readfirstlane(mdst)); }
    glds16((const char*)Khn+(size_t)1*(KVBLK*DM*2)+koff,(unsigned)__builtin_amdgcn_readfirstlane(kdst+SLOTB));
    glds16((const char*)Khn+(size_t)2*(KVBLK*DM*2)+koff,(unsigned)__builtin_amdgcn_readfirstlane(kdst+2*SLOTB)); }
  #undef PKW
  #undef PAF
  #undef VFR
  #undef PIN
  #undef MX3
  #undef GAPA
  #undef GAPB
  #undef EX
  #undef VRD
  #undef KRD
  #undef STEP
  #undef ENDW
  {auto rr=__builtin_amdgcn_permlane32_swap(__float_as_uint(l_reg),__float_as_uint(l_reg),false,false);l_reg=__uint_as_float(rr[0])+__uint_as_float(rr[1]);}
  if(hi==0)wsf[32+r32]=l_reg;asm volatile("s_waitcnt lgkmcnt(0)":::"memory");
  float rli[16];
  #pragma unroll
  for(int r=0;r<16;++r)rli[r]=__builtin_amdgcn_rcpf(wsf[32+crow(r,hi)]);
  unsigned char*Ow=O+(rowbase+q0+wid*QBLK)*DM+h*D;
  { bf16*stg=(bf16*)(shm+LDS_OST)+wid*2048;
    #pragma unroll
    for(int r=0;r<16;++r){const int orow=crow(r,hi);
      #pragma unroll
      for(int d0=0;d0<2;++d0)stg[orow*64+d0*32+r32]=__float2bfloat16(o[d0][r]*rli[r]);}
    asm volatile("s_waitcnt lgkmcnt(0)":::"memory");
    #pragma unroll
    for(int i=0;i<4;++i){const int row=i*8+(lane>>3),ch=lane&7; const u32x4 v=*(const u32x4*)(stg+row*64+ch*8); u32x2 w;
      w.x=pg8::cvt4_fp8(16.f*__uint_as_float(v.x<<16),16.f*__uint_as_float(v.x&0xffff0000u),16.f*__uint_as_float(v.y<<16),16.f*__uint_as_float(v.y&0xffff0000u));
      w.y=pg8::cvt4_fp8(16.f*__uint_as_float(v.z<<16),16.f*__uint_as_float(v.z&0xffff0000u),16.f*__uint_as_float(v.w<<16),16.f*__uint_as_float(v.w&0xffff0000u));
      *(u32x2*)(Ow+(long)row*DM+ch*8)=w;} }
  asm volatile("s_waitcnt lgkmcnt(0)\n\ts_barrier":::"memory");
  #undef DMA_K
  #undef DMA_V
  #undef DMA_M
  #undef CMASK
  #undef AMASK_PEEL
  #undef AMASK_STEADY
  #undef ADDV
  #undef ADDV_PEEL
  #undef ADDV_STEADY
  #undef START
  #undef RESC
  #undef ROT
}
constexpr int ATTN_LDS_BYTES=LDS_BYTES;
#undef SBAR
#undef WAIT_BAR
}

constexpr int NWAVES = 8;
constexpr size_t MiB = 1u << 20;
constexpr size_t WS_CTL = 0, CTL_ZERO_BYTES = 1 * MiB;
constexpr size_t WS_WIN = 1 * MiB, WS_WA = 13 * MiB, WS_WB = 14 * MiB, WS_WOUT = 15 * MiB, WS_W13 = 17 * MiB, WS_W2 = 81 * MiB;
constexpr size_t WS_WR = 113 * MiB, WS_ROPE = 113 * MiB + 512 * 1024;
constexpr size_t WS_RSTD1 = 114 * MiB, WS_RSTD2 = 114 * MiB + 256 * 1024, WS_KBSUM = 114 * MiB + 512 * 1024;
constexpr size_t WS_KI = 115 * MiB, WS_WI = 123 * MiB, WS_MASK = 125 * MiB, WS_TOK = 141 * MiB, WS_GATE = 149 * MiB;
constexpr size_t WS_RSORT = WS_KI, WS_GSORT = WS_MASK;
constexpr size_t WS_QA = 152 * MiB, WS_KA = 216 * MiB, WS_VA = 280 * MiB, WS_QB = 344 * MiB, WS_KB = 408 * MiB, WS_VB = 472 * MiB, WS_QI = 536 * MiB;
constexpr size_t WS_XB = 600 * MiB, WS_OA = 928 * MiB, WS_OB = 960 * MiB, WS_MIX = 216 * MiB, WS_X1B = 728 * MiB, WS_HID = 856 * MiB, WS_YS = 152 * MiB, WS_END = 1024 * MiB;
constexpr size_t WS_WR8 = 113 * MiB + 256 * 1024;
constexpr size_t WS_X1H = 280 * MiB, WS_X1L = 408 * MiB;
static_assert(WS_HID + (size_t)HID_ROWS * EFF <= WS_OA, "ws map");
constexpr size_t WS_MIX8 = 152 * MiB;
constexpr size_t WS_WIN8 = WS_WIN + 6 * MiB, WS_X8 = 728 * MiB;
static_assert(WS_WIN + (size_t)NINA * DMODEL * 2 <= WS_WIN8 && WS_WIN8 + (size_t)NINB * DMODEL <= WS_WA, "ws map");
constexpr int CW_CNT = 64;
constexpr int CW_BAR = 4096;
constexpr int RING_BYTES = 131072, SCR_BYTES = 132096, MISC_OFF = SCR_BYTES, LDS_BYTES = 155648;
constexpr int QSTG_OFF = MISC_OFF + 4096, QSTG_STRIDE = 1056, WSTG_OFF = QSTG_OFF + 16 * QSTG_STRIDE;
static_assert(WSTG_OFF + 512 <= LDS_BYTES, "lds map");
constexpr int SC_STRIDE = 2052;
static_assert(16 * SC_STRIDE * 4 <= SCR_BYTES && attn_body::ATTN_LDS_BYTES <= RING_BYTES && attn_body::LDS_QST + attn_body::LDS_QST_BYTES <= MISC_OFF + 1024, "lds map");

#define GAS __attribute__((address_space(1)))
#define LAS __attribute__((address_space(3)))
typedef unsigned short bf16;
typedef unsigned v4u __attribute__((ext_vector_type(4)));
typedef unsigned v2u __attribute__((ext_vector_type(2)));
typedef float f32x4 __attribute__((ext_vector_type(4)));
typedef short bf16x8 __attribute__((ext_vector_type(8)));
#define LDS_WAIT() asm volatile("s_waitcnt lgkmcnt(0)" ::: "memory")
__device__ __forceinline__ unsigned f2bf(float f) { unsigned u = __builtin_bit_cast(unsigned, f); return (u + 0x7fffu + ((u >> 16) & 1u)) >> 16; }
__device__ __forceinline__ unsigned pk2(float lo, float hi) { return f2bf(lo) | (f2bf(hi) << 16); }
__device__ __forceinline__ float bf2f(unsigned s) { return __uint_as_float(s << 16); }

#define XB_TMO      128
#define XB_XCNT(j)  (256  + 64 * (j))
#define XB_XSUB(j)  (1280 + 64 * (j))
#define XB_XGEN(j)  (2304 + 64 * (j))
#define XB_TOP      3328
#define XB_TOPGEN   3392
#define XCD_BAR_WORDS 3456
#define XB_SPIN_CAP (1u << 22)
__device__ __forceinline__ unsigned xb_ld(unsigned* p)              { return __hip_atomic_load(p, __ATOMIC_RELAXED, __HIP_MEMORY_SCOPE_AGENT); }
__device__ __forceinline__ unsigned xb_add(unsigned* p, unsigned v) { return __hip_atomic_fetch_add(p, v, __ATOMIC_RELAXED, __HIP_MEMORY_SCOPE_AGENT); }
__device__ __forceinline__ unsigned xb_xcc_id() { return (unsigned)__builtin_amdgcn_s_getreg((3 << 11) | 20) & 0xFu; }
#define XB_SPIN(cond, bar) do { unsigned _sp = 0; while (cond) { __builtin_amdgcn_s_sleep(1); \
    if ((++_sp & 255u) == 0u) { if (xb_ld(&(bar)[XB_TMO])) break; if (_sp > XB_SPIN_CAP) { atomicAdd(&(bar)[XB_TMO], 1u); break; } } } } while (0)
struct XcdBarrier { unsigned* bar; unsigned x; volatile LAS unsigned* st; };
__device__ __forceinline__ XcdBarrier xcd_barrier_post(unsigned* bar, volatile LAS unsigned* st, int tid) {
    XcdBarrier b; b.bar = bar; b.x = xb_xcc_id(); b.st = st;
    if (tid == 0) (void)xb_add(&bar[XB_XCNT(b.x)], 1u);
    return b;
}
__device__ __forceinline__ void xcd_barrier_complete(unsigned* bar, unsigned x, unsigned G, unsigned& nloc, unsigned& nx) {
    unsigned sum, cnt, mine, sp = 0u;
    for (;;) {
        sum = 0u; cnt = 0u; mine = 0u;
#pragma unroll
        for (unsigned j = 0; j < 16; ++j) { const unsigned c = xb_ld(&bar[XB_XCNT(j)]); sum += c; cnt += (c > 0u) ? 1u : 0u; mine = (j == x) ? c : mine; }
        if (sum == G) break;
        __builtin_amdgcn_s_sleep(1);
        if ((++sp & 255u) == 0u) { if (xb_ld(&bar[XB_TMO])) break; if (sp > XB_SPIN_CAP) { atomicAdd(&bar[XB_TMO], 1u); break; } }
    }
    nloc = mine > 0u ? mine : 1u; nx = cnt > 0u ? cnt : 1u;
}
__device__ __forceinline__ void xcd_barrier(const XcdBarrier& b, int tid, unsigned G) {
    asm volatile("s_waitcnt vmcnt(0)" ::: "memory");
    __syncthreads();
    if (tid == 0) {
        unsigned* bar = b.bar;
        __builtin_amdgcn_s_waitcnt(0);
        unsigned nloc = b.st[0], nx = b.st[1];
        if (nloc == 0u) { xcd_barrier_complete(bar, b.x, G, nloc, nx); b.st[0] = nloc; b.st[1] = nx; }
        const unsigned old = xb_add(&bar[XB_XSUB(b.x)], 1u);
        const unsigned gen = old / nloc;
        if (old + 1u == (gen + 1u) * nloc) {
            __builtin_amdgcn_fence(__ATOMIC_RELEASE, "agent");
            asm volatile("s_waitcnt vmcnt(0)" ::: "memory");
            const unsigned og = xb_add(&bar[XB_TOP], 1u);
            const unsigned tg = og / nx;
            if (og + 1u == (tg + 1u) * nx) xb_add(&bar[XB_TOPGEN], 1u);
            else XB_SPIN(xb_ld(&bar[XB_TOPGEN]) == tg, bar);
            __builtin_amdgcn_fence(__ATOMIC_ACQUIRE, "agent");
            xb_add(&bar[XB_XGEN(b.x)], 1u);
            asm volatile("s_waitcnt vmcnt(0)" ::: "memory");
        } else {
            XB_SPIN(xb_ld(&bar[XB_XGEN(b.x)]) == gen, bar);
            __builtin_amdgcn_fence(__ATOMIC_ACQUIRE, "agent");
            asm volatile("s_waitcnt vmcnt(0)" ::: "memory");
        }
    }
    __syncthreads();
}

struct Frame {
    LAS unsigned char* lds; unsigned char* ldsg;
    int tid, lane, wave, vcu, G;
    const float *x, *g_mix, *w_in, *w_pa, *w_pb, *w_out, *g_ffn, *w_group, *b_group, *w_expert, *b_expert, *w1, *w3, *w2, *g_final;
    float* out; unsigned char* ws;
};

__device__ __forceinline__ int lane_id_v() { int l; asm volatile("v_mbcnt_lo_u32_b32 %0, -1, 0\n\tv_mbcnt_hi_u32_b32 %0, -1, %0" : "=v"(l)); return l; }
__device__ __forceinline__ float wave_sum(float v) {
#pragma unroll
    for (int o = 1; o < 64; o <<= 1) v += __shfl_xor(v, o);
    return v;
}

struct P0Item { const float* sp; const float* kscale; bf16* WT; unsigned sstride; int K, nrow0, k0; float mulz; float f8scale; };
__device__ __forceinline__ void p0_load(const P0Item& d, int lane, float (&v)[32], f32x4& g0, f32x4& g1) {
    const int c = lane & 7; g0 = (f32x4){1.f, 1.f, 1.f, 1.f}; g1 = g0;
    if (d.kscale) { g0 = *(const GAS f32x4*)(d.kscale + d.k0 + 8 * c); g1 = *(const GAS f32x4*)(d.kscale + d.k0 + 8 * c + 4); }
#pragma unroll
    for (int i = 0; i < 32; ++i) { const int kk = 2 * i + (lane >> 5); v[i] = d.sp[(size_t)(d.k0 + kk) * d.sstride]; }
}
__device__ __forceinline__ void p0_finish(const P0Item& d, int lane, const float (&v)[32], LAS float* scr, f32x4 g0, f32x4 g1) {
#pragma unroll
    for (int i = 0; i < 32; ++i) { const int kk = 2 * i + (lane >> 5); scr[kk * 33 + (lane & 31)] = v[i] * d.mulz; }
    LDS_WAIT(); asm volatile("" ::: "memory");
    const int c = lane & 7;
    if (d.f8scale != 0.f) { g0 = g0 * d.f8scale; g1 = g1 * d.f8scale;
#pragma unroll
        for (int j = 0; j < 4; ++j) { const int n = (lane >> 3) + 8 * j; const LAS float* s = scr + (8 * c) * 33 + n;
            v2u o; o.x = pg8::cvt4_fp8(s[0 * 33] * g0[0], s[1 * 33] * g0[1], s[2 * 33] * g0[2], s[3 * 33] * g0[3]); o.y = pg8::cvt4_fp8(s[4 * 33] * g1[0], s[5 * 33] * g1[1], s[6 * 33] * g1[2], s[7 * 33] * g1[3]);
            *(GAS v2u*)((unsigned char*)d.WT + (size_t)(d.nrow0 + n) * d.K + d.k0 + 8 * c) = o; }
        LDS_WAIT(); asm volatile("" ::: "memory"); return; }
#pragma unroll
    for (int j = 0; j < 4; ++j) { const int n = (lane >> 3) + 8 * j; const LAS float* s = scr + (8 * c) * 33 + n;
        v4u o; o.x = pk2(s[0 * 33] * g0[0], s[1 * 33] * g0[1]); o.y = pk2(s[2 * 33] * g0[2], s[3 * 33] * g0[3]); o.z = pk2(s[4 * 33] * g1[0], s[5 * 33] * g1[1]); o.w = pk2(s[6 * 33] * g1[2], s[7 * 33] * g1[3]);
        *(GAS v4u*)(d.WT + (size_t)(d.nrow0 + n) * d.K + d.k0 + 8 * c) = o; }
    LDS_WAIT(); asm volatile("" ::: "memory");
}
__device__ __forceinline__ int cmap_in(int np) {
    const int tile = np >> 8, sl = np & 255, bj = sl >> 7, wc = (sl >> 5) & 3, rho = sl & 31;
    if (tile < 14) { const int seg = tile >> 1;
        if (seg == 2 || seg == 5) return (np & ~255) + pg8::perm16(sl);
        return (np & ~255) + 64 * wc + 32 * bj + pg8::perm32(rho); }
    if (tile == 14) { if (wc == 0) return 3584 + 32 * bj + pg8::perm32(rho); if (bj == 0 && wc == 1 && rho < 8) return 3648 + rho; return -1; }
    return 3656 + (tile - 15) * 256 + pg8::perm16(sl);
}
__device__ const double INV_FREQ[32] = {1.0, 0.7498942093324559, 0.5623413251903491, 0.4216965034285822, 0.31622776601683794, 0.23713737056616552, 0.1778279410038923, 0.1333521432163324, 0.09999999999999999, 0.07498942093324558, 0.056234132519034905, 0.042169650342858224, 0.03162277660168379, 0.023713737056616554, 0.01778279410038923, 0.013335214321633239, 0.01, 0.007498942093324559, 0.005623413251903491, 0.004216965034285822, 0.0031622776601683794, 0.002371373705661655, 0.0017782794100389228, 0.0013335214321633238, 0.001, 0.0007498942093324559, 0.000562341325190349, 0.00042169650342858224, 0.00031622776601683794, 0.00023713737056616554, 0.0001778279410038923, 0.0001333521432163324};
__device__ __forceinline__ void sincos_d(double a, float& c, float& s) {
    const double TWO_OVER_PI = 0.63661977236758134308, PIO2_HI = 1.57079632679489655800e+00, PIO2_LO = 6.12323399573676603587e-17;
    const double kf = __builtin_rint(a * TWO_OVER_PI); const long k = (long)kf;
    const double y = (a - kf * PIO2_HI) - kf * PIO2_LO, y2 = y * y;
    const double sp = y * (1.0 + y2 * (-1.0 / 6 + y2 * (1.0 / 120 + y2 * (-1.0 / 5040 + y2 * (1.0 / 362880 + y2 * (-1.0 / 39916800 + y2 * (1.0 / 6227020800.0)))))));
    const double cp = 1.0 + y2 * (-0.5 + y2 * (1.0 / 24 + y2 * (-1.0 / 720 + y2 * (1.0 / 40320 + y2 * (-1.0 / 3628800 + y2 * (1.0 / 479001600.0 + y2 * (-1.0 / 87178291200.0)))))));
    double sv, cv; switch (k & 3) { case 0: sv = sp; cv = cp; break; case 1: sv = cp; cv = -sp; break; case 2: sv = -sp; cv = -cp; break; default: sv = -cp; cv = sp; break; }
    c = (float)cv; s = (float)sv;
}

__device__ __forceinline__ void p0_prologue(Frame& F) {
    unsigned char* ws = F.ws;
    LAS float* scr = (LAS float*)(F.lds + F.wave * 16384);
    const int gw = F.vcu * NWAVES + F.wave, NGW = F.G * NWAVES, lane = F.lane;
    bf16* WinT = (bf16*)(ws + WS_WIN); bf16* WaT = (bf16*)(ws + WS_WA); bf16* WbT = (bf16*)(ws + WS_WB); bf16* WoutT = (bf16*)(ws + WS_WOUT);
    bf16* W13T = (bf16*)(ws + WS_W13); bf16* W2T = (bf16*)(ws + WS_W2);
    constexpr int I_INA = 16 * (NINA / 32), I_INB = 16 * (NINB / 32), I_IN = I_INA + I_INB, I_PA = 8 * 32, I_OUT = 16 * 32, I_13 = 16 * 32 * NEXP, I_2 = 8 * 32 * NEXP;
    constexpr int NITEMS = I_IN + 2 * I_PA + I_OUT;
    (void)I_13; (void)I_2; (void)W13T; (void)W2T;
    auto decode = [&](int it) -> P0Item { P0Item d; d.mulz = 1.0f; d.kscale = nullptr; d.f8scale = 0.f; int r = it;
        if (r < I_IN) { const int part = r >= I_INA ? 1 : 0; if (part) r -= I_INA; const int ng = (part ? NINB : NINA) / 32, nb = r % ng, kb = r / ng;
            const int col = cmap_in(pg8::in_tile_of(part, nb >> 3) * 256 + (nb & 7) * 32 + (lane & 31));
            d.sp = F.w_in + (col >= 0 ? col : 0); d.mulz = col >= 0 ? 1.0f : 0.0f; d.sstride = IN_COLS; d.kscale = F.g_mix; d.K = DMODEL; d.nrow0 = nb * 32; d.k0 = kb * 64;
            if (part) { d.WT = (bf16*)(ws + WS_WIN8); d.f8scale = 32.0f; } else d.WT = WinT; return d; } r -= I_IN;
        if (r < 2 * I_PA) { const bool second = r >= I_PA; if (second) r -= I_PA; const int nb = r % 32, kb = r / 32; const int col = (nb >> 3) * 256 + pg8::perm16((nb & 7) * 32 + (lane & 31));
            d.sp = (second ? F.w_pb : F.w_pa) + col; d.sstride = DMODEL; d.WT = second ? WbT : WaT; d.K = HW; d.f8scale = 16.0f; d.nrow0 = nb * 32; d.k0 = kb * 64; return d; } r -= 2 * I_PA;
        if (r < I_OUT) { const int nb = r % 32, kb = r / 32; d.sp = F.w_out + (nb >> 3) * 256 + pg8::perm16((nb & 7) * 32 + (lane & 31)); d.sstride = DMODEL; d.WT = WoutT; d.K = DMODEL; d.f8scale = 32.0f; d.nrow0 = nb * 32; d.k0 = kb * 64; return d; } r -= I_OUT;
        return d; };
    if (gw < NITEMS) { P0Item dA = decode(gw), dB = dA; float vA[32], vB[32]; f32x4 gA0, gA1, gB0, gB1; p0_load(dA, lane, vA, gA0, gA1);
        for (int it = gw;;) {
            const int itB = it + NGW; const bool hasB = itB < NITEMS; if (hasB) { dB = decode(itB); p0_load(dB, lane, vB, gB0, gB1); }
            p0_finish(dA, lane, vA, scr, gA0, gA1); if (!hasB) break;
            const int itA = itB + NGW; const bool hasA = itA < NITEMS; if (hasA) { dA = decode(itA); p0_load(dA, lane, vA, gA0, gA1); }
            p0_finish(dB, lane, vB, scr, gB0, gB1); if (!hasA) break;
            it = itA; } }
    { bf16* Wh = (bf16*)(ws + WS_WR); bf16* Wl = Wh + 48 * DMODEL;
      for (int i = (F.vcu * NWAVES * 64) + F.tid; i < 48 * DMODEL; i += F.G * NWAVES * 64) { const int n = i / DMODEL, k = i % DMODEL;
          float w = 0.f; if (n < 4) w = F.w_group[k * 4 + n]; else if (n < 36) w = F.w_expert[k * 32 + (n - 4)]; w *= F.g_ffn[k];
          const unsigned h = f2bf(w); const float lo = w - bf2f(h); Wh[i] = (bf16)h; Wl[i] = (bf16)f2bf(lo);
          ((unsigned char*)(ws + WS_WR8))[i] = (unsigned char)(pg8::cvt4_fp8(lo * 16384.0f, 0.f, 0.f, 0.f) & 0xffu); } }
    { bf16* XB = (bf16*)(ws + WS_XB); float* irstd1 = (float*)(ws + WS_RSTD1);
#define P0X_LOAD(V, M0) do { _Pragma("unroll") for (int r = 0; r < 4; ++r) { const GAS f32x4* xr = (const GAS f32x4*)(F.x + (size_t)((M0) + r) * DMODEL) + lane; \
          _Pragma("unroll") for (int j = 0; j < 4; ++j) V[r][j] = xr[64 * j]; } } while (0)
#define P0X_DONE(V, M0) do { _Pragma("unroll") for (int r = 0; r < 4; ++r) { float s = 0.f; \
          _Pragma("unroll") for (int j = 0; j < 4; ++j) s += (V[r][j].x * V[r][j].x + V[r][j].y * V[r][j].y) + (V[r][j].z * V[r][j].z + V[r][j].w * V[r][j].w); \
          s = wave_sum(s); const float irs = sqrtf(s * (1.0f / DMODEL) + RMS_EPS), rs = 1.0f / irs; if (lane == 0) irstd1[(M0) + r] = irs; \
          GAS unsigned long long* o8 = (GAS unsigned long long*)(XB + (size_t)((M0) + r) * DMODEL) + lane; GAS unsigned* q8 = (GAS unsigned*)(ws + WS_X8 + (size_t)((M0) + r) * DMODEL) + lane; \
          _Pragma("unroll") for (int j = 0; j < 4; ++j) { const f32x4 w = V[r][j] * rs; \
              o8[64 * j] = (unsigned long long)pk2(w.x, w.y) | ((unsigned long long)pk2(w.z, w.w) << 32); q8[64 * j] = pg8::cvt4_fp8(w.x, w.y, w.z, w.w); } } } while (0)
      const int mstep = NGW * 4; int m0 = gw * 4;
      if (m0 < T) { f32x4 va[4][4], vb[4][4]; P0X_LOAD(va, m0);
          for (;;) {
              const int m1 = m0 + mstep; const bool h1 = m1 < T; if (h1) P0X_LOAD(vb, m1);
              P0X_DONE(va, m0); if (!h1) break;
              const int m2 = m1 + mstep; const bool h2 = m2 < T; if (h2) P0X_LOAD(va, m2);
              P0X_DONE(vb, m1); if (!h2) break;
              m0 = m2; } }
#undef P0X_LOAD
#undef P0X_DONE
    }
}

__device__ __forceinline__ void p2_kbsum(Frame& F) {
    const bf16* KA = (const bf16*)(F.ws + WS_KA); float* kbsum = (float*)(F.ws + WS_KBSUM);
    const int gw = F.vcu * NWAVES + F.wave, NGW = F.G * NWAVES, lane = F.lane;
    for (int it = gw; it < NBATCH * NHEAD * 8; it += NGW) { const int j = it & 7, h = (it >> 3) & 7, b = it >> 6;
        const bf16* base = KA + ((size_t)(b * SEQ + j * 256 + (lane >> 3))) * HW + h * 64 + (lane & 7) * 8; float s[8];
#pragma unroll
        for (int k = 0; k < 8; ++k) s[k] = 0.f;
#pragma unroll 4
        for (int i = 0; i < 32; ++i) { const v4u w = *(const GAS v4u*)(base + (size_t)i * 8 * HW);
#pragma unroll
            for (int k = 0; k < 4; ++k) { s[2 * k] += bf2f(w[k] & 0xffffu); s[2 * k + 1] += __uint_as_float(w[k] & 0xffff0000u); } }
#pragma unroll
        for (int k = 0; k < 8; ++k) { s[k] += __shfl_xor(s[k], 8); s[k] += __shfl_xor(s[k], 16); s[k] += __shfl_xor(s[k], 32); }
        if (lane < 8) { float* o = kbsum + (size_t)it * 64 + lane * 8; *(f32x4*)o = (f32x4){s[0], s[1], s[2], s[3]}; *(f32x4*)(o + 4) = (f32x4){s[4], s[5], s[6], s[7]}; } }
}

__device__ __forceinline__ int wsum6(int c) { int tot = 0;
#pragma unroll
    for (int b = 0; b < 6; ++b) tot += __popcll(__ballot((c >> b) & 1)) << b;
    return tot; }
__device__ __forceinline__ int sel_cnt_ge(const unsigned (&key)[32], int nq, unsigned cand) { int c = 0;
    const unsigned cs = (unsigned)__builtin_amdgcn_readfirstlane((int)cand);
#pragma unroll
    for (int q = 0; q < 8; ++q) { if (q < nq) { unsigned long long m0, m1, m2, m3;
        asm volatile("v_cmp_le_u32_e64 %0, %4, %5\n\tv_cmp_le_u32_e64 %1, %4, %6\n\tv_cmp_le_u32_e64 %2, %4, %7\n\tv_cmp_le_u32_e64 %3, %4, %8"
                     : "=&s"(m0), "=&s"(m1), "=&s"(m2), "=&s"(m3) : "s"(cs), "v"(key[4 * q]), "v"(key[4 * q + 1]), "v"(key[4 * q + 2]), "v"(key[4 * q + 3]));
        c += (__popcll(m0) + __popcll(m1)) + (__popcll(m2) + __popcll(m3)); } }
    return c; }
#define SEL_CMP4(q) asm volatile("v_cmp_le_u32_e64 %0, %4, %5\n\tv_cmp_le_u32_e64 %1, %4, %6\n\tv_cmp_le_u32_e64 %2, %4, %7\n\tv_cmp_le_u32_e64 %3, %4, %8" \
        : "=&s"(m[q][0]), "=&s"(m[q][1]), "=&s"(m[q][2]), "=&s"(m[q][3]) : "s"(cs), "v"(key[4 * (q)]), "v"(key[4 * (q) + 1]), "v"(key[4 * (q) + 2]), "v"(key[4 * (q) + 3]))
template <int NQ> __device__ __forceinline__ int sel_cnt_ge_t(const unsigned (&key)[32], unsigned cand) {
    const unsigned cs = (unsigned)__builtin_amdgcn_readfirstlane((int)cand); unsigned long long m[NQ][4]; int c = 0;
    SEL_CMP4(0);
#pragma unroll
    for (int q = 0; q < NQ; ++q) { if (q + 1 < NQ) SEL_CMP4(q + 1); c += (__popcll(m[q][0]) + __popcll(m[q][1])) + (__popcll(m[q][2]) + __popcll(m[q][3])); }
    return c; }
template <int NQ> __device__ __forceinline__ void sel_bisect_full(const unsigned (&key)[32], const unsigned M, unsigned& lo, unsigned& hi, int& clo, int& chi, bool& exact) {
    { const unsigned lo0 = (M > (4u << 23)) ? M - (4u << 23) : 0u;
      if (lo0 > 0u) { const int c0 = sel_cnt_ge_t<NQ>(key, lo0); if (c0 >= 256) { lo = lo0; clo = c0; exact = (c0 == 256); } else { hi = lo0; chi = c0; } } }
#pragma unroll 1
    while (!exact && hi - lo > 1u && clo - chi > 64) { const unsigned mid = lo + ((hi - lo) >> 1);
        const int tot = sel_cnt_ge_t<NQ>(key, mid);
        if (tot >= 256) { lo = mid; clo = tot; exact = (tot == 256); } else { hi = mid; chi = tot; } }
}
__device__ __forceinline__ int sel_cnt_eq_lt(const unsigned (&key)[32], int nq, unsigned val, int cx, int lane) { int c = 0;
#pragma unroll
    for (int q = 0; q < 8; ++q) { if (q < nq) {
#pragma unroll
        for (int k = 0; k < 4; ++k) c += __popcll(__ballot(key[4 * q + k] == val && (64 * (4 * q + k) + lane) < cx)); } }
    return c; }
__device__ __forceinline__ unsigned wave_max_u32(unsigned v) {
    int x = (int)v;
    { const int t = __builtin_amdgcn_update_dpp(x, x, 0xB1, 0xF, 0xF, false); x = (int)max((unsigned)x, (unsigned)t); }
    { const int t = __builtin_amdgcn_update_dpp(x, x, 0x4E, 0xF, 0xF, false); x = (int)max((unsigned)x, (unsigned)t); }
    { const int t = __builtin_amdgcn_update_dpp(x, x, 0x141, 0xF, 0xF, false); x = (int)max((unsigned)x, (unsigned)t); }
    { const int t = __builtin_amdgcn_update_dpp(x, x, 0x140, 0xF, 0xF, false); x = (int)max((unsigned)x, (unsigned)t); }
    const unsigned a = (unsigned)__builtin_amdgcn_readlane(x, 0), b = (unsigned)__builtin_amdgcn_readlane(x, 16), c = (unsigned)__builtin_amdgcn_readlane(x, 32), d = (unsigned)__builtin_amdgcn_readlane(x, 48);
    return max(max(a, b), max(c, d));
}
struct SelStep { int b, g, half; };
__device__ __forceinline__ void sel_load_q(Frame& F, const SelStep st, bf16x8 (&bq)[8][2], float (&w8)[8]) {
    const bf16* QI = (const bf16*)(F.ws + WS_QI); const float* WI = (const float*)(F.ws + WS_WI);
    const int qidx = F.lane & 15, kc = F.lane >> 4; const size_t qrow = (size_t)(st.b * SEQ + st.g * 32 + st.half * 16 + qidx);
#pragma unroll
    for (int h = 0; h < 8; ++h) {
#pragma unroll
        for (int ks = 0; ks < 2; ++ks) bq[h][ks] = *(const GAS bf16x8*)(QI + qrow * HW + h * 64 + ks * 32 + kc * 8); }
    const f32x4 a = *(const GAS f32x4*)(WI + qrow * 8), c = *(const GAS f32x4*)(WI + qrow * 8 + 4); w8[0] = a[0]; w8[1] = a[1]; w8[2] = a[2]; w8[3] = a[3]; w8[4] = c[0]; w8[5] = c[1]; w8[6] = c[2]; w8[7] = c[3];
}
__device__ __forceinline__ void sel_stage_q(Frame& F, const SelStep st) {
    const size_t qrow0 = (size_t)(st.b * SEQ + st.g * 32 + st.half * 16); const unsigned lds0 = (unsigned)(uintptr_t)F.lds;
#pragma unroll
    for (int rr = 0; rr < 2; ++rr) { const int row = 2 * F.wave + rr;
        attn_body::glds16((const char*)(F.ws + WS_QI) + (qrow0 + row) * (HW * 2) + F.lane * 16, (unsigned)__builtin_amdgcn_readfirstlane((int)(lds0 + QSTG_OFF + row * QSTG_STRIDE))); }
    if (F.wave == 0 && F.lane < 32) attn_body::glds16((const char*)(F.ws + WS_WI) + qrow0 * 32 + F.lane * 16, (unsigned)__builtin_amdgcn_readfirstlane((int)(lds0 + WSTG_OFF)));
}
__device__ __forceinline__ void sel_load_q_lds(Frame& F, bf16x8 (&bq)[8][2], float (&w8)[8]) {
    const int qidx = F.lane & 15, kc = F.lane >> 4; LAS char* q = (LAS char*)(F.lds + QSTG_OFF + qidx * QSTG_STRIDE + kc * 16);
#pragma unroll
    for (int h = 0; h < 8; ++h) {
#pragma unroll
        for (int ks = 0; ks < 2; ++ks) bq[h][ks] = *(const LAS bf16x8*)(q + h * 128 + ks * 64); }
    const f32x4 a = *(const LAS f32x4*)(F.lds + WSTG_OFF + qidx * 32), c = *(const LAS f32x4*)(F.lds + WSTG_OFF + qidx * 32 + 16); w8[0] = a[0]; w8[1] = a[1]; w8[2] = a[2]; w8[3] = a[3]; w8[4] = c[0]; w8[5] = c[1]; w8[6] = c[2]; w8[7] = c[3];
}
__device__ __forceinline__ void sel_loadg0(Frame& F, const SelStep st, bf16x8 (&A0)[4], bf16x8 (&A1)[4]) {
    const bf16* KI = (const bf16*)(F.ws + WS_KI); const int qidx = F.lane & 15, kc = F.lane >> 4;
    const int ntg = __builtin_amdgcn_readfirstlane((st.g + 2) >> 1), nsub = ntg * 4;
#pragma unroll
    for (int u = 0; u < 4; ++u) { int st_ = F.wave + 8 * u; st_ = st_ < nsub ? st_ : nsub - 1;
        const bf16* kp_ = KI + (size_t)(st.b * SEQ + st_ * 16 + qidx) * 64 + kc * 8; A0[u] = *(const GAS bf16x8*)kp_; A1[u] = *(const GAS bf16x8*)(kp_ + 32); }
}
__device__ __forceinline__ void sel_scores(Frame& F, const SelStep st, const bf16x8 (&bq)[8][2], const float (&w8)[8], const bf16x8 (&P0)[4], const bf16x8 (&P1)[4]) {
    const bf16* KI = (const bf16*)(F.ws + WS_KI); LAS float* sc = (LAS float*)F.lds;
    const int lane = F.lane, wave = F.wave, qidx = lane & 15, kc = lane >> 4, b = st.b;
    const int ntg = __builtin_amdgcn_readfirstlane((st.g + 2) >> 1), nsub = ntg * 4;
    const int nit = (nsub + 7) >> 3, ngrp = (nit + 3) >> 2;
    bf16x8 A0[4], A1[4], B0[4], B1[4];
#define SEL_LOADG(X0, X1, gi) do { _Pragma("unroll") for (int u = 0; u < 4; ++u) { int st_ = wave + 8 * (4 * (gi) + u); st_ = st_ < nsub ? st_ : nsub - 1; \
        const bf16* kp_ = KI + (size_t)(b * SEQ + st_ * 16 + qidx) * 64 + kc * 8; X0[u] = *(const GAS bf16x8*)kp_; X1[u] = *(const GAS bf16x8*)(kp_ + 32); } } while (0)
#define SEL_COMPG(X0, X1, gi) do { _Pragma("unroll") for (int u = 0; u < 4; ++u) { const int st_ = wave + 8 * (4 * (gi) + u); if (st_ < nsub) { f32x4 s_ = {0.f, 0.f, 0.f, 0.f}; \
        _Pragma("unroll") for (int h = 0; h < 8; ++h) { f32x4 d_ = __builtin_amdgcn_mfma_f32_16x16x32_bf16(X0[u], bq[h][0], (f32x4){0.f, 0.f, 0.f, 0.f}, 0, 0, 0); \
            d_ = __builtin_amdgcn_mfma_f32_16x16x32_bf16(X1[u], bq[h][1], d_, 0, 0, 0); \
            _Pragma("unroll") for (int k = 0; k < 4; ++k) s_[k] += w8[h] * __int_as_float(max(__float_as_int(d_[k]), 0)); }   \
        *(LAS f32x4*)(sc + qidx * SC_STRIDE + st_ * 16 + 4 * kc) = s_; } } } while (0)
#pragma unroll
    for (int u = 0; u < 4; ++u) { A0[u] = P0[u]; A1[u] = P1[u]; }
    for (int gi = 0; gi < ngrp; gi += 2) {
        if (gi + 1 < ngrp) SEL_LOADG(B0, B1, gi + 1);
        SEL_COMPG(A0, A1, gi);
        if (gi + 1 < ngrp) { if (gi + 2 < ngrp) SEL_LOADG(A0, A1, gi + 2); SEL_COMPG(B0, B1, gi + 1); }
    }
#undef SEL_LOADG
#undef SEL_COMPG
}
__device__ __forceinline__ void sel_rows(Frame& F, const SelStep st) {
    unsigned long long* maskw = (unsigned long long*)(F.ws + WS_MASK); LAS float* sc = (LAS float*)F.lds;
    const int lane = F.lane, wave = F.wave, b = st.b;
    const int ntg = __builtin_amdgcn_readfirstlane((st.g + 2) >> 1), nq = (ntg + 3) >> 2; const int qh = st.g * 32 + st.half * 16;
    LAS int* rowctr = (LAS int*)(F.lds + MISC_OFF + 3072);
    for (;;) { int row_ = 0; if (lane == 0) row_ = __hip_atomic_fetch_add(rowctr, 1, __ATOMIC_RELAXED, __HIP_MEMORY_SCOPE_WORKGROUP);
        const int row = __builtin_amdgcn_readfirstlane(row_); if (row >= 16) break;
        const int t = __builtin_amdgcn_readfirstlane(qh + row);
        unsigned key[32]; unsigned mx = 0u;
#pragma unroll
        for (int q = 0; q < 8; ++q) {
#pragma unroll
            for (int k = 0; k < 4; ++k) key[4 * q + k] = 0u;
            if (q < nq) {
#pragma unroll
                for (int k = 0; k < 4; ++k) { const int j = 4 * q + k; const float v = sc[row * SC_STRIDE + 64 * j + lane]; const unsigned u = __float_as_uint(v);
                    const unsigned kk = (u & 0x80000000u) ? ~u : (u | 0x80000000u); key[j] = (64 * j + lane <= t) ? kk : 0u; mx = max(mx, key[j]); } } }
        const unsigned M = wave_max_u32(mx);
        unsigned lo = 0u, hi = M + 1u; int clo = 1 << 20, chi = 0; bool exact = false;
        switch (nq) { case 2: sel_bisect_full<2>(key, M, lo, hi, clo, chi, exact); break; case 3: sel_bisect_full<3>(key, M, lo, hi, clo, chi, exact); break;
            case 4: sel_bisect_full<4>(key, M, lo, hi, clo, chi, exact); break; case 5: sel_bisect_full<5>(key, M, lo, hi, clo, chi, exact); break;
            case 6: sel_bisect_full<6>(key, M, lo, hi, clo, chi, exact); break; case 7: sel_bisect_full<7>(key, M, lo, hi, clo, chi, exact); break;
            default: sel_bisect_full<8>(key, M, lo, hi, clo, chi, exact); break; }
        if (!exact && hi - lo > 1u) {
            LAS unsigned* cb = (LAS unsigned*)(sc + row * SC_STRIDE); int base = 0; const unsigned wdt = hi - lo;
#pragma unroll
            for (int q = 0; q < 8; ++q) { if (q < nq) {
#pragma unroll
                for (int k = 0; k < 4; ++k) { const int j = 4 * q + k; const bool inb = (key[j] - lo) < wdt; const unsigned long long m = __ballot(inb);
                    const int pos = base + (int)__builtin_amdgcn_mbcnt_hi((unsigned)(m >> 32), __builtin_amdgcn_mbcnt_lo((unsigned)m, 0u));
                    cb[inb ? pos : 64 + lane] = key[j]; base += __popcll(m); } } }
            LDS_WAIT(); asm volatile("" ::: "memory");
            unsigned cand = cb[lane]; LDS_WAIT(); cand = (lane < base) ? cand : 0u;
#pragma unroll 1
            while (!exact && hi - lo > 1u) { const unsigned mid = lo + ((hi - lo) >> 1);
                const int tot = chi + __popcll(__ballot(cand >= mid));
                if (tot >= 256) { lo = mid; exact = (tot == 256); } else hi = mid; } }
        unsigned P; int xcut;
        if (exact) { P = lo - 1u; xcut = -1; }
        else {
            const int need = 256 - sel_cnt_ge(key, nq, lo + 1u); int xx = 0;
#pragma unroll 1
            for (int bit = 10; bit >= 0; --bit) { const int cx = xx | (1 << bit);
                if (sel_cnt_eq_lt(key, nq, lo, cx, lane) < need) xx = cx; }
            P = lo; xcut = xx; }
        int mlo = 0, mhi = 0;
        if (exact) {
            const unsigned cs = (unsigned)__builtin_amdgcn_readfirstlane((int)lo); unsigned long long m[8][4];
#define SEL_WL(q, k) do { const int a_ = (int)(unsigned)m[q][k], b_ = (int)(unsigned)(m[q][k] >> 32); \
                asm volatile("v_writelane_b32 %0, %1, %2" : "+v"(mlo) : "s"(a_), "n"(4 * (q) + (k))); asm volatile("v_writelane_b32 %0, %1, %2" : "+v"(mhi) : "s"(b_), "n"(4 * (q) + (k))); } while (0)
#define SEL_EX4(q) do { if ((q) < nq) { SEL_CMP4(q); SEL_WL(q, 0); SEL_WL(q, 1); SEL_WL(q, 2); SEL_WL(q, 3); } } while (0)
            SEL_EX4(0); SEL_EX4(1); SEL_EX4(2); SEL_EX4(3); SEL_EX4(4); SEL_EX4(5); SEL_EX4(6); SEL_EX4(7);
#undef SEL_EX4
#undef SEL_WL
        } else {
#define SEL_EMIT(j) do { const bool al = (key[j] > P) || (key[j] == P && (64 * (j) + lane) <= xcut); \
            const unsigned long long m = __ballot(al); const int m0_ = (int)(unsigned)m, m1_ = (int)(unsigned)(m >> 32); \
            asm volatile("v_writelane_b32 %0, %1, %2" : "+v"(mlo) : "s"(m0_), "n"(j)); asm volatile("v_writelane_b32 %0, %1, %2" : "+v"(mhi) : "s"(m1_), "n"(j)); } while (0)
#define SEL_EMIT4(q) do { if ((q) < nq) { SEL_EMIT(4 * (q)); SEL_EMIT(4 * (q) + 1); SEL_EMIT(4 * (q) + 2); SEL_EMIT(4 * (q) + 3); } } while (0)
        SEL_EMIT4(0); SEL_EMIT4(1); SEL_EMIT4(2); SEL_EMIT4(3); SEL_EMIT4(4); SEL_EMIT4(5); SEL_EMIT4(6); SEL_EMIT4(7);
#undef SEL_EMIT4
#undef SEL_EMIT
        }
        if (lane < 32) maskw[(size_t)(b * SEQ + t) * 32 + lane] = ((unsigned long long)(unsigned)mhi << 32) | (unsigned long long)(unsigned)mlo;
    }
}
constexpr int MW_I13 = 16 * 32 * NEXP, MW_I2 = 8 * 32 * NEXP, MW_ITEMS = MW_I13 + MW_I2;
struct MwItem { const float* sp; unsigned sstride; unsigned char* wt; const float* ks; float f8; };
__device__ __forceinline__ MwItem mw_decode(Frame& F, int it, int lane) { MwItem d; asm volatile("" : "+v"(lane));
    const int h = lane >> 5;
    if (it < MW_I13) { const int e = it / 512, r = it % 512, nb = r % 32, kb = r / 32;
        d.sp = (((nb >> 2) & 1) ? F.w3 : F.w1) + (size_t)e * DMODEL * EFF + 128 * (nb >> 3) + 32 * (nb & 3) + pg8::perm32(lane & 31) + (size_t)(kb * 64 + 32 * h) * EFF; d.sstride = EFF;
        d.wt = F.ws + WS_W13 + (size_t)e * 1024 * DMODEL + (size_t)(nb * 32 + (lane & 31)) * DMODEL + kb * 64 + 32 * h; d.ks = F.g_ffn + kb * 64; d.f8 = 32.0f; }
    else { const int r0 = it - MW_I13, e = r0 / 256, r = r0 % 256, nb = r % 32, kb = r / 32; const int col = (nb >> 3) * 256 + pg8::perm16((nb & 7) * 32 + (lane & 31));
        d.sp = F.w2 + (size_t)e * EFF * DMODEL + col + (size_t)(kb * 64 + 32 * h) * DMODEL; d.sstride = DMODEL;
        d.wt = F.ws + WS_W2 + (size_t)e * DMODEL * EFF + (size_t)(nb * 32 + (lane & 31)) * EFF + kb * 64 + 32 * h; d.ks = nullptr; d.f8 = 16.0f; }
    return d; }
__device__ __forceinline__ void mw_load(const MwItem& d, int lane, float (&v)[32], float& gv) {
#pragma unroll
    for (int i = 0; i < 32; ++i) v[i] = d.sp[(size_t)i * d.sstride];
    gv = d.ks ? d.ks[lane] : 1.0f; }
__device__ __forceinline__ void mw_finish(const MwItem& d, int lane, const float (&v)[32], float gv) {
    asm volatile("" : "+v"(lane)); const int src = (lane & 32); gv *= d.f8; unsigned w[8];
#pragma unroll
    for (int c = 0; c < 8; ++c) { float t[4];
#pragma unroll
        for (int k = 0; k < 4; ++k) t[k] = v[4 * c + k] * __shfl(gv, src + 4 * c + k);
        w[c] = pg8::cvt4_fp8(t[0], t[1], t[2], t[3]); }
    v4u o0, o1; o0.x = w[0]; o0.y = w[1]; o0.z = w[2]; o0.w = w[3]; o1.x = w[4]; o1.y = w[5]; o1.z = w[6]; o1.w = w[7];
    *(GAS v4u*)d.wt = o0; *(GAS v4u*)(d.wt + 16) = o1; }
__device__ __forceinline__ void p2_select(Frame& F) {
    const int nitems = (F.G == 256) ? 7 : ((NBATCH * 56 - F.vcu + F.G - 1) / F.G), nsteps = 2 * nitems;
    auto decode = [&](int s) -> SelStep { SelStep st; const int r = s >> 1; st.half = s & 1;
        if (F.G == 256) { st.b = F.vcu >> 3; const int c = F.vcu & 7; st.g = 8 + 8 * r + ((r & 1) ? 7 - c : c); }
        else { const int I = F.vcu + r * F.G; st.b = I / 56; st.g = 8 + I % 56; }
        return st; };
    if (nsteps <= 0) return;
    const int gw = F.vcu * NWAVES + F.wave, NGW = F.G * NWAVES;
    bf16x8 kA0[4], kA1[4];
    sel_stage_q(F, decode(0)); asm volatile("s_waitcnt vmcnt(0)" ::: "memory"); sel_loadg0(F, decode(0), kA0, kA1); __syncthreads();
    for (int s = 0; s < nsteps; ++s) {
        { int l_ = F.lane; asm volatile("" : "+v"(l_)); F.lane = l_; }
        const SelStep st = decode(s); bf16x8 qA[8][2]; float wA[8];
        const int mit = gw + NGW * s; const bool mw = mit < MW_ITEMS; float mv[32], mg = 1.0f;
        if (F.tid == 0) *(LAS int*)(F.lds + MISC_OFF + 3072) = 0;
        sel_load_q_lds(F, qA, wA); sel_scores(F, st, qA, wA, kA0, kA1); __syncthreads();
        if (s + 1 < nsteps) sel_stage_q(F, decode(s + 1));
        if (mw) { const MwItem md = mw_decode(F, mit, F.lane); mw_load(md, F.lane, mv, mg); }
        sel_rows(F, st);
        if (mw) { const MwItem md = mw_decode(F, mit, F.lane); mw_finish(md, F.lane, mv, mg); }
        asm volatile("s_waitcnt vmcnt(0)" ::: "memory");
        if (s + 1 < nsteps) sel_loadg0(F, decode(s + 1), kA0, kA1);
        __syncthreads(); }
    for (int mit = gw + NGW * nsteps; mit < MW_ITEMS; mit += NGW) { float mv[32], mg; const MwItem md = mw_decode(F, mit, F.lane); mw_load(md, F.lane, mv, mg); mw_finish(md, F.lane, mv, mg); }
}

__device__ __forceinline__ void p6_router(Frame& F, bool dummy) {
    const bf16* XH = (const bf16*)(F.ws + WS_X1H); const unsigned char* XL = (const unsigned char*)(F.ws + WS_X1L); float* rstd2 = (float*)(F.ws + WS_RSTD2);
    const bf16* Wh = (const bf16*)(F.ws + WS_WR); const bf16* Wl = Wh + 48 * DMODEL;
    int* tokl = (int*)(F.ws + WS_TOK); float* gate = (float*)(F.ws + WS_GATE); unsigned* gcnt = (unsigned*)(F.ws + WS_CTL) + CW_CNT + (dummy ? 32 : 0);
    LAS float* lg = (LAS float*)F.lds + F.wave * (16 * 48);
    LAS int* hist = (LAS int*)(F.lds + 32768); LAS int* base = hist + 32;
    LAS int* aE = (LAS int*)(F.lds + 36864); LAS int* aP = aE + 512; LAS float* aG = (LAS float*)(aP + 512); LAS float* aR = aG + 512;
    float* rsort = (float*)(F.ws + WS_RSORT); float* gsort = (float*)(F.ws + WS_GSORT);
    const int lane = F.lane, wave = F.wave, tk = lane & 15, kc = lane >> 4;
    constexpr int WLDS_OFF = 49152, WLDS_STRIDE = 2080;
    { LAS char* wl_ = (LAS char*)(F.lds + WLDS_OFF);
      for (int i = F.tid; i < 37 * 128; i += NWAVES * 64) { const int row = i >> 7, ch = i & 127; v4u v = {0u, 0u, 0u, 0u};
          if (row < 36) v = *(const GAS v4u*)((const GAS char*)Wh + (size_t)(row * 2048 + ch * 16));
          *(LAS v4u*)(wl_ + row * WLDS_STRIDE + ch * 16) = v; } }
    for (int st = F.vcu; st < T / 256; st += F.G) {
        if (F.tid < 32) hist[F.tid] = 0;
        __syncthreads();
        const int rbase = st * 256 + wave * 32;
        f32x4 acc[2][3], accs[2];
#pragma unroll
        for (int tt = 0; tt < 2; ++tt) { accs[tt] = (f32x4){0.f, 0.f, 0.f, 0.f};
#pragma unroll
            for (int nt = 0; nt < 3; ++nt) acc[tt][nt] = (f32x4){0.f, 0.f, 0.f, 0.f}; }
        unsigned w8o[3], xof[2], lof[2]; const unsigned char* W8 = (const unsigned char*)(F.ws + WS_WR8);
#pragma unroll
        for (int nt = 0; nt < 3; ++nt) { w8o[nt] = (unsigned)((nt * 16 + tk) * DMODEL + kc * 8); asm volatile("" : "+v"(w8o[nt])); }
#pragma unroll
        for (int tt = 0; tt < 2; ++tt) { lof[tt] = (unsigned)((rbase + tt * 16 + tk) * DMODEL + kc * 8); xof[tt] = lof[tt] * 2u; asm volatile("" : "+v"(xof[tt])); asm volatile("" : "+v"(lof[tt])); }
        bf16x8 whA[3]; v2u w80[3], w81[3], w82[3], w83[3], w84[3], w85[3], w86[3], w87[3]; bf16x8 xh0[2], xh1[2], xh2[2], xh3[2], xh4[2], xh5[2], xh6[2], xh7[2]; v2u xl0[2], xl1[2], xl2[2], xl3[2], xl4[2], xl5[2], xl6[2], xl7[2];
#define P6_LOADW(WH, kk) do { _Pragma("unroll") for (int nt = 0; nt < 3; ++nt) WH[nt] = *(const LAS bf16x8*)(F.lds + (WLDS_OFF + ((nt * 16 + tk) < 36 ? (nt * 16 + tk) : 36) * WLDS_STRIDE + kc * 16) + (kk) * 64); } while (0)
#define P6_LOADWL(W8r, kk) do { _Pragma("unroll") for (int nt = 0; nt < 3; ++nt) W8r[nt] = *(const GAS v2u*)((const GAS char*)W8 + (size_t)(w8o[nt] + (unsigned)((kk) * 32))); } while (0)
#define P6_LOADX(XHr, XLr, kk) do { _Pragma("unroll") for (int tt = 0; tt < 2; ++tt) { \
            XHr[tt] = *(const GAS bf16x8*)((const GAS char*)XH + (size_t)(xof[tt] + (unsigned)((kk) * 64))); XLr[tt] = *(const GAS v2u*)((const GAS char*)XL + (size_t)(lof[tt] + (unsigned)((kk) * 32))); } } while (0)
#define P6_COMP(WH, W8r, XHr, XLr, kk) do { bf16x8 WL[3]; \
        _Pragma("unroll") for (int nt = 0; nt < 3; ++nt) { typedef float v2f_ __attribute__((ext_vector_type(2))); const v2u l8 = W8r[nt]; v4u lw_; \
            const v2f_ a0 = __builtin_amdgcn_cvt_pk_f32_fp8((int)l8.x, false), a1 = __builtin_amdgcn_cvt_pk_f32_fp8((int)l8.x, true), c0 = __builtin_amdgcn_cvt_pk_f32_fp8((int)l8.y, false), c1 = __builtin_amdgcn_cvt_pk_f32_fp8((int)l8.y, true); \
            lw_.x = pg8::cvt_pk_bf16(a0.x * (1.0f / 16384.0f), a0.y * (1.0f / 16384.0f)); lw_.y = pg8::cvt_pk_bf16(a1.x * (1.0f / 16384.0f), a1.y * (1.0f / 16384.0f)); \
            lw_.z = pg8::cvt_pk_bf16(c0.x * (1.0f / 16384.0f), c0.y * (1.0f / 16384.0f)); lw_.w = pg8::cvt_pk_bf16(c1.x * (1.0f / 16384.0f), c1.y * (1.0f / 16384.0f)); WL[nt] = __builtin_bit_cast(bf16x8, lw_); } \
        _Pragma("unroll") for (int tt = 0; tt < 2; ++tt) { const bf16x8 xh = XHr[tt]; bf16x8 xl; \
            { typedef float v2f_ __attribute__((ext_vector_type(2))); const v2u l8 = XLr[tt]; v4u lw_; \
              const v2f_ a0 = __builtin_amdgcn_cvt_pk_f32_fp8((int)l8.x, false), a1 = __builtin_amdgcn_cvt_pk_f32_fp8((int)l8.x, true), c0 = __builtin_amdgcn_cvt_pk_f32_fp8((int)l8.y, false), c1 = __builtin_amdgcn_cvt_pk_f32_fp8((int)l8.y, true); \
              lw_.x = pg8::cvt_pk_bf16(a0.x * (1.0f / 512.0f), a0.y * (1.0f / 512.0f)); lw_.y = pg8::cvt_pk_bf16(a1.x * (1.0f / 512.0f), a1.y * (1.0f / 512.0f)); \
              lw_.z = pg8::cvt_pk_bf16(c0.x * (1.0f / 512.0f), c0.y * (1.0f / 512.0f)); lw_.w = pg8::cvt_pk_bf16(c1.x * (1.0f / 512.0f), c1.y * (1.0f / 512.0f)); xl = __builtin_bit_cast(bf16x8, lw_); } \
            accs[tt] = __builtin_amdgcn_mfma_f32_16x16x32_bf16(xh, xh, accs[tt], 0, 0, 0); \
            _Pragma("unroll") for (int nt = 0; nt < 3; ++nt) { \
                acc[tt][nt] = __builtin_amdgcn_mfma_f32_16x16x32_bf16(WH[nt], xh, acc[tt][nt], 0, 0, 0); \
                acc[tt][nt] = __builtin_amdgcn_mfma_f32_16x16x32_bf16(WL[nt], xh, acc[tt][nt], 0, 0, 0); \
                acc[tt][nt] = __builtin_amdgcn_mfma_f32_16x16x32_bf16(WH[nt], xl, acc[tt][nt], 0, 0, 0); } } } while (0)
        P6_LOADWL(w80, 0); P6_LOADX(xh0, xl0, 0); P6_LOADWL(w81, 1); P6_LOADX(xh1, xl1, 1); P6_LOADWL(w82, 2); P6_LOADX(xh2, xl2, 2); P6_LOADWL(w83, 3); P6_LOADX(xh3, xl3, 3);
        P6_LOADWL(w84, 4); P6_LOADX(xh4, xl4, 4); P6_LOADWL(w85, 5); P6_LOADX(xh5, xl5, 5); P6_LOADWL(w86, 6); P6_LOADX(xh6, xl6, 6);
#define P6_SLOT(WHc, WHn, W8c, W8n, XHc, XLc, XHn, XLn, k) do { P6_LOADW(whA, k); if ((k) + 7 < 32) { P6_LOADWL(W8n, (k) + 7); P6_LOADX(XHn, XLn, (k) + 7); } P6_COMP(whA, W8c, XHc, XLc, k); } while (0)
#pragma unroll 1
        for (int kk = 0; kk < 32; kk += 8) {
            P6_SLOT(whA, whA, w80, w87, xh0, xl0, xh7, xl7, kk);     P6_SLOT(whA, whA, w81, w80, xh1, xl1, xh0, xl0, kk + 1);
            P6_SLOT(whA, whA, w82, w81, xh2, xl2, xh1, xl1, kk + 2); P6_SLOT(whA, whA, w83, w82, xh3, xl3, xh2, xl2, kk + 3);
            P6_SLOT(whA, whA, w84, w83, xh4, xl4, xh3, xl3, kk + 4); P6_SLOT(whA, whA, w85, w84, xh5, xl5, xh4, xl4, kk + 5);
            P6_SLOT(whA, whA, w86, w85, xh6, xl6, xh5, xl5, kk + 6); P6_SLOT(whA, whA, w87, w86, xh7, xl7, xh6, xl6, kk + 7);
        }
#undef P6_SLOT
#undef P6_LOADW
#undef P6_LOADWL
#undef P6_LOADX
#undef P6_COMP
        for (int tt = 0; tt < 2; ++tt) { const int r0 = rbase + tt * 16;
            const f32x4 dg = tt == 0 ? accs[0] : accs[1]; const int rsel = tk & 3;
            float sst = rsel == 0 ? dg[0] : rsel == 1 ? dg[1] : rsel == 2 ? dg[2] : dg[3]; sst = (kc == (tk >> 2)) ? sst : 0.f;
            sst += __shfl_xor(sst, 16); sst += __shfl_xor(sst, 32);
            const float rs = 1.0f / sqrtf(sst * (1.0f / DMODEL) + RMS_EPS);
#pragma unroll
            for (int nt = 0; nt < 3; ++nt)
#pragma unroll
                for (int k = 0; k < 4; ++k) lg[tk * 48 + nt * 16 + 4 * kc + k] = (tt == 0 ? acc[0][nt][k] : acc[1][nt][k]) * rs;
            LDS_WAIT(); asm volatile("" ::: "memory");
            if (lane < 16) { const int tokid = r0 + lane; rstd2[tokid] = rs; aR[wave * 32 + tt * 16 + lane] = rs;
                const LAS float* L = lg + lane * 48;
                float gl[4];
#pragma unroll
                for (int k = 0; k < 4; ++k) gl[k] = L[k] + F.b_group[k];
                int gs = 0; float gm = gl[0];
#pragma unroll
                for (int k = 1; k < 4; ++k) if (gl[k] > gm) { gm = gl[k]; gs = k; }
                float gz = 0.f;
#pragma unroll
                for (int k = 0; k < 4; ++k) gz += __expf(gl[k] - gm);
                const float gwt = 1.0f / gz;
                float el[8];
#pragma unroll
                for (int k = 0; k < 8; ++k) el[k] = L[4 + 8 * gs + k] + F.b_expert[8 * gs + k];
                int ia = 0; float ea = el[0];
#pragma unroll
                for (int k = 1; k < 8; ++k) if (el[k] > ea) { ea = el[k]; ia = k; }
                int ib = -1; float eb = -INFINITY;
#pragma unroll
                for (int k = 0; k < 8; ++k) if (k != ia && el[k] > eb) { eb = el[k]; ib = k; }
                const float pa = 1.0f, pb = __expf(eb - ea); const float inv = gwt / (pa + pb);
                const int e0 = 8 * gs + ia, e1 = 8 * gs + ib;
                const int l0 = __hip_atomic_fetch_add(hist + e0, 1, __ATOMIC_RELAXED, __HIP_MEMORY_SCOPE_WORKGROUP);
                const int l1 = __hip_atomic_fetch_add(hist + e1, 1, __ATOMIC_RELAXED, __HIP_MEMORY_SCOPE_WORKGROUP);
                const int ai = (wave * 32 + tt * 16 + lane) * 2;
                aE[ai] = e0; aP[ai] = l0; aG[ai] = pa * inv; aE[ai + 1] = e1; aP[ai + 1] = l1; aG[ai + 1] = pb * inv; }
            LDS_WAIT(); asm volatile("" ::: "memory");
        }
        __syncthreads();
        { int t32 = F.tid; asm volatile("" : "+v"(t32)); if (t32 < 32) base[t32] = (int)__hip_atomic_fetch_add(gcnt + t32, (unsigned)hist[t32], __ATOMIC_RELAXED, __HIP_MEMORY_SCOPE_AGENT); }
        __syncthreads();
        { int ai = F.tid; asm volatile("" : "+v"(ai));
          const int e = aE[ai]; const int pos = base[e] + aP[ai]; const int ts = (st * 256) * 2 + ai;
          tokl[(size_t)e * 65536 + pos] = ts; gate[ts] = aG[ai]; if (!dummy) { rsort[(size_t)e * 65536 + pos] = aR[ai >> 1]; gsort[(size_t)e * 65536 + pos] = aG[ai]; } }
        __syncthreads();
    }
}

__device__ __forceinline__ void p9_final(Frame& F, bool dummy) {
    const unsigned char* YS = (const unsigned char*)(F.ws + WS_YS); const int gw = F.vcu * NWAVES + F.wave, NGW = F.G * NWAVES, lane = F.lane;
    f32x4 gf[4];
#pragma unroll
    for (int j = 0; j < 4; ++j) gf[j] = *((const GAS f32x4*)F.g_final + lane + 64 * j);
    float* dst = dummy ? (float*)(F.ws + WS_XB) : F.out;
    for (int m = gw; m < T; m += NGW) { const GAS v2u* xr = (const GAS v2u*)(F.ws + WS_X1H + (size_t)m * DMODEL * 2) + lane; GAS f32x4* xw = (GAS f32x4*)(dst + (size_t)m * DMODEL) + lane;
        const GAS unsigned* y0 = (const GAS unsigned*)(YS + (size_t)(2 * m) * DMODEL) + lane; const GAS unsigned* y1 = (const GAS unsigned*)(YS + (size_t)(2 * m + 1) * DMODEL) + lane;
        f32x4 v[4]; float s = 0.f;
#pragma unroll
        for (int j = 0; j < 4; ++j) { const v2u hx = xr[64 * j]; v[j] = (f32x4){__uint_as_float(hx.x << 16), __uint_as_float(hx.x & 0xffff0000u), __uint_as_float(hx.y << 16), __uint_as_float(hx.y & 0xffff0000u)}; const unsigned a = y0[64 * j], c = y1[64 * j];
            typedef float v2f_ __attribute__((ext_vector_type(2)));
            const v2f_ a0 = __builtin_amdgcn_cvt_pk_f32_fp8((int)a, false), a1 = __builtin_amdgcn_cvt_pk_f32_fp8((int)a, true), c0 = __builtin_amdgcn_cvt_pk_f32_fp8((int)c, false), c1 = __builtin_amdgcn_cvt_pk_f32_fp8((int)c, true);
            v[j].x += (a0.x + c0.x) * (1.0f / 16.0f); v[j].y += (a0.y + c0.y) * (1.0f / 16.0f); v[j].z += (a1.x + c1.x) * (1.0f / 16.0f); v[j].w += (a1.y + c1.y) * (1.0f / 16.0f);
            s += (v[j].x * v[j].x + v[j].y * v[j].y) + (v[j].z * v[j].z + v[j].w * v[j].w); }
        s = wave_sum(s); const float rs = 1.0f / sqrtf(s * (1.0f / DMODEL) + RMS_EPS);
#pragma unroll
        for (int j = 0; j < 4; ++j) xw[64 * j] = v[j] * rs * gf[j]; }
}

template <class T_> struct KArgPtr { typedef T_ V; typedef const V __attribute__((address_space(4)))* type; };
struct Args { const float* in[15]; float* out; unsigned char* ws; int ph_lo, ph_hi; };
static_assert(sizeof(Args) == 144 && offsetof(Args, out) == 120 && offsetof(Args, ws) == 128 && offsetof(Args, ph_lo) == 136, "Args layout is read by offset (KARG)");
constexpr int N_PHASES = 10;

__global__ void __launch_bounds__(NWAVES * 64, 2) skel_fwd(Args args) {
    extern __shared__ __attribute__((aligned(16))) unsigned char lds[];
    Frame F;
    F.lds = (LAS unsigned char*)lds; F.ldsg = lds;
    F.wave = __builtin_amdgcn_readfirstlane(threadIdx.x >> 6); F.lane = lane_id_v(); F.tid = F.wave * 64 + F.lane;
    F.G = gridDim.x; { const int bx = blockIdx.x; F.vcu = (F.G % 8 == 0) ? (bx % 8) * (F.G / 8) + bx / 8 : bx; }
    typedef __attribute__((address_space(4))) const char* kptr_t;
    kptr_t ka = (kptr_t)__builtin_amdgcn_kernarg_segment_ptr();
#define KARG(T_, off) (*(KArgPtr<T_>::type)(ka + (off)))
#define LOADARGS() do { asm volatile("" : "+s"(ka)); \
    F.x = KARG(const float*, 0); F.g_mix = KARG(const float*, 8); F.w_in = KARG(const float*, 16); F.w_pa = KARG(const float*, 24); F.w_pb = KARG(const float*, 32); F.w_out = KARG(const float*, 40); \
    F.g_ffn = KARG(const float*, 48); F.w_group = KARG(const float*, 56); F.b_group = KARG(const float*, 64); F.w_expert = KARG(const float*, 72); F.b_expert = KARG(const float*, 80); \
    F.w1 = KARG(const float*, 88); F.w3 = KARG(const float*, 96); F.w2 = KARG(const float*, 104); F.g_final = KARG(const float*, 112); F.out = KARG(float*, 120); F.ws = KARG(unsigned char*, 128); ws = F.ws; \
    F.lane = lane_id_v(); F.tid = F.wave * 64 + F.lane; } while (0)
    unsigned char* ws;
    const int lo = KARG(int, 136), hi = KARG(int, 140);
    LOADARGS();
    for (int u = F.tid; u < (LDS_BYTES - MISC_OFF) / 4; u += NWAVES * 64) ((LAS unsigned*)(F.lds + MISC_OFF))[u] = 0u;
    __syncthreads();
    XcdBarrier bar = xcd_barrier_post((unsigned*)(ws + WS_CTL) + CW_BAR, (volatile LAS unsigned*)(F.lds + MISC_OFF + 1024), F.tid);
    cg::grid_group grid = cg::this_grid();
#define FRESH() LOADARGS()
#ifndef PHASE_MASK
#define PHASE_MASK 0x3ff
#endif
#define IN(k) (((PHASE_MASK >> (k)) & 1) && lo <= (k) && (k) < hi)
#ifndef DUP_PHASE
#define DUP_PHASE -1
#endif
#define REPS(k) for (int rep_ = 0, nrep_ = ((k) == DUP_PHASE ? 2 : 1); rep_ < nrep_; ++rep_, (rep_ < nrep_ ? (xcd_barrier(bar, F.tid, (unsigned)F.G), 0) : 0))
#define DUMMY() (rep_ + 1 < nrep_)
#define SEAM(k) do { if (IN(k) && IN((k) + 1)) { if ((k) == 0 && lo < 0) { grid.sync(); } xcd_barrier(bar, F.tid, (unsigned)F.G); } } while (0)

    if (IN(0)) REPS(0) { FRESH(); p0_prologue(F); }
    SEAM(0);
    if (IN(1)) REPS(1) {
        FRESH(); unsigned char* sga = (unsigned char*)F.out; unsigned char* sgb = sga + (size_t)T * DMODEL;
        { pg8::GmPlain g{(const char*)(ws + WS_XB), (const char*)(ws + WS_WIN), DMODEL};
          pg8::StaticOrder S; S.init(T, NINA, F.G, (int)blockIdx.x);
          pg8::EpiIn<0> E{
                     (bf16*)(ws + WS_QA), (bf16*)(ws + WS_KA), (bf16*)(ws + WS_VA), (bf16*)(ws + WS_QB), (bf16*)(ws + WS_KB), (bf16*)(ws + WS_VB), (bf16*)(ws + WS_QI), (bf16*)(ws + WS_KI),
                     (float*)(ws + WS_WI), sga, sgb};
          pg8::gemm_phase(F.lds, g, S, E, F.tid); }
        FRESH();
        { unsigned char* sga2 = (unsigned char*)F.out; unsigned char* sgb2 = sga2 + (size_t)T * DMODEL;
          pg8::GmPlainF8 g{(const char*)(ws + WS_X8), (const char*)(ws + WS_WIN8), DMODEL};
          pg8::StaticOrder S; S.init(T, NINB, F.G, (int)blockIdx.x);
          pg8::EpiIn<1> E{
                     (bf16*)(ws + WS_QA), (bf16*)(ws + WS_KA), (bf16*)(ws + WS_VA), (bf16*)(ws + WS_QB), (bf16*)(ws + WS_KB), (bf16*)(ws + WS_VB), (bf16*)(ws + WS_QI), (bf16*)(ws + WS_KI),
                     (float*)(ws + WS_WI), sga2, sgb2};
          pg8::gemm_phase(F.lds, g, S, E, F.tid); }
    }
    SEAM(1);
    if (IN(2)) REPS(2) { FRESH(); p2_kbsum(F); p2_select(F); }
    SEAM(2);
    if (IN(3)) REPS(3) {
        FRESH(); using namespace attn_body;
        const float* kbsum = (const float*)(ws + WS_KBSUM); const unsigned long long* maskw = (const unsigned long long*)(ws + WS_MASK);
        for (int bh = F.vcu; bh < NBATCH * NHEAD; bh += F.G) { const int b = bh >> 3, h = bh & 7;
            const attn_body::bf16* QAp = (const attn_body::bf16*)(ws + WS_QA); const attn_body::bf16* KAp = (const attn_body::bf16*)(ws + WS_KA);
            const attn_body::bf16* QBp = (const attn_body::bf16*)(ws + WS_QB); const attn_body::bf16* KBp = (const attn_body::bf16*)(ws + WS_KB);
            for (int i = 0; i < 8; ++i) { const int qb = (i & 1) ? (i >> 1) : 7 - (i >> 1); const int i1 = (i + 1) & 7; const int qbn = (i1 & 1) ? (i1 >> 1) : 7 - (i1 >> 1);
                attn_unit<0, 8>(b, h, qb, QAp, KAp, (const attn_body::bf16*)(ws + WS_VA), (unsigned char*)(ws + WS_OA), (char*)lds, kbsum, maskw, F.tid,
                                i > 0, true, i < 7 ? QAp : QBp, i < 7 ? KAp : KBp, qbn, i == 7 && qbn > 0); }
            for (int i = 0; i < 8; ++i) { const int qb = (i & 1) ? (i >> 1) : 7 - (i >> 1); const int i1 = (i + 1) & 7; const int qbn = (i1 & 1) ? (i1 >> 1) : 7 - (i1 >> 1);
                attn_unit<1, 8>(b, h, qb, QBp, KBp, (const attn_body::bf16*)(ws + WS_VB), (unsigned char*)(ws + WS_OB), (char*)lds, kbsum, maskw, F.tid,
                                true, i < 7, QBp, KBp, qbn, qbn > 0); } }
    }
    SEAM(3);
    if (IN(4)) REPS(4) {
        FRESH(); unsigned char* sga = (unsigned char*)F.out; unsigned char* sgb = sga + (size_t)T * DMODEL;
        { pg8::GmPlainF8 g{(const char*)(ws + WS_OA), (const char*)(ws + WS_WA), HW}; pg8::StaticOrder S; S.init(T, DMODEL, F.G, (int)blockIdx.x);
          pg8::EpiGate<true> E{sga, (unsigned char*)(ws + WS_MIX), (unsigned char*)(ws + WS_MIX8)}; pg8::gemm_phase(F.lds, g, S, E, F.tid); }
        { pg8::GmPlainF8 g{(const char*)(ws + WS_OB), (const char*)(ws + WS_WB), HW}; pg8::StaticOrder S; S.init(T, DMODEL, F.G, (int)blockIdx.x);
          pg8::EpiGate<false> E{sgb, (unsigned char*)(ws + WS_MIX), (unsigned char*)(ws + WS_MIX8)}; pg8::gemm_phase(F.lds, g, S, E, F.tid); }
    }
    SEAM(4);
    if (IN(5)) REPS(5) {
        FRESH();
        pg8::GmPlainF8 g{(const char*)(ws + WS_MIX8), (const char*)(ws + WS_WOUT), DMODEL}; pg8::StaticOrder S; S.init(T, DMODEL, F.G, (int)blockIdx.x);
        pg8::EpiRes E{(const bf16*)(ws + WS_XB), (const float*)(ws + WS_RSTD1), (bf16*)(ws + WS_X1H), (unsigned char*)(ws + WS_X1L), (unsigned char*)(ws + WS_X1B)}; pg8::gemm_phase(F.lds, g, S, E, F.tid);
    }
    SEAM(5);
    if (IN(6)) REPS(6) { FRESH(); p6_router(F, DUMMY()); }
    SEAM(6);
    LAS int* tstart = (LAS int*)(F.lds + MISC_OFF); LAS int* ecnt = tstart + 64;
    if (IN(7) || IN(8)) {
        FRESH();
        const unsigned* gcnt = (const unsigned*)(ws + WS_CTL) + CW_CNT;
        if (F.tid < 32) ecnt[F.tid] = (int)__hip_atomic_load(gcnt + F.tid, __ATOMIC_RELAXED, __HIP_MEMORY_SCOPE_AGENT);
        __syncthreads();
        if (F.tid == 0) { int s = 0; for (int e = 0; e < NEXP; ++e) { tstart[e] = s; s += (ecnt[e] + 255) >> 8; } tstart[NEXP] = s; }
        __syncthreads();
    }
    if (IN(7)) REPS(7) {
        FRESH();
        pg8::GmMoe1F8 g{(const char*)(ws + WS_X1B), (const char*)(ws + WS_W13), (const int*)(ws + WS_TOK), DMODEL};
        pg8::MoeOrder S{tstart, ecnt, 4, F.G, (int)blockIdx.x};
        pg8::EpiSwiGlu E{(const float*)(ws + WS_RSORT), (unsigned char*)(ws + WS_HID)};
        pg8::gemm_phase(F.lds, g, S, E, F.tid);
    }
    SEAM(7);
    if (IN(8)) REPS(8) {
        FRESH();
        pg8::GmMoe2F8 g{(const char*)(ws + WS_HID), (const char*)(ws + WS_W2), EFF};
        pg8::MoeOrder S{tstart, ecnt, 4, F.G, (int)blockIdx.x};
        pg8::EpiDown E{(const int*)(ws + WS_TOK), (const float*)(ws + WS_GSORT), (unsigned char*)(ws + WS_YS)};
        pg8::gemm_phase(F.lds, g, S, E, F.tid);
    }
    SEAM(8);
    if (IN(9)) REPS(9) { FRESH(); p9_final(F, DUMMY()); }
#undef IN
#undef SEAM
}

extern "C" void kernel_launch(void* const* d_in, const int* in_sizes, int n_in, void* d_out, int out_size, void* d_ws, size_t ws_size, hipStream_t stream) {
    static int grid = 0;
    if (grid == 0) {
        if (n_in != 15 || in_sizes[0] != T * DMODEL || out_size != T * DMODEL || ws_size < WS_END) {
            fprintf(stderr, "kernel_launch: unexpected shapes: n_in %d in0 %d out %d ws %zu (need >= %zu)\n", n_in, n_in > 0 ? in_sizes[0] : -1, out_size, ws_size, (size_t)WS_END); grid = -1; return; }
        int dev = 0, cus = 0, per_cu = 0;
        if (hipGetDevice(&dev) != hipSuccess || hipDeviceGetAttribute(&cus, hipDeviceAttributeMultiprocessorCount, dev) != hipSuccess) { grid = -1; return; }
        if (hipFuncSetAttribute((const void*)skel_fwd, hipFuncAttributeMaxDynamicSharedMemorySize, LDS_BYTES) != hipSuccess) { fprintf(stderr, "kernel_launch: hipFuncSetAttribute failed\n"); grid = -1; return; }
        if (hipOccupancyMaxActiveBlocksPerMultiprocessor(&per_cu, (const void*)skel_fwd, NWAVES * 64, LDS_BYTES) != hipSuccess || per_cu < 1) { fprintf(stderr, "kernel_launch: occupancy query says %d blocks per CU\n", per_cu); grid = -1; (void)hipGetLastError(); return; }
        grid = cus;
    }
    if (grid < 0) return;
    (void)hipMemsetAsync((char*)d_ws + WS_CTL, 0, CTL_ZERO_BYTES, stream);
    Args a{};
    for (int i = 0; i < 15; ++i) a.in[i] = (const float*)d_in[i];
    a.out = (float*)d_out; a.ws = (unsigned char*)d_ws;
#if MK_N_LAUNCHES == 1
    a.ph_lo = 0; a.ph_hi = N_PHASES;
    { void* kargs[] = {&a}; hipError_t e = hipLaunchCooperativeKernel((const void*)skel_fwd, dim3(grid), dim3(NWAVES * 64), kargs, LDS_BYTES, stream);
      if (e != hipSuccess) fprintf(stderr, "kernel_launch: cooperative launch failed: %s (grid %d)\n", hipGetErrorString(e), grid); }
#else
    for (int p = 0; p < N_PHASES; ++p) { a.ph_lo = p; a.ph_hi = p + 1; hipLaunchKernelGGL(skel_fwd, dim3(grid), dim3(NWAVES * 64), LDS_BYTES, stream, a); }
#endif
}
```

```cpp
#include <hip/hip_runtime.h>
#include <hip/hip_cooperative_groups.h>
#include <hip/hip_bf16.h>
#include <cstdio>
#include <cstdint>
#include <cstddef>
#include <cmath>
namespace cg = cooperative_groups;

#ifndef MK_N_LAUNCHES
#define MK_N_LAUNCHES 1
#endif

constexpr int NBATCH = 32, SEQ = 2048, DMODEL = 1024, T = NBATCH * SEQ;
constexpr int NHEAD = 8, HD = 64, HW = NHEAD * HD;
constexpr int IN_COLS = 5704, NINA = 768, NINB = 5120;
constexpr int NEXP = 32, EFF = 512;
constexpr float RMS_EPS = 1e-6f;
constexpr float IDX_SCALE = 0.044194173824159216f;
constexpr float C2 = 0.125f * 1.4426950408889634f;
constexpr int HID_ROWS = 131072 + 8192;

namespace pg8 {
#define PG8_LAS __attribute__((address_space(3)))
typedef unsigned short bf16_t;
typedef short bf16x8 __attribute__((ext_vector_type(8)));
typedef float f32x4 __attribute__((ext_vector_type(4)));
typedef unsigned u32x4 __attribute__((ext_vector_type(4)));
typedef unsigned u32x2 __attribute__((ext_vector_type(2)));
constexpr int BM = 256, BK = 64, HALF = 128, HTB = HALF * BK * 2, STAGE_BYTES = 8 * HTB, NXCD = 8, WGM = 8;

__host__ __device__ __forceinline__ int lds_byte(int r, int c) { const int st = (r >> 4) * 2 + (c >> 5), rr = r & 15, cc = c & 31, ob = rr * 64 + cc * 2; return st * 1024 + (ob ^ (((ob >> 9) & 1) << 5)); }
__host__ __device__ __forceinline__ void stage_rc(int b, int& R, int& C) { const int st = b / 1024, sb = b % 1024, swz = sb ^ (((sb >> 9) & 1) << 5); R = (st >> 1) * 16 + swz / 64; C = (st & 1) * 32 + (swz % 64) / 2; }
__host__ __device__ __forceinline__ int perm32(int rho) { const int n = rho >> 4, i = rho & 15; return 8 * (i >> 2) + 4 * n + (i & 3); }

typedef int v8i __attribute__((ext_vector_type(8)));
__host__ __device__ __forceinline__ int swz8(int r) { return (((r >> 1) & 3) << 5) ^ (((r >> 3) & 1) << 4); }
__host__ __device__ __forceinline__ int lds_byte8(int r, int cb) { return r * 128 + (cb ^ swz8(r)); }
__host__ __device__ __forceinline__ void stage_rc8(int b, int& R, int& Cb) { R = b >> 7; Cb = (b & 127) ^ swz8(R); }
constexpr int F8_SCALE1 = 0x7f7f7f7f;
__host__ __device__ __forceinline__ int perm16(int s) { return 64 * ((s >> 5) & 3) + 16 * ((s >> 2) & 3) + 8 * (s >> 7) + 4 * ((s >> 4) & 1) + (s & 3); }
struct Unit { int pm, pn, e, lt, cnt; };

template <int M_, int N_> struct StaticOrder {
    static constexpr int nM = M_ / BM, nN = N_ / BM, nwg = nM * nN;
    int G, c;
    __device__ void init(int, int, int G_, int c_) { G = G_; c = c_; }
    __device__ bool next(int i, Unit& u) const {
        const long L = (long)i * G + c; if (L >= nwg) return false;
        int wgid = (int)L; { constexpr int q = nwg / NXCD, r = nwg % NXCD; const int xcd = wgid % NXCD, off = wgid / NXCD; wgid = (xcd < r ? xcd * (q + 1) : r * (q + 1) + (xcd - r) * q) + off; }
        constexpr int nig = WGM * nN; static_assert(nM % WGM == 0, "group size is WGM everywhere");
        const int gid = wgid / nig, fm = gid * WGM;
        u.pm = fm + ((wgid % nig) % WGM); u.pn = (wgid % nig) / WGM; u.e = 0; u.lt = 0; u.cnt = 0; return true;
    }
};
struct MoeOrder {
    const PG8_LAS int* tstart; const PG8_LAS int* cnt; int nN, G, c;
    __device__ bool next(int i, Unit& u) const {
        const long L = (long)i * G + c; const int ntiles = tstart[NEXP];
        if (L >= (long)ntiles * nN) return false;
        const int pm = (int)(L >> 2); u.pm = pm; u.pn = (int)(L & 3);
        int lane_; asm volatile("v_mbcnt_lo_u32_b32 %0, -1, 0\n\tv_mbcnt_hi_u32_b32 %0, -1, %0" : "=v"(lane_));
        const int ts_ = tstart[lane_ & 31];
        const int e = __builtin_popcountll(__ballot((lane_ < NEXP) && (ts_ <= pm))) - 1;
        u.e = e; u.lt = pm - tstart[e]; u.cnt = cnt[e]; return true;
    }
};

__device__ __forceinline__ unsigned cvt_pk_bf16(float lo, float hi) { typedef float f2 __attribute__((ext_vector_type(2))); typedef __bf16 b2 __attribute__((ext_vector_type(2))); f2 v = {lo, hi}; b2 b = __builtin_convertvector(v, b2); return __builtin_bit_cast(unsigned, b); }
__device__ __forceinline__ float bf2f(unsigned short s) { return __uint_as_float((unsigned)s << 16); }

struct GmPlain {
    static constexpr bool FP8 = false;
    const char* A; const char* Bt; int K;
    __device__ __forceinline__ const char* abase() const { return A; }
    __device__ __forceinline__ void offs(const Unit& u, const int (&R)[2], const int (&C)[2], unsigned (&o)[2][2]) const {
#pragma unroll
        for (int h = 0; h < 2; ++h)
#pragma unroll
            for (int i = 0; i < 2; ++i) o[h][i] = (unsigned)(((u.pm * 256 + h * 128 + R[i]) * K + C[i]) * 2);
    }
    __device__ __forceinline__ const char* bptr(const Unit& u) const { return Bt + (size_t)u.pn * 256 * K * 2; }
};
struct GmMoe1 {
    static constexpr bool FP8 = false;
    const char* A; const char* Bt; const int* tok; int K;
    __device__ __forceinline__ const char* abase() const { return A; }
    __device__ __forceinline__ void offs(const Unit& u, const int (&R)[2], const int (&C)[2], unsigned (&o)[2][2]) const {
#pragma unroll
        for (int h = 0; h < 2; ++h)
#pragma unroll
            for (int i = 0; i < 2; ++i) { int r = u.lt * 256 + h * 128 + R[i]; r = r < u.cnt ? r : u.cnt - 1; const int ts = tok[(size_t)u.e * 65536 + r]; o[h][i] = (unsigned)((((ts >> 1)) * K + C[i]) * 2); }
    }
    __device__ __forceinline__ const char* bptr(const Unit& u) const { return Bt + ((size_t)u.e * 1024 + (size_t)u.pn * 256) * K * 2; }
};
struct GmMoe2 {
    static constexpr bool FP8 = false;
    const char* A; const char* Bt; int K;
    __device__ __forceinline__ const char* abase() const { return A; }
    __device__ __forceinline__ void offs(const Unit& u, const int (&R)[2], const int (&C)[2], unsigned (&o)[2][2]) const {
#pragma unroll
        for (int h = 0; h < 2; ++h)
#pragma unroll
            for (int i = 0; i < 2; ++i) o[h][i] = (unsigned)(((u.pm * 256 + h * 128 + R[i]) * K + C[i]) * 2);
    }
    __device__ __forceinline__ const char* bptr(const Unit& u) const { return Bt + ((size_t)u.e * 1024 + (size_t)u.pn * 256) * K * 2; }
};

struct GmMoe1F8 {
    static constexpr bool FP8 = true;
    const char* A; const char* Bt; const int* tok; int K;
    __device__ __forceinline__ const char* abase() const { return A; }
    __device__ __forceinline__ void offs(const Unit& u, const int (&R)[2], const int (&C)[2], unsigned (&o)[2][2]) const {
#pragma unroll
        for (int h = 0; h < 2; ++h)
#pragma unroll
            for (int i = 0; i < 2; ++i) { int r = u.lt * 256 + h * 128 + R[i]; r = r < u.cnt ? r : u.cnt - 1; const int ts = tok[(size_t)u.e * 65536 + r]; o[h][i] = (unsigned)((ts >> 1) * K + C[i]); }
    }
    __device__ __forceinline__ const char* bptr(const Unit& u) const { return Bt + ((size_t)u.e * 1024 + (size_t)u.pn * 256) * K; }
};
struct GmPlainF8 {
    static constexpr bool FP8 = true;
    const char* A; const char* Bt; int K;
    __device__ __forceinline__ const char* abase() const { return A; }
    __device__ __forceinline__ void offs(const Unit& u, const int (&R)[2], const int (&C)[2], unsigned (&o)[2][2]) const {
#pragma unroll
        for (int h = 0; h < 2; ++h)
#pragma unroll
            for (int i = 0; i < 2; ++i) o[h][i] = (unsigned)((u.pm * 256 + h * 128 + R[i]) * K + C[i]);
    }
    __device__ __forceinline__ const char* bptr(const Unit& u) const { return Bt + (size_t)u.pn * 256 * K; }
};
struct GmMoe2F8 {
    static constexpr bool FP8 = true;
    const char* A; const char* Bt; int K;
    __device__ __forceinline__ const char* abase() const { return A; }
    __device__ __forceinline__ void offs(const Unit& u, const int (&R)[2], const int (&C)[2], unsigned (&o)[2][2]) const {
#pragma unroll
        for (int h = 0; h < 2; ++h)
#pragma unroll
            for (int i = 0; i < 2; ++i) o[h][i] = (unsigned)((u.pm * 256 + h * 128 + R[i]) * K + C[i]);
    }
    __device__ __forceinline__ const char* bptr(const Unit& u) const { return Bt + ((size_t)u.e * 1024 + (size_t)u.pn * 256) * K; }
};
__device__ __forceinline__ unsigned cvt4_fp8(float a, float b, float c, float d) { int w = 0; w = __builtin_amdgcn_cvt_pk_fp8_f32(a, b, w, false); w = __builtin_amdgcn_cvt_pk_fp8_f32(c, d, w, true); return (unsigned)w; }


__host__ __device__ __forceinline__ int in_tile_of(int part, int p) { return part == 0 ? (p < 2 ? 12 + p : 14) : (p < 12 ? p : p + 3); }
__device__ __forceinline__ size_t pairaddr(int row, int col) { return ((size_t)(row >> 1) << 11) + (size_t)(((col >> 6) << 7) + ((row & 1) << 6) + (col & 63)); }
template <int PART> struct EpiIn {
    struct Pre {}; __device__ __forceinline__ void prefetch(const Unit&, int, int, Pre&) const {}
    bf16_t *qa, *ka, *va, *qb, *kb, *vb, *qi, *ki; float* wi; unsigned char *sga, *sgb;
    static constexpr float ASCALE = PART == 0 ? 1.0f : (1.0f / 32.0f);
    __device__ __forceinline__ void rope_rows(const f32x4 (&acc)[2][2][4][2], bf16_t* dst, int pitch, int rowb, int fq, float sc) const {
        constexpr float C16[4][8] = {{-9.576594803e-01f, 8.429445198e-01f, -9.100810415e-01f, 8.942880023e-01f, 3.403182001e-01f, -7.945044213e-01f, -9.564100574e-01f, -5.335885357e-01f}, {-2.919952230e-02f, 3.625155109e-01f, 6.218088190e-01f, 7.808853865e-01f, 8.747074712e-01f, 9.288796899e-01f, 9.597951768e-01f, 9.773242439e-01f}, {9.872272834e-01f, 9.928106620e-01f, 9.959550145e-01f, 9.977246657e-01f, 9.987202730e-01f, 9.992802895e-01f, 9.995952558e-01f, 9.997723889e-01f}, {9.998720027e-01f, 9.999280212e-01f, 9.999595231e-01f, 9.999772381e-01f, 9.999872000e-01f, 9.999928020e-01f, 9.999959523e-01f, 9.999977238e-01f}};
        constexpr float S16[4][8] = {{-2.879033167e-01f, -5.380004986e-01f, 4.144303293e-01f, 4.474918647e-01f, -9.403103332e-01f, -6.072583671e-01f, 2.920270571e-01f, 8.457442135e-01f}, {9.995736030e-01f, 9.319777381e-01f, 7.831690702e-01f, 6.246743256e-01f, 4.846512559e-01f, 3.703815892e-01f, 2.807012978e-01f, 2.117482522e-01f}, {1.593182066e-01f, 1.196954025e-01f, 8.985326395e-02f, 6.742025942e-02f, 5.057485751e-02f, 3.793287644e-02f, 2.844863180e-02f, 2.133472409e-02f}, {1.599931734e-02f, 1.199801947e-02f, 8.997339806e-03f, 6.747092862e-03f, 5.059622668e-03f, 3.794188826e-03f, 2.845243217e-03f, 2.133632673e-03f}};
        constexpr float B8[8] = {0.15915494309189535f, 0.11934937021124886f, 0.08949940160889101f, 0.06711508300522726f, 0.050329212104487035f, 0.03774158471741977f, 0.0283021958306234f, 0.02122365276477766f};
        const float dec = fq == 0 ? 1.0f : fq == 1 ? 0.1f : fq == 2 ? 0.01f : 0.001f; const int j0 = 8 * fq;
        f32x4 c4[2][2], s4[2][2], cr[2], sr[2];
        const float p0 = (float)(rowb & (SEQ - 1)), p1 = (float)((rowb + HALF) & (SEQ - 1));
#pragma unroll
        for (int n = 0; n < 2; ++n)
#pragma unroll
            for (int k = 0; k < 4; ++k) { const float w = dec * B8[4 * n + k];
                cr[n][k] = fq == 0 ? C16[0][4 * n + k] : fq == 1 ? C16[1][4 * n + k] : fq == 2 ? C16[2][4 * n + k] : C16[3][4 * n + k];
                sr[n][k] = fq == 0 ? S16[0][4 * n + k] : fq == 1 ? S16[1][4 * n + k] : fq == 2 ? S16[2][4 * n + k] : S16[3][4 * n + k];
                const float ra = __builtin_amdgcn_fractf(p0 * w); c4[0][n][k] = __builtin_amdgcn_cosf(ra); s4[0][n][k] = __builtin_amdgcn_sinf(ra);
                const float rb = __builtin_amdgcn_fractf(p1 * w); c4[1][n][k] = __builtin_amdgcn_cosf(rb); s4[1][n][k] = __builtin_amdgcn_sinf(rb); }
#pragma unroll
        for (int ai = 0; ai < 2; ++ai) {
#pragma unroll
            for (int m = 0; m < 4; ++m) { const int row = rowb + ai * HALF + m * 16;
                u32x4 a, b;
#pragma unroll
                for (int n = 0; n < 2; ++n) { const f32x4 c = c4[ai][n], sn = s4[ai][n];
                    const f32x4 x1 = acc[ai][0][m][n] * sc, x2 = acc[ai][1][m][n] * sc; const f32x4 o1 = x1 * c - x2 * sn, o2 = x1 * sn + x2 * c;
                    a[2 * n] = cvt_pk_bf16(o1[0], o1[1]); a[2 * n + 1] = cvt_pk_bf16(o1[2], o1[3]); b[2 * n] = cvt_pk_bf16(o2[0], o2[1]); b[2 * n + 1] = cvt_pk_bf16(o2[2], o2[3]);
                    c4[ai][n] = c * cr[n] - sn * sr[n]; s4[ai][n] = sn * cr[n] + c * sr[n]; }
                bf16_t* p = dst + (size_t)row * pitch + j0; *(u32x4*)p = a; *(u32x4*)(p + 32) = b; } }
    }
    __device__ __forceinline__ void operator()(const f32x4 (&acc)[2][2][4][2], const Unit& u, int wr, int wc, int fr, int fq, const Pre& pre) const {
        const int pn = in_tile_of(PART, u.pn); const int rowb = u.pm * BM + wr * 64 + fr;
        if (pn < 14) {
            const int seg = pn >> 1;
            if (seg == 2 || seg == 5) {
                bf16_t* dst = (seg == 2) ? va : vb; const int colb = (pn & 1) * 256 + wc * 64 + 16 * fq;
#pragma unroll
                for (int ai = 0; ai < 2; ++ai) {
#pragma unroll
                    for (int m = 0; m < 4; ++m) { const int row = rowb + ai * HALF + m * 16; const float r = ASCALE;
#pragma unroll
                        for (int bj = 0; bj < 2; ++bj) { const f32x4 v0 = acc[ai][bj][m][0] * r, v1 = acc[ai][bj][m][1] * r; u32x4 w;
                            w.x = cvt_pk_bf16(v0[0], v0[1]); w.y = cvt_pk_bf16(v0[2], v0[3]); w.z = cvt_pk_bf16(v1[0], v1[1]); w.w = cvt_pk_bf16(v1[2], v1[3]);
                            *(u32x4*)(dst + (size_t)row * HW + colb + bj * 8) = w; } } }
            } else {
                bf16_t* dst = (seg == 0) ? qa : (seg == 1) ? ka : (seg == 3) ? qb : (seg == 4) ? kb : qi;
                const float sc = ((seg == 0 || seg == 3) ? C2 : 1.0f) * ASCALE; const int head = 4 * (pn & 1) + wc;
                rope_rows(acc, dst + head * 64, HW, rowb, fq, sc);
            }
        } else if (pn == 14) {
            if (wc == 0) rope_rows(acc, ki, 64, rowb, fq, 1.0f);
            else if (wc == 1 && fq < 2) {
#pragma unroll
                for (int ai = 0; ai < 2; ++ai)
#pragma unroll
                    for (int m = 0; m < 4; ++m) { const int row = rowb + ai * HALF + m * 16; const float r = IDX_SCALE;
                        *(f32x4*)(wi + (size_t)row * 8 + 4 * fq) = acc[ai][0][m][0] * r; }
            }
        } else {
            const int gi = pn - 15; unsigned char* dst = (gi < 4) ? sga : sgb; const int colb = (gi & 3) * 256 + wc * 64 + 16 * fq;
#pragma unroll
            for (int ai = 0; ai < 2; ++ai) {
#pragma unroll
                for (int m = 0; m < 4; ++m) { const int row = rowb + ai * HALF + m * 16; const float r = -1.4426950408889634f * ASCALE; u32x4 w;
#pragma unroll
                    for (int bj = 0; bj < 2; ++bj)
#pragma unroll
                        for (int n = 0; n < 2; ++n) { f32x4 v = acc[ai][bj][m][n] * r;
#pragma unroll
                            for (int k = 0; k < 4; ++k) v[k] = __builtin_amdgcn_rcpf(__builtin_fmaf(__builtin_amdgcn_exp2f(v[k]), 1.0f / 256.0f, 1.0f / 256.0f));
                            w[2 * bj + n] = cvt4_fp8(v[0], v[1], v[2], v[3]); }
                    *(u32x4*)(dst + pairaddr(row, colb)) = w; } }
        }
    }
};
template <bool FIRST> struct EpiGate {
    struct Pre {}; __device__ __forceinline__ void prefetch(const Unit&, int, int, Pre&) const {}
    const unsigned char* sg; unsigned char* tmp; unsigned char* out8;
    __device__ __forceinline__ void operator()(const f32x4 (&acc)[2][2][4][2], const Unit& u, int wr, int wc, int fr, int fq, const Pre& pre) const {
        typedef float v2f_ __attribute__((ext_vector_type(2)));
        const int rowb = u.pm * BM + wr * 64 + fr, colb = u.pn * BM + wc * 64 + 16 * fq;
#pragma unroll
        for (int ai = 0; ai < 2; ++ai) { u32x4 g[4], pv[4];
#pragma unroll
            for (int m = 0; m < 4; ++m) { const size_t off = pairaddr(rowb + ai * HALF + m * 16, colb);
                g[m] = *(const u32x4*)(sg + off); if (!FIRST) pv[m] = *(const u32x4*)(tmp + off); else pv[m] = (u32x4){0u, 0u, 0u, 0u}; }
#pragma unroll
            for (int m = 0; m < 4; ++m) { const int row = rowb + ai * HALF + m * 16; const size_t off = FIRST ? pairaddr(row, colb) : (size_t)row * DMODEL + colb; u32x4 w;
#pragma unroll
                for (int bj = 0; bj < 2; ++bj)
#pragma unroll
                    for (int n = 0; n < 2; ++n) { const f32x4 a = acc[ai][bj][m][n] * (32.0f / 65536.0f); const int q = 2 * bj + n;
                        const v2f_ g0 = __builtin_amdgcn_cvt_pk_f32_fp8((int)g[m][q], false), g1 = __builtin_amdgcn_cvt_pk_f32_fp8((int)g[m][q], true);
                        const v2f_ p0 = __builtin_amdgcn_cvt_pk_f32_fp8((int)pv[m][q], false), p1 = __builtin_amdgcn_cvt_pk_f32_fp8((int)pv[m][q], true);
                        w[q] = cvt4_fp8(a[0] * g0.x + p0.x, a[1] * g0.y + p0.y, a[2] * g1.x + p1.x, a[3] * g1.y + p1.y); }
                *(u32x4*)((FIRST ? tmp : out8) + off) = w; } }
    }
};
struct EpiRes {
    struct Pre {}; __device__ __forceinline__ void prefetch(const Unit&, int, int, Pre&) const {}
    const bf16_t* xb; const float* irstd; bf16_t* xh; unsigned char* xl; unsigned char* xq;
    __device__ __forceinline__ void operator()(const f32x4 (&acc)[2][2][4][2], const Unit& u, int wr, int wc, int fr, int fq, const Pre& pre) const {
        const int rowb = u.pm * BM + wr * 64 + fr, colb = u.pn * BM + wc * 64 + 16 * fq;
#pragma unroll
        for (int ai = 0; ai < 2; ++ai) { u32x4 bs[4][2]; float ir[4];
#pragma unroll
            for (int m = 0; m < 4; ++m) { const int row = rowb + ai * HALF + m * 16; const size_t off = (size_t)row * DMODEL + colb; ir[m] = irstd[row];
#pragma unroll
                for (int bj = 0; bj < 2; ++bj) bs[m][bj] = *(const u32x4*)(xb + off + bj * 8); }
#pragma unroll
            for (int m = 0; m < 4; ++m) { const size_t off = (size_t)(rowb + ai * HALF + m * 16) * DMODEL + colb; u32x4 hw[2], lw, qw;
#pragma unroll
                for (int bj = 0; bj < 2; ++bj)
#pragma unroll
                    for (int n = 0; n < 2; ++n) { float qv[4], lo[4];
#pragma unroll
                        for (int q = 0; q < 2; ++q) { const unsigned xw = bs[m][bj][2 * n + q];
                            const float v0 = __uint_as_float(xw << 16) * ir[m] + acc[ai][bj][m][n][2 * q] * (1.0f / 1024.0f), v1 = __uint_as_float(xw & 0xffff0000u) * ir[m] + acc[ai][bj][m][n][2 * q + 1] * (1.0f / 1024.0f);
                            const unsigned h = cvt_pk_bf16(v0, v1); qv[2 * q] = v0; qv[2 * q + 1] = v1; hw[bj][2 * n + q] = h;
                            lo[2 * q] = (v0 - __uint_as_float(h << 16)) * 512.0f; lo[2 * q + 1] = (v1 - __uint_as_float(h & 0xffff0000u)) * 512.0f; }
                        qw[2 * bj + n] = cvt4_fp8(qv[0], qv[1], qv[2], qv[3]); lw[2 * bj + n] = cvt4_fp8(lo[0], lo[1], lo[2], lo[3]); }
                *(u32x4*)(xh + off) = hw[0]; *(u32x4*)(xh + off + 8) = hw[1]; *(u32x4*)(xl + off) = lw; *(u32x4*)(xq + off) = qw; } }
    }
};
__device__ __forceinline__ unsigned ld_untracked(const void* p) { unsigned v; asm volatile("global_load_dword %0, %1, off" : "=v"(v) : "v"(p) : "memory"); return v; }
struct EpiSwiGlu {
    const float* rsort; unsigned char* hid;
    struct Pre { unsigned rr[2][4]; };
    __device__ __forceinline__ void prefetch(const Unit& u, int wr, int fr, Pre& p) const {
#pragma unroll
        for (int ai = 0; ai < 2; ++ai)
#pragma unroll
            for (int m = 0; m < 4; ++m) { int er = u.lt * 256 + ai * HALF + wr * 64 + m * 16 + fr; er = er < u.cnt ? er : u.cnt - 1; p.rr[ai][m] = ld_untracked(rsort + (size_t)u.e * 65536 + er); } }
    __device__ __forceinline__ void operator()(const f32x4 (&acc)[2][2][4][2], const Unit& u, int wr, int wc, int fr, int fq, const Pre& pre) const {
#pragma unroll
        for (int ai = 0; ai < 2; ++ai)
#pragma unroll
            for (int m = 0; m < 4; ++m) { const int lr = ai * HALF + wr * 64 + m * 16 + fr; const int er = u.lt * 256 + lr;
                if (er < u.cnt) { const float r = __uint_as_float(pre.rr[ai][m]) * (1.0f / 32.0f); float o[8];
#pragma unroll
                    for (int n = 0; n < 2; ++n) { const f32x4 a = acc[ai][0][m][n] * r, b = acc[ai][1][m][n] * r;
#pragma unroll
                        for (int k = 0; k < 4; ++k) { const float sg2 = __builtin_amdgcn_rcpf(__builtin_fmaf(__builtin_amdgcn_exp2f(a[k] * (-1.4426950408889634f)), 0.5f, 0.5f)); o[4 * n + k] = a[k] * sg2 * b[k]; } }
                    u32x2 w; w.x = cvt4_fp8(o[0], o[1], o[2], o[3]); w.y = cvt4_fp8(o[4], o[5], o[6], o[7]);
                    *(u32x2*)(hid + (size_t)(u.pm * 256 + lr) * EFF + 128 * u.pn + 32 * wc + 8 * fq) = w; } }
    }
};
struct EpiDown {
    const int* tok; const float* gsort; unsigned char* ys;
    struct Pre { unsigned ts[2][4], gg[2][4]; };
    __device__ __forceinline__ void prefetch(const Unit& u, int wr, int fr, Pre& p) const {
#pragma unroll
        for (int ai = 0; ai < 2; ++ai)
#pragma unroll
            for (int m = 0; m < 4; ++m) { int er = u.lt * 256 + ai * HALF + wr * 64 + m * 16 + fr; er = er < u.cnt ? er : u.cnt - 1; p.ts[ai][m] = ld_untracked(tok + (size_t)u.e * 65536 + er); p.gg[ai][m] = ld_untracked(gsort + (size_t)u.e * 65536 + er); } }
    __device__ __forceinline__ void operator()(const f32x4 (&acc)[2][2][4][2], const Unit& u, int wr, int wc, int fr, int fq, const Pre& pre) const {
        const int colb = u.pn * BM + wc * 64 + 16 * fq;
#pragma unroll
        for (int ai = 0; ai < 2; ++ai)
#pragma unroll
            for (int m = 0; m < 4; ++m) { const int er = u.lt * 256 + ai * HALF + wr * 64 + m * 16 + fr;
                if (er < u.cnt) { const float g = __uint_as_float(pre.gg[ai][m]) * (16.0f / 32.0f); const int t_ = (int)pre.ts[ai][m]; u32x4 w;
#pragma unroll
                    for (int bj = 0; bj < 2; ++bj)
#pragma unroll
                        for (int n = 0; n < 2; ++n) { const f32x4 v = acc[ai][bj][m][n] * g; w[2 * bj + n] = cvt4_fp8(v[0], v[1], v[2], v[3]); }
                    *(u32x4*)(ys + (size_t)t_ * DMODEL + colb) = w; } }
    }
};

template <class GM, class Epi, class Sched>
__device__ __forceinline__ void gemm_phase(PG8_LAS unsigned char* lds, const GM g, const Sched& S, const Epi& E, const int tid) {
    const int wid = __builtin_amdgcn_readfirstlane(tid >> 6), lane = tid & 63, wr = wid >> 2, wc = wid & 3, fr = lane & 15, fq = lane >> 4;
    constexpr bool FP8 = GM::FP8;
    const int K = g.K, nt = FP8 ? K / 128 : K / BK;
    int sR[2], sC[2]; unsigned voffB[2];
#pragma unroll
    for (int i = 0; i < 2; ++i) { int R, C; if constexpr (FP8) { stage_rc8(tid * 16 + i * 8192, R, C); voffB[i] = (unsigned)(R * K + C); } else { stage_rc(tid * 16 + i * 8192, R, C); voffB[i] = (unsigned)(R * K + C) * 2u; }
        sR[i] = R; sC[i] = C; }
    const size_t kstep = (size_t)(BK * 2);
    const size_t hstep = FP8 ? (size_t)HALF * K : (size_t)HALF * K * 2;
    const unsigned ldsw = (unsigned)wid * 1024u;
    const int aoff = FP8 ? lds_byte8(wr * 64 + fr, fq * 32) : lds_byte(wr * 64 + fr, fq * 8), boff = FP8 ? lds_byte8(wc * 32 + fr, fq * 32) : lds_byte(wc * 32 + fr, fq * 8);
    const int aoff1 = aoff ^ 16, boff1 = boff ^ 16;
    const char* const abase = g.abase();
#define PG8_SA(b, h) (((b) * 2 + (h)) * HTB)
#define PG8_SB(b, h) ((4 + (b) * 2 + (h)) * HTB)
#define PG8_STAGE(bufoff, gbase, voff) do { _Pragma("unroll") for (int _i = 0; _i < 2; ++_i) \
        __builtin_amdgcn_global_load_lds((const unsigned*)((const char*)(gbase) + (voff)[_i]), (PG8_LAS unsigned*)(lds + (bufoff) + ldsw + _i * 8192), 16, 0, 0); } while (0)
#define PG8_STAGEA(bufoff, OFF, h, kb) do { const char* ub_ = abase + (kb);   _Pragma("unroll") for (int _i = 0; _i < 2; ++_i) \
        __builtin_amdgcn_global_load_lds((const unsigned*)(ub_ + (OFF)[h][_i]), (PG8_LAS unsigned*)(lds + (bufoff) + ldsw + _i * 8192), 16, 0, 0); } while (0)
#define PG8_LD8(off0_, off1_, cst_) ({ typedef int v4i_ __attribute__((ext_vector_type(4))); const v4i_ lo_ = *(const PG8_LAS v4i_*)(lds + (cst_) + (off0_)); const v4i_ hi_ = *(const PG8_LAS v4i_*)(lds + (cst_) + (off1_)); __builtin_shufflevector(lo_, hi_, 0, 1, 2, 3, 4, 5, 6, 7); })
#define PG8_LDA(dst, b, h) do { if constexpr (FP8) { _Pragma("unroll") for (int m = 0; m < 4; ++m) dst##8[m] = PG8_LD8(aoff, aoff1, PG8_SA(b, h) + m * 2048); } \
        else { _Pragma("unroll") for (int m = 0; m < 4; ++m) _Pragma("unroll") for (int k = 0; k < 2; ++k) dst[m][k] = *(const PG8_LAS bf16x8*)(lds + PG8_SA(b, h) + aoff + m * 2048 + k * 1024); } } while (0)
#define PG8_LDB(dst, b, h) do { if constexpr (FP8) { _Pragma("unroll") for (int n = 0; n < 2; ++n) dst##8[n] = PG8_LD8(boff, boff1, PG8_SB(b, h) + n * 2048); } \
        else { _Pragma("unroll") for (int n = 0; n < 2; ++n) _Pragma("unroll") for (int k = 0; k < 2; ++k) dst[n][k] = *(const PG8_LAS bf16x8*)(lds + PG8_SB(b, h) + boff + n * 2048 + k * 1024); } } while (0)
#define PG8_MMA(ai, bj, At, Bt) do { __builtin_amdgcn_s_setprio(1); if constexpr (FP8) { _Pragma("unroll") for (int m = 0; m < 4; ++m) _Pragma("unroll") for (int n = 0; n < 2; ++n) \
        asm volatile("v_mfma_scale_f32_16x16x128_f8f6f4 %0, %1, %2, %0, %3, %3 op_sel_hi:[0,0,0]" : "+v"(acc[ai][bj][m][n]) : "v"(Bt##8[n]), "v"(At##8[m]), "v"(f8sc)); } \
        else { _Pragma("unroll") for (int m = 0; m < 4; ++m) _Pragma("unroll") for (int n = 0; n < 2; ++n) _Pragma("unroll") for (int k = 0; k < 2; ++k) \
        acc[ai][bj][m][n] = __builtin_amdgcn_mfma_f32_16x16x32_bf16(Bt[n][k], At[m][k], acc[ai][bj][m][n], 0, 0, 0); } __builtin_amdgcn_s_setprio(0); } while (0)
#define PG8_WAIT_V(n) asm volatile("s_waitcnt vmcnt(" #n ")" ::: "memory")
#define PG8_WAIT_L(n) asm volatile("s_waitcnt lgkmcnt(" #n ")" ::: "memory")
#define PG8_BAR __builtin_amdgcn_s_barrier()
#define PG8_SCHED __builtin_amdgcn_sched_barrier(0)
    Unit cur, nxt; int ui = 0;
    if (!S.next(0, cur)) return;
    f32x4 acc[2][2][4][2];
#pragma unroll
    for (int a = 0; a < 2; ++a)
#pragma unroll
        for (int b = 0; b < 2; ++b)
#pragma unroll
            for (int m = 0; m < 4; ++m)
#pragma unroll
                for (int n = 0; n < 2; ++n) acc[a][b][m][n] = (f32x4){0.f, 0.f, 0.f, 0.f};
    bf16x8 At[4][2], B0[2][2], B1[2][2]; v8i At8[4], B08[2], B18[2];
    const int f8sc = F8_SCALE1;
    unsigned cOff[2][2], nOff[2][2];
    g.offs(cur, sR, sC, cOff);
    const char* cB = g.bptr(cur);
    PG8_STAGE(PG8_SB(0, 0), cB, voffB); PG8_STAGE(PG8_SB(0, 1), cB + hstep, voffB); PG8_STAGEA(PG8_SA(0, 0), cOff, 0, (size_t)0); PG8_STAGEA(PG8_SA(0, 1), cOff, 1, (size_t)0);
    if (wr == 1) PG8_BAR;
    PG8_WAIT_V(2); PG8_BAR;
    PG8_STAGE(PG8_SB(1, 0), cB + kstep, voffB); PG8_STAGEA(PG8_SA(1, 0), cOff, 0, kstep); PG8_STAGE(PG8_SB(1, 1), cB + hstep + kstep, voffB);
    PG8_WAIT_V(6); PG8_BAR;
    for (;;) {
        const bool has_next = S.next(ui + 1, nxt);
        const char* nB = cB;
        if (has_next) { g.offs(nxt, sR, sC, nOff); nB = g.bptr(nxt); }
        else {
#pragma unroll
            for (int h = 0; h < 2; ++h)
#pragma unroll
                for (int i = 0; i < 2; ++i) nOff[h][i] = cOff[h][i];
        }
        typename Epi::Pre pre; { int fr_ = fr; asm volatile("" : "+v"(fr_)); E.prefetch(cur, wr, fr_, pre); }
#pragma unroll 1
        for (int t = 0; t < nt; t += 2) {
            const bool last = (t == nt - 2);
            const size_t kb1 = (size_t)(t + 1) * kstep;
            const size_t kb2 = last ? (size_t)0 : (size_t)(t + 2) * kstep, kb3 = kb2 + kstep;
            unsigned o2[2][2];
#pragma unroll
            for (int h = 0; h < 2; ++h)
#pragma unroll
                for (int i = 0; i < 2; ++i) o2[h][i] = last ? nOff[h][i] : cOff[h][i];
            const char* b2 = last ? nB : cB + (size_t)(t + 2) * kstep; const char* b3 = b2 + kstep;
            PG8_LDB(B0, 0, 0); PG8_LDB(B1, 0, 1); PG8_SCHED; PG8_LDA(At, 0, 0); PG8_STAGEA(PG8_SA(1, 1), cOff, 1, kb1);
            PG8_WAIT_V(8); PG8_WAIT_L(0); PG8_BAR; PG8_MMA(0, 0, At, B0); PG8_MMA(0, 1, At, B1); PG8_BAR; PG8_SCHED;
            PG8_LDA(At, 0, 1); PG8_STAGE(PG8_SB(0, 0), b2, voffB); PG8_STAGE(PG8_SB(0, 1), b2 + hstep, voffB); PG8_STAGEA(PG8_SA(0, 0), o2, 0, kb2);
            PG8_WAIT_V(8); PG8_WAIT_L(0); PG8_BAR; PG8_MMA(1, 0, At, B0); PG8_MMA(1, 1, At, B1); PG8_BAR; PG8_SCHED;
            PG8_LDB(B0, 1, 0); PG8_LDB(B1, 1, 1); PG8_SCHED; PG8_LDA(At, 1, 0); PG8_STAGEA(PG8_SA(0, 1), o2, 1, kb2);
            PG8_WAIT_V(8); PG8_WAIT_L(0); PG8_BAR; PG8_MMA(0, 0, At, B0); PG8_MMA(0, 1, At, B1); PG8_BAR; PG8_SCHED;
            PG8_LDA(At, 1, 1); PG8_STAGE(PG8_SB(1, 0), b3, voffB); PG8_STAGE(PG8_SB(1, 1), b3 + hstep, voffB); PG8_STAGEA(PG8_SA(1, 0), o2, 0, kb3);
            PG8_WAIT_V(8); PG8_WAIT_L(0); PG8_BAR; PG8_MMA(1, 0, At, B0); PG8_MMA(1, 1, At, B1); PG8_BAR; PG8_SCHED;
        }
        if constexpr (FP8) asm volatile("s_nop 15\n\ts_nop 15" ::: "memory");
        if (wr == 0) PG8_BAR;
        { int fr_ = fr, fq_ = fq; asm volatile("" : "+v"(fr_), "+v"(fq_));
          E(acc, cur, wr, wc, fr_, fq_, pre); }
        if (!has_next) break;
#pragma unroll
        for (int a = 0; a < 2; ++a)
#pragma unroll
            for (int b = 0; b < 2; ++b)
#pragma unroll
                for (int m = 0; m < 4; ++m)
#pragma unroll
                    for (int n = 0; n < 2; ++n) acc[a][b][m][n] = (f32x4){0.f, 0.f, 0.f, 0.f};
        cur = nxt; cB = nB; ++ui;
#pragma unroll
        for (int h = 0; h < 2; ++h)
#pragma unroll
            for (int i = 0; i < 2; ++i) cOff[h][i] = nOff[h][i];
        if (wr == 1) PG8_BAR;
    }
    PG8_WAIT_V(0);
    PG8_BAR;
#undef PG8_SA
#undef PG8_SB
#undef PG8_STAGE
#undef PG8_STAGEA
#undef PG8_LDA
#undef PG8_LD8
#undef PG8_LDB
#undef PG8_MMA
#undef PG8_WAIT_V
#undef PG8_WAIT_L
#undef PG8_BAR
#undef PG8_SCHED
}
}

namespace attn_body {
using bf16=__hip_bfloat16;
using bf16x8=__attribute__((ext_vector_type(8)))short;
using s16x4=__attribute__((ext_vector_type(4)))short;
using f32x16=__attribute__((ext_vector_type(16)))float;
using f32x4=__attribute__((ext_vector_type(4)))float;
using u32x4=__attribute__((ext_vector_type(4)))unsigned;
using u32x2=__attribute__((ext_vector_type(2)))unsigned;
constexpr int D=64,DM=HW;
constexpr int NW=8,QBLK=32,QB=QBLK*NW,KVBLK=64;
__device__ __forceinline__ int crow(int r,int hi){return (r&3)+8*(r>>2)+4*hi;}
#define SBAR() __builtin_amdgcn_sched_barrier(0)
__device__ __forceinline__ void cmask(f32x16&p0,f32x16&p1,int jb,int qrel,int hi){
  const float NEG=-INFINITY; const int d=qrel-64*jb-4*hi;
  #pragma unroll
  for(int r=0;r<16;++r){const int c=(r&3)+8*(r>>2); if(c>d)p0[r]=NEG; if(c+32>d)p1[r]=NEG;}
}
__device__ __forceinline__ void addmask(f32x16&p0,f32x16&p1,float addv){
  #pragma unroll
  for(int r=0;r<16;++r){p0[r]+=addv;p1[r]+=addv;}
}
typedef __attribute__((address_space(3))) const char* lds_cptr;
__device__ __forceinline__ float mselect(int m,float v){ return __uint_as_float((__float_as_uint(v)&(unsigned)m)|(0xff800000u&~(unsigned)m)); }
__device__ __forceinline__ void bitmask(f32x16&p0,f32x16&p1,lds_cptr mrow,int t,int hi){
  const u32x2 w=*(const __attribute__((address_space(3))) u32x2*)(mrow+((t>>2)&1)*1024+((t>>1)&1)*512+(t&1)*8);
  const int w0=(int)(w.x>>(4*hi)),w1=(int)(w.y>>(4*hi));
  #pragma unroll
  for(int r=0;r<16;++r){const int bpos=(r&3)+8*(r>>2); p0[r]=mselect(__builtin_amdgcn_sbfe(w0,bpos,1),p0[r]); p1[r]=mselect(__builtin_amdgcn_sbfe(w1,bpos,1),p1[r]);}
}

constexpr int NSLOT=3, SLOTB=8192;
constexpr int LDS_K=0, LDS_V=NSLOT*SLOTB, LDS_WS=2*NSLOT*SLOTB, LDS_OST=LDS_WS+NW*64*4, LDS_MSK=LDS_OST+NW*4096, LDS_BYTES=LDS_MSK+NW*2048, LDS_QST=LDS_BYTES, LDS_QST_BYTES=NW*4096;
__device__ __forceinline__ void glds16(const void*gsrc,unsigned lds_dst){unsigned keep;
  asm volatile("s_mov_b32 %0, m0\n\ts_mov_b32 m0, %2\n\ts_nop 0\n\tglobal_load_lds_dwordx4 %1, off\n\ts_mov_b32 m0, %0":"=&s"(keep):"v"(gsrc),"s"(lds_dst):"memory");}
__device__ __forceinline__ float max3f(float a,float b,float c){float r;asm("v_max3_f32 %0, %1, %2, %3":"=v"(r):"v"(a),"v"(b),"v"(c));return r;}
__device__ __forceinline__ float max2f(float a,float b){float r;asm("v_max_f32_e32 %0, %1, %2":"=v"(r):"v"(a),"v"(b));return r;}
__device__ __forceinline__ float fadd_s(float a,float b){float r;asm("v_add_f32_e32 %0, %1, %2":"=v"(r):"v"(a),"v"(b));return r;}
__device__ __forceinline__ float fsub_s(float a,float b){float r;asm("v_sub_f32_e32 %0, %1, %2":"=v"(r):"v"(a),"v"(b));return r;}
typedef float f32x2_t __attribute__((ext_vector_type(2))); typedef __bf16 bf16x2_t __attribute__((ext_vector_type(2)));
__device__ __forceinline__ unsigned cvtpk_s(float lo,float hi){f32x2_t v={lo,hi};bf16x2_t b=__builtin_convertvector(v,bf16x2_t);return __builtin_bit_cast(unsigned,b);}
#define WAIT_BAR(N) asm volatile("s_waitcnt vmcnt(" #N ") lgkmcnt(0)\n\ts_barrier":::"memory")

__device__ __forceinline__ void qkt(f32x16&p0,f32x16&p1,const char*Kslot,const bf16x8*qr,int r32,int hi){
  const f32x16 negm=f32x16{};
  const char*kb=Kslot+hi*1024+r32*16;
  #pragma unroll
  for(int d0=0;d0<4;++d0){
    const bf16x8 b0=*reinterpret_cast<const bf16x8*>(kb+d0*2048);
    const bf16x8 b1=*reinterpret_cast<const bf16x8*>(kb+d0*2048+512);
    if(d0==0){p0=__builtin_amdgcn_mfma_f32_32x32x16_bf16(b0,qr[0],negm,0,0,0);p1=__builtin_amdgcn_mfma_f32_32x32x16_bf16(b1,qr[0],negm,0,0,0);}
    else{p0=__builtin_amdgcn_mfma_f32_32x32x16_bf16(b0,qr[d0],p0,0,0,0);p1=__builtin_amdgcn_mfma_f32_32x32x16_bf16(b1,qr[d0],p1,0,0,0);}}
}
typedef short v4i16_t __attribute__((ext_vector_type(4)));
__device__ __forceinline__ void kload8(bf16x8*kf,lds_cptr kp){
  kf[0]=*(const __attribute__((address_space(3))) bf16x8*)(kp);      kf[1]=*(const __attribute__((address_space(3))) bf16x8*)(kp+512);
  kf[2]=*(const __attribute__((address_space(3))) bf16x8*)(kp+2048); kf[3]=*(const __attribute__((address_space(3))) bf16x8*)(kp+2560);
  kf[4]=*(const __attribute__((address_space(3))) bf16x8*)(kp+4096); kf[5]=*(const __attribute__((address_space(3))) bf16x8*)(kp+4608);
  kf[6]=*(const __attribute__((address_space(3))) bf16x8*)(kp+6144); kf[7]=*(const __attribute__((address_space(3))) bf16x8*)(kp+6656);
}
__device__ __forceinline__ void kload2(bf16x8*kf,lds_cptr kp,int j){ kf[2*j]=*(const __attribute__((address_space(3))) bf16x8*)(kp+j*2048); kf[2*j+1]=*(const __attribute__((address_space(3))) bf16x8*)(kp+j*2048+512); }
__device__ __forceinline__ s16x4 vtr(lds_cptr p){ return __builtin_bit_cast(s16x4,__builtin_amdgcn_ds_read_tr16_b64_v4i16((__attribute__((address_space(3))) v4i16_t*)p)); }
__device__ __forceinline__ float rowmax(const f32x16&p0,const f32x16&p1){
  float a=max3f(p0[0],p0[1],p1[0]),b=max3f(p0[2],p0[3],p1[1]);a=max3f(a,p1[2],p1[3]);
  #pragma unroll
  for(int r=4;r<16;r+=4){a=max3f(a,p0[r],p0[r+1]);b=max3f(b,p0[r+2],p0[r+3]);a=max3f(a,p1[r],p1[r+1]);b=max3f(b,p1[r+2],p1[r+3]);}
  const float m=max2f(a,b);
  auto rr=__builtin_amdgcn_permlane32_swap(__float_as_uint(m),__float_as_uint(m),false,false);
  return max2f(__uint_as_float(rr[0]),__uint_as_float(rr[1]));
}
__device__ __forceinline__ void pv(f32x16*o,int vb,bf16x8 pa0,bf16x8 pa1,bf16x8 pa2,bf16x8 pa3){
  #pragma unroll
  for(int d0=0;d0<2;++d0){s16x4 lo[4],hi[4];
    #pragma unroll
    for(int ks=0;ks<4;++ks){
      asm volatile("ds_read_b64_tr_b16 %0,%1 offset:%c2":"=&v"(lo[ks]):"v"(vb),"i"(d0*4096+ks*1024):"memory");
      asm volatile("ds_read_b64_tr_b16 %0,%1 offset:%c2":"=&v"(hi[ks]):"v"(vb),"i"(d0*4096+ks*1024+512):"memory");}
    asm volatile("s_waitcnt lgkmcnt(0)":::"memory");SBAR();
    #define PK(k) (bf16x8){lo[k][0],lo[k][1],lo[k][2],lo[k][3],hi[k][0],hi[k][1],hi[k][2],hi[k][3]}
    o[d0]=__builtin_amdgcn_mfma_f32_32x32x16_bf16(pa0,PK(0),o[d0],0,0,0);
    o[d0]=__builtin_amdgcn_mfma_f32_32x32x16_bf16(pa1,PK(1),o[d0],0,0,0);
    o[d0]=__builtin_amdgcn_mfma_f32_32x32x16_bf16(pa2,PK(2),o[d0],0,0,0);
    o[d0]=__builtin_amdgcn_mfma_f32_32x32x16_bf16(pa3,PK(3),o[d0],0,0,0);
    #undef PK
  }
}
#ifndef ATTN_STORE16
#define ATTN_STORE16(p,v) (*(u32x4*)(p)=(v))
#endif
__device__ __forceinline__ float bfs(short s){ return __uint_as_float(((unsigned)(unsigned short)s)<<16); }

template<int MODE,int THRL> __device__ __forceinline__ void attn_unit(int b,int h,int qb,const bf16*Q,const bf16*__restrict__ K,const bf16*__restrict__ V,unsigned char*O,char*shm,
                                                                      const float*kbsum,const unsigned long long*maskw,const int tid_in,
                                                                      const bool pre,const bool has_next,const bf16*Qn,const bf16*Kn,const int qbn,const bool bitsn){
  int tid=tid_in; asm volatile("":"+v"(tid));
  const int lane=tid&63,r32=lane&31,hi=lane>>5; const int wid=__builtin_amdgcn_readfirstlane(tid>>6);
  const long rowbase=(long)b*SEQ; const int q0=qb*QB;
  const bf16*Qw=Q+(rowbase+q0+wid*QBLK)*DM+h*D;
  const bf16*Kh=K+rowbase*DM+h*D,*Vh=V+rowbase*DM+h*D;
  const unsigned lds0=(unsigned)(uintptr_t)shm;
  float*wsf=(float*)(shm+LDS_WS)+wid*64;
  const unsigned koff=(unsigned)((lane*DM+wid*8)*2);
  const unsigned voff=(unsigned)(((16*(wid&3)+(lane>>2))*DM+(wid>>2)*32+(lane&3)*8)*2);
  const unsigned kdst=lds0+LDS_K+wid*1024, vdst=lds0+LDS_V+wid*1024;
  #define DMA_K(t,slot) glds16((const char*)Kh+(size_t)(t)*(KVBLK*DM*2)+koff,(unsigned)__builtin_amdgcn_readfirstlane(kdst+(slot)))
  #define DMA_V(t,slot) glds16((const char*)Vh+(size_t)(t)*(KVBLK*DM*2)+voff,(unsigned)__builtin_amdgcn_readfirstlane(vdst+(slot)))
  const unsigned long long*mbase=maskw+(size_t)(rowbase+q0+wid*QBLK)*32;
  const unsigned moff=(unsigned)((r32*32+2*hi)*8);
  const unsigned mdst=lds0+LDS_MSK+wid*2048;
  #define DMA_M(tg) glds16((const char*)mbase+(size_t)(32*(tg))+moff,(unsigned)__builtin_amdgcn_readfirstlane(mdst+((tg)&1)*1024))
  const bool usebits=(MODE==1)&&(qb>0);
  const int vb0=(int)(lds0+LDS_V)+((lane>>4)&1)*32+(lane&3)*8+(4*hi+((lane&15)>>2))*64;
  const char*Kbase=shm+LDS_K; bf16x8 kf[8];
  const lds_cptr shm3=(lds_cptr)shm; const lds_cptr kp0=shm3+LDS_K+hi*1024+r32*16; const lds_cptr vp0=shm3+LDS_V+((lane>>4)&1)*32+(lane&3)*8+(4*hi+((lane&15)>>2))*64;
  const lds_cptr mrow=shm3+LDS_MSK+wid*2048+r32*16;
  const int NT=(q0+QB)/KVBLK;
  const unsigned qst=lds0+LDS_QST+wid*4096;
  bf16x8 qr[4];
  if(!pre){ if(usebits){DMA_M(0);} DMA_K(0,0);DMA_V(0,0);DMA_K(1,SLOTB);
    #pragma unroll
    for(int d0=0;d0<4;++d0)qr[d0]=*reinterpret_cast<const bf16x8*>(&Qw[(long)r32*DM+d0*16+hi*8]); }
  else { DMA_V(0,0);
    asm volatile("s_waitcnt vmcnt(7)":::"memory");
    const lds_cptr qp=shm3+LDS_QST+wid*4096+(r32>>3)*1024+(r32&7)*128;
    #pragma unroll
    for(int d0=0;d0<4;++d0)qr[d0]=*reinterpret_cast<const __attribute__((address_space(3))) bf16x8*>(qp+(((d0*2+hi)^(r32&7))*16)); }
  unsigned selbits=(1u<<qb)-1u;
  const lds_cptr kbl=shm3+LDS_MSK+1024;
  if(MODE==0&&!pre){ const float kv_=kbsum[(size_t)(b*NHEAD+h)*512+tid];
    *(__attribute__((address_space(3))) float*)(kbl+tid*4)=kv_; asm volatile("s_waitcnt lgkmcnt(0)\n\ts_barrier":::"memory"); }
  if(MODE==0&&qb>3){
    float g[7];
    #pragma unroll
    for(int j=0;j<7;++j){ g[j]=0.f;
      if(j<qb){ const lds_cptr kbp=kbl+(j*64+hi*8)*4; float s=0.f;
        #pragma unroll
        for(int d0=0;d0<4;++d0){ const f32x4 k0=*(const __attribute__((address_space(3))) f32x4*)(kbp+d0*64),k1=*(const __attribute__((address_space(3))) f32x4*)(kbp+d0*64+16);
          s+=bfs(qr[d0][0])*k0[0]+bfs(qr[d0][1])*k0[1]+bfs(qr[d0][2])*k0[2]+bfs(qr[d0][3])*k0[3]+bfs(qr[d0][4])*k1[0]+bfs(qr[d0][5])*k1[1]+bfs(qr[d0][6])*k1[2]+bfs(qr[d0][7])*k1[3]; }
        s+=__shfl_xor(s,32); g[j]=s; } }
    selbits=0u;
    #pragma unroll
    for(int j=0;j<7;++j){ if(j<qb){ int rank=0;
      #pragma unroll
      for(int i=0;i<7;++i){ if(i!=j&&i<qb){ rank+=(g[i]>g[j]||(g[i]==g[j]&&i<j))?1:0; } }
      if(rank<3)selbits|=(1u<<j); } }
  }
  float mhat=0.f,l_reg=0.f;f32x16 o[2];o[0]=f32x16{};o[1]=f32x16{};const f32x16 zero16=f32x16{};
  const int qrel=wid*QBLK+r32;
  #define AMASK_PEEL(P0,P1,t) do{ const int jb_=(t)-(NT-4); \
      if(usebits){ bitmask(P0,P1,mrow,(t),hi); } \
      else if(jb_>=0){ cmask(P0,P1,jb_,qrel,hi); } }while(0)
  #define ADDV_PEEL(t) ((MODE==0&&(t)<NT-4)?(((selbits>>((t)>>2))&1u)?0.f:-INFINITY):0.f)
  #define AMASK_STEADY(P0,P1,t) do{ if(MODE==1){ bitmask(P0,P1,mrow,(t),hi); } }while(0)
  #define ADDV_STEADY(t) ((MODE==0)?(((selbits>>((t)>>2))&1u)?0.f:-INFINITY):0.f)
  #define CMASK(P0,P1,t) AMASK_PEEL(P0,P1,t)
  #define ADDV(t) ADDV_PEEL(t)
  bool resc=false;
  #define START(P0,P1) do{ const float rm=rowmax(P0,P1); resc=false; \
    { const float dl=(rm<-1e30f)?0.f:rm; mhat=fadd_s(mhat,dl); \
      _Pragma("unroll") for(int r=0;r<16;++r){P0[r]=fsub_s(P0[r],dl);P1[r]=fsub_s(P1[r],dl);} } \
    _Pragma("unroll") for(int r=0;r<16;++r)P0[r]=__builtin_amdgcn_exp2f(P0[r]); }while(0)
  #define RESC() do{ if(resc){ asm volatile("s_waitcnt lgkmcnt(0)":::"memory"); \
      _Pragma("unroll") for(int d_=0;d_<2;++d_) _Pragma("unroll") for(int r=0;r<16;++r)o[d_][r]*=wsf[crow(r,hi)]; } }while(0)
  f32x16 pA0,pA1,pB0,pB1;
  int sl_prev=0,sl_cur=0,sl_next=SLOTB;
  #define ROT() do{sl_prev=sl_cur;sl_cur=sl_next;sl_next=(sl_next==(NSLOT-1)*SLOTB)?0:sl_next+SLOTB;}while(0)
  if(!pre){ DMA_K(2,2*SLOTB); WAIT_BAR(3); } else { WAIT_BAR(7); }
  qkt(pA0,pA1,Kbase,qr,r32,hi);asm volatile("s_nop 15\n\ts_nop 7":"+v"(pA0),"+v"(pA1));CMASK(pA0,pA1,0);
  if(MODE==0){ addmask(pA0,pA1,ADDV(0)); }
  asm volatile("s_nop 7":"+v"(pA0),"+v"(pA1));
  START(pA0,pA1);
  _Pragma("unroll") for(int r=0;r<16;++r)pA1[r]=__builtin_amdgcn_exp2f(pA1[r]);
  WAIT_BAR(0);
  const bool m1_=usebits&&NT>4;
  DMA_K(3,0);DMA_V(1,SLOTB); if(m1_){DMA_M(1);}
  ROT();
  kload8(kf,kp0+sl_cur);
  if(m1_){WAIT_BAR(3);}else{WAIT_BAR(2);}
  s16x4 vlo[8],vhi[8]; u32x4 pw0,pw1,pw2,pw3;
  #define PKW(P,B) cvtpk_s(P[B],P[B+1])
  #define PAF(k) __builtin_bit_cast(bf16x8,pw##k)
  #define VFR(i) (bf16x8){vlo[i][0],vlo[i][1],vlo[i][2],vlo[i][3],vhi[i][0],vhi[i][1],vhi[i][2],vhi[i][3]}
  #define PIN(x) asm volatile("":"+v"(x))
  #define MX3(a,b,c) __builtin_fmaxf(__builtin_fmaxf((a),(b)),(c))
  #define GAPA(MF,A0,A1,A2,A3,W0,W1,PW) do{ MF; sacc+=A0; sacc+=A1; sacc+=A2; sacc+=A3; PIN(sacc); W0; W1; PIN(PW); SBAR(); }while(0)
  #define EX(v) __builtin_amdgcn_exp2f(v)
  #define GAPB(MF,X,B) do{ MF; X[B]=EX(X[B]); X[B+1]=EX(X[B+1]); X[B+2]=EX(X[B+2]); X[B+3]=EX(X[B+3]); PIN(X); SBAR(); }while(0)
  #define VRD(i) do{ vlo[i]=vtr(vp_+(((i)>>2)*4096+((i)&3)*1024)); vhi[i]=vtr(vp_+(((i)>>2)*4096+((i)&3)*1024+512)); }while(0)
  #define KRD(G,j) do{ if(G){ kload2(kf,kp0+sl_next,j); SBAR(); } }while(0)
  #define STEP(C0,C1,P0,P1,t,GK,GV,GL,GM) do{ SBAR(); \
    const lds_cptr vp_=vp0+sl_prev; \
    VRD(0); SBAR(); float sacc=(P0[0]+P0[1]); \
    GAPA(C0=__builtin_amdgcn_mfma_f32_32x32x16_bf16(kf[0],qr[0],zero16,0,0,0), P0[2],P0[3],P0[4],P0[5],     pw0[0]=PKW(P0,0), pw0[1]=PKW(P0,2), pw0); \
    VRD(4); SBAR(); GAPA(C1=__builtin_amdgcn_mfma_f32_32x32x16_bf16(kf[1],qr[0],zero16,0,0,0), P0[6],P0[7],P0[8],P0[9],     pw0[2]=PKW(P0,4), pw0[3]=PKW(P0,6), pw0); \
    VRD(1); SBAR(); GAPA(C0=__builtin_amdgcn_mfma_f32_32x32x16_bf16(kf[2],qr[1],C0,0,0,0),   P0[10],P0[11],P0[12],P0[13], pw1[0]=PKW(P0,8), pw1[1]=PKW(P0,10), pw1); \
    VRD(5); SBAR(); GAPA(C1=__builtin_amdgcn_mfma_f32_32x32x16_bf16(kf[3],qr[1],C1,0,0,0),   P0[14],P0[15],P1[0],P1[1],   pw1[2]=PKW(P0,12),pw1[3]=PKW(P0,14), pw1); \
    VRD(2); SBAR(); GAPA(C0=__builtin_amdgcn_mfma_f32_32x32x16_bf16(kf[4],qr[2],C0,0,0,0),   P1[2],P1[3],P1[4],P1[5],     pw2[0]=PKW(P1,0), pw2[1]=PKW(P1,2), pw2); \
    VRD(6); SBAR(); GAPA(C1=__builtin_amdgcn_mfma_f32_32x32x16_bf16(kf[5],qr[2],C1,0,0,0),   P1[6],P1[7],P1[8],P1[9],     pw2[2]=PKW(P1,4), pw2[3]=PKW(P1,6), pw2); \
    VRD(3); SBAR(); GAPA(C0=__builtin_amdgcn_mfma_f32_32x32x16_bf16(kf[6],qr[3],C0,0,0,0),   P1[10],P1[11],P1[12],P1[13], pw3[0]=PKW(P1,8), pw3[1]=PKW(P1,10), pw3); \
    VRD(7); SBAR(); GAPA(C1=__builtin_amdgcn_mfma_f32_32x32x16_bf16(kf[7],qr[3],C1,0,0,0),   P1[14],P1[15],0.f,0.f,       pw3[2]=PKW(P1,12),pw3[3]=PKW(P1,14), pw3); \
    l_reg+=sacc; \
    if(GK){DMA_K((t)+3,sl_cur);} if(GV){DMA_V((t)+1,sl_next);} \
    if(GM){DMA_M(((t)>>2)+1);} \
    CMASK(C0,C1,t); \
    { float a=MX3(C0[0],C0[1],C1[0]),b=MX3(C0[2],C0[3],C1[1]); a=MX3(a,C1[2],C1[3]); \
      _Pragma("unroll") for(int r=4;r<16;r+=4){a=MX3(a,C0[r],C0[r+1]);b=MX3(b,C0[r+2],C0[r+3]);a=MX3(a,C1[r],C1[r+1]);b=MX3(b,C1[r+2],C1[r+3]);} \
      float rm=__builtin_fmaxf(a,b); { auto rr=__builtin_amdgcn_permlane32_swap(__float_as_uint(rm),__float_as_uint(rm),false,false); rm=__builtin_fmaxf(__uint_as_float(rr[0]),__uint_as_float(rr[1])); } \
      const float addv_=ADDV(t); rm=(rm+addv_)-mhat; \
      resc=false; \
      if(__builtin_expect(__any(rm>(float)THRL),0)){ const float dl=__builtin_fmaxf(rm,0.f); mhat+=dl; \
        const float f=__builtin_amdgcn_exp2f(-dl); l_reg*=f; if(hi==0)wsf[r32]=f; resc=true; } \
      const float sub_=mhat-addv_; \
      _Pragma("unroll") for(int r=0;r<16;++r){C0[r]-=sub_;C1[r]-=sub_;} } \
    SBAR(); \
    GAPB(o[0]=__builtin_amdgcn_mfma_f32_32x32x16_bf16(PAF(0),VFR(0),o[0],0,0,0), C0,0); \
    GAPB(o[1]=__builtin_amdgcn_mfma_f32_32x32x16_bf16(PAF(0),VFR(4),o[1],0,0,0), C0,4); \
    KRD(GL,0); GAPB(o[0]=__builtin_amdgcn_mfma_f32_32x32x16_bf16(PAF(1),VFR(1),o[0],0,0,0), C0,8); \
    KRD(GL,1); GAPB(o[1]=__builtin_amdgcn_mfma_f32_32x32x16_bf16(PAF(1),VFR(5),o[1],0,0,0), C0,12); \
    KRD(GL,2); GAPB(o[0]=__builtin_amdgcn_mfma_f32_32x32x16_bf16(PAF(2),VFR(2),o[0],0,0,0), C1,0); \
    KRD(GL,3); GAPB(o[1]=__builtin_amdgcn_mfma_f32_32x32x16_bf16(PAF(2),VFR(6),o[1],0,0,0), C1,4); \
    GAPB(o[0]=__builtin_amdgcn_mfma_f32_32x32x16_bf16(PAF(3),VFR(3),o[0],0,0,0), C1,8); \
    GAPB(o[1]=__builtin_amdgcn_mfma_f32_32x32x16_bf16(PAF(3),VFR(7),o[1],0,0,0), C1,12); \
    }while(0)
  int t=1;
  #undef CMASK
  #undef ADDV
  #define CMASK(P0,P1,t) AMASK_STEADY(P0,P1,t)
  #define ADDV(t) ADDV_STEADY(t)
  for(;t+5<NT;t+=2){
    STEP(pB0,pB1,pA0,pA1,t,true,true,true,false);     WAIT_BAR(2); RESC(); ROT();
    { const bool gm_=(MODE==1&&(((t+1)&3)==0)&&(t+5<NT)); STEP(pA0,pA1,pB0,pB1,t+1,true,true,true,gm_); if(gm_){WAIT_BAR(3);}else{WAIT_BAR(2);} RESC(); ROT(); }
  }
  #undef CMASK
  #undef ADDV
  #define CMASK(P0,P1,t) AMASK_PEEL(P0,P1,t)
  #define ADDV(t) ADDV_PEEL(t)
  #define ENDW(tt) do{ if((tt)+3<NT){WAIT_BAR(2);} else if((tt)+2<NT){WAIT_BAR(1);} else {WAIT_BAR(0);} }while(0)
  for(;t+1<NT;t+=2){
    STEP(pB0,pB1,pA0,pA1,t,(t+3<NT),(t+1<NT),(t+1<NT),false);       ENDW(t);   RESC(); ROT();
    STEP(pA0,pA1,pB0,pB1,t+1,(t+4<NT),(t+2<NT),(t+2<NT),false);     ENDW(t+1); RESC(); ROT();
  }
  STEP(pB0,pB1,pA0,pA1,NT-1,false,false,false,false); RESC();
  { float sacc=pB0[0]+pB0[1]; _Pragma("unroll") for(int r=2;r<16;++r)sacc+=pB0[r]; _Pragma("unroll") for(int r=0;r<16;++r)sacc+=pB1[r]; l_reg+=sacc;
    pw0=(u32x4){PKW(pB0,0),PKW(pB0,2),PKW(pB0,4),PKW(pB0,6)};pw1=(u32x4){PKW(pB0,8),PKW(pB0,10),PKW(pB0,12),PKW(pB0,14)};pw2=(u32x4){PKW(pB1,0),PKW(pB1,2),PKW(pB1,4),PKW(pB1,6)};pw3=(u32x4){PKW(pB1,8),PKW(pB1,10),PKW(pB1,12),PKW(pB1,14)};
    SBAR(); pv(o,vb0+sl_cur,PAF(0),PAF(1),PAF(2),PAF(3)); }
  if(has_next){ const int q0n=qbn*QB; const bf16*Khn=Kn+rowbase*DM+h*D;
    glds16((const char*)Khn+koff,(unsigned)__builtin_amdgcn_readfirstlane(kdst));
    { const char*Qnw=(const char*)(Qn+(rowbase+q0n+wid*QBLK)*DM+h*D);
      #pragma unroll
      for(int j=0;j<4;++j) glds16(Qnw+(size_t)(8*j+(lane>>3))*(DM*2)+(((lane&7)^(lane>>3))*16),(unsigned)__builtin_amdgcn_readfirstlane(qst+j*1024)); }
    if(bitsn){ const unsigned long long*mbn=maskw+(size_t)(rowbase+q0n+wid*QBLK)*32; glds16((const char*)mbn+moff,(unsigned)__builtin_amdgcn_readfirstlane(mdst)); }
    glds16((const char*)Khn+(size_t)1*(KVBLK*DM*2)+koff,(unsigned)__builtin_amdgcn_readfirstlane(kdst+SLOTB));
    glds16((const char*)Khn+(size_t)2*(KVBLK*DM*2)+koff,(unsigned)__builtin_amdgcn_readfirstlane(kdst+2*SLOTB)); }
  #undef PKW
  #undef PAF
  #undef VFR
  #undef PIN
  #undef MX3
  #undef GAPA
  #undef GAPB
  #undef EX
  #undef VRD
  #undef KRD
  #undef STEP
  #undef ENDW
  {auto rr=__builtin_amdgcn_permlane32_swap(__float_as_uint(l_reg),__float_as_uint(l_reg),false,false);l_reg=__uint_as_float(rr[0])+__uint_as_float(rr[1]);}
  if(hi==0)wsf[32+r32]=l_reg;asm volatile("s_waitcnt lgkmcnt(0)":::"memory");
  float rli[16];
  #pragma unroll
  for(int r=0;r<16;++r)rli[r]=__builtin_amdgcn_rcpf(wsf[32+crow(r,hi)]);
  unsigned char*Ow=O+(rowbase+q0+wid*QBLK)*DM+h*D;
  { bf16*stg=(bf16*)(shm+LDS_OST)+wid*2048;
    #pragma unroll
    for(int r=0;r<16;++r){const int orow=crow(r,hi);
      #pragma unroll
      for(int d0=0;d0<2;++d0)stg[orow*64+d0*32+r32]=__float2bfloat16(o[d0][r]*rli[r]);}
    asm volatile("s_waitcnt lgkmcnt(0)":::"memory");
    #pragma unroll
    for(int i=0;i<4;++i){const int row=i*8+(lane>>3),ch=lane&7; const u32x4 v=*(const u32x4*)(stg+row*64+ch*8); u32x2 w;
      w.x=pg8::cvt4_fp8(16.f*__uint_as_float(v.x<<16),16.f*__uint_as_float(v.x&0xffff0000u),16.f*__uint_as_float(v.y<<16),16.f*__uint_as_float(v.y&0xffff0000u));
      w.y=pg8::cvt4_fp8(16.f*__uint_as_float(v.z<<16),16.f*__uint_as_float(v.z&0xffff0000u),16.f*__uint_as_float(v.w<<16),16.f*__uint_as_float(v.w&0xffff0000u));
      *(u32x2*)(Ow+(long)row*DM+ch*8)=w;} }
  asm volatile("s_waitcnt lgkmcnt(0)\n\ts_barrier":::"memory");
  #undef DMA_K
  #undef DMA_V
  #undef DMA_M
  #undef CMASK
  #undef AMASK_PEEL
  #undef AMASK_STEADY
  #undef ADDV
  #undef ADDV_PEEL
  #undef ADDV_STEADY
  #undef START
  #undef RESC
  #undef ROT
}
constexpr int ATTN_LDS_BYTES=LDS_BYTES;
#undef SBAR
#undef WAIT_BAR
}

constexpr int NWAVES = 8;
constexpr size_t MiB = 1u << 20;
constexpr size_t WS_CTL = 0, CTL_ZERO_BYTES = 32 * 1024;
constexpr size_t WS_WIN = 1 * MiB, WS_WA = 13 * MiB, WS_WB = 14 * MiB, WS_WOUT = 15 * MiB, WS_W13 = 17 * MiB, WS_W2 = 81 * MiB;
constexpr size_t WS_WR = 113 * MiB, WS_ROPE = 113 * MiB + 512 * 1024;
constexpr size_t WS_RSTD1 = 114 * MiB, WS_RSTD2 = 114 * MiB + 256 * 1024, WS_KBSUM = 114 * MiB + 512 * 1024;
constexpr size_t WS_KI = 115 * MiB, WS_WI = 123 * MiB, WS_MASK = 125 * MiB, WS_TOK = 141 * MiB, WS_GATE = 149 * MiB;
constexpr size_t WS_RSORT = WS_KI, WS_GSORT = WS_MASK;
constexpr size_t WS_QA = 152 * MiB, WS_KA = 216 * MiB, WS_VA = 280 * MiB, WS_QB = 344 * MiB, WS_KB = 408 * MiB, WS_VB = 472 * MiB, WS_QI = 536 * MiB;
constexpr size_t WS_XB = 600 * MiB, WS_OA = 928 * MiB, WS_OB = 960 * MiB, WS_MIX = 216 * MiB, WS_X1B = 728 * MiB, WS_HID = 856 * MiB, WS_YS = 152 * MiB, WS_END = 1024 * MiB;
constexpr size_t WS_WR8 = 113 * MiB + 256 * 1024;
constexpr size_t WS_X1H = 280 * MiB, WS_X1L = 408 * MiB;
static_assert(WS_HID + (size_t)HID_ROWS * EFF <= WS_OA, "ws map");
constexpr size_t WS_MIX8 = 152 * MiB;
constexpr size_t WS_WIN8 = WS_WIN + 6 * MiB, WS_X8 = 728 * MiB;
static_assert(WS_WIN + (size_t)NINA * DMODEL * 2 <= WS_WIN8 && WS_WIN8 + (size_t)NINB * DMODEL <= WS_WA, "ws map");
constexpr int CW_CNT = 64;
constexpr int CW_BAR = 4096;
constexpr int RING_BYTES = 131072, SCR_BYTES = 132096, MISC_OFF = SCR_BYTES, LDS_BYTES = 155648;
constexpr int QSTG_OFF = MISC_OFF + 4096, QSTG_STRIDE = 1056, WSTG_OFF = QSTG_OFF + 16 * QSTG_STRIDE;
static_assert(WSTG_OFF + 512 <= LDS_BYTES, "lds map");
constexpr int SC_STRIDE = 2052;
static_assert(16 * SC_STRIDE * 4 <= SCR_BYTES && attn_body::ATTN_LDS_BYTES <= RING_BYTES && attn_body::LDS_QST + attn_body::LDS_QST_BYTES <= MISC_OFF + 1024, "lds map");

#define GAS __attribute__((address_space(1)))
#define LAS __attribute__((address_space(3)))
typedef unsigned short bf16;
typedef unsigned v4u __attribute__((ext_vector_type(4)));
typedef unsigned v2u __attribute__((ext_vector_type(2)));
typedef float f32x4 __attribute__((ext_vector_type(4)));
typedef short bf16x8 __attribute__((ext_vector_type(8)));
#define LDS_WAIT() asm volatile("s_waitcnt lgkmcnt(0)" ::: "memory")
__device__ __forceinline__ unsigned f2bf(float f) { unsigned u = __builtin_bit_cast(unsigned, f); return (u + 0x7fffu + ((u >> 16) & 1u)) >> 16; }
__device__ __forceinline__ unsigned pk2(float lo, float hi) { return f2bf(lo) | (f2bf(hi) << 16); }
__device__ __forceinline__ float bf2f(unsigned s) { return __uint_as_float(s << 16); }

#define XB_TMO      128
#define XB_XCNT(j)  (256  + 64 * (j))
#define XB_XSUB(j)  (1280 + 64 * (j))
#define XB_XGEN(j)  (2304 + 64 * (j))
#define XB_TOP      3328
#define XB_TOPGEN   3392
#define XCD_BAR_WORDS 3456
#define XB_SPIN_CAP (1u << 22)
__device__ __forceinline__ unsigned xb_ld(unsigned* p)              { return __hip_atomic_load(p, __ATOMIC_RELAXED, __HIP_MEMORY_SCOPE_AGENT); }
__device__ __forceinline__ unsigned xb_add(unsigned* p, unsigned v) { return __hip_atomic_fetch_add(p, v, __ATOMIC_RELAXED, __HIP_MEMORY_SCOPE_AGENT); }
__device__ __forceinline__ unsigned xb_xcc_id() { return (unsigned)__builtin_amdgcn_s_getreg((3 << 11) | 20) & 0xFu; }
#define XB_SPIN(cond, bar) do { unsigned _sp = 0; while (cond) { __builtin_amdgcn_s_sleep(1); \
    if ((++_sp & 255u) == 0u) { if (xb_ld(&(bar)[XB_TMO])) break; if (_sp > XB_SPIN_CAP) { atomicAdd(&(bar)[XB_TMO], 1u); break; } } } } while (0)
struct XcdBarrier { unsigned* bar; unsigned x; volatile LAS unsigned* st; };
__device__ __forceinline__ XcdBarrier xcd_barrier_post(unsigned* bar, volatile LAS unsigned* st, int tid) {
    XcdBarrier b; b.bar = bar; b.x = xb_xcc_id(); b.st = st;
    if (tid == 0) (void)xb_add(&bar[XB_XCNT(b.x)], 1u);
    return b;
}
__device__ __forceinline__ void xcd_barrier_complete(unsigned* bar, unsigned x, unsigned G, unsigned& nloc, unsigned& nx) {
    unsigned sum, cnt, mine, sp = 0u;
    for (;;) {
        sum = 0u; cnt = 0u; mine = 0u;
#pragma unroll
        for (unsigned j = 0; j < 16; ++j) { const unsigned c = xb_ld(&bar[XB_XCNT(j)]); sum += c; cnt += (c > 0u) ? 1u : 0u; mine = (j == x) ? c : mine; }
        if (sum == G) break;
        __builtin_amdgcn_s_sleep(1);
        if ((++sp & 255u) == 0u) { if (xb_ld(&bar[XB_TMO])) break; if (sp > XB_SPIN_CAP) { atomicAdd(&bar[XB_TMO], 1u); break; } }
    }
    nloc = mine > 0u ? mine : 1u; nx = cnt > 0u ? cnt : 1u;
}
__device__ __forceinline__ void xcd_barrier(const XcdBarrier& b, int tid, unsigned G) {
    asm volatile("s_waitcnt vmcnt(0)" ::: "memory");
    __syncthreads();
    if (tid == 0) {
        unsigned* bar = b.bar;
        __builtin_amdgcn_s_waitcnt(0);
        unsigned nloc = b.st[0], nx = b.st[1];
        if (nloc == 0u) { xcd_barrier_complete(bar, b.x, G, nloc, nx); b.st[0] = nloc; b.st[1] = nx; }
        const unsigned old = xb_add(&bar[XB_XSUB(b.x)], 1u);
        const unsigned gen = old / nloc;
        if (old + 1u == (gen + 1u) * nloc) {
            __builtin_amdgcn_fence(__ATOMIC_RELEASE, "agent");
            asm volatile("s_waitcnt vmcnt(0)" ::: "memory");
            const unsigned og = xb_add(&bar[XB_TOP], 1u);
            const unsigned tg = og / nx;
            if (og + 1u == (tg + 1u) * nx) xb_add(&bar[XB_TOPGEN], 1u);
            else XB_SPIN(xb_ld(&bar[XB_TOPGEN]) == tg, bar);
            __builtin_amdgcn_fence(__ATOMIC_ACQUIRE, "agent");
            xb_add(&bar[XB_XGEN(b.x)], 1u);
            asm volatile("s_waitcnt vmcnt(0)" ::: "memory");
        } else {
            XB_SPIN(xb_ld(&bar[XB_XGEN(b.x)]) == gen, bar);
            __builtin_amdgcn_fence(__ATOMIC_ACQUIRE, "agent");
            asm volatile("s_waitcnt vmcnt(0)" ::: "memory");
        }
    }
    __syncthreads();
}

struct Frame {
    LAS unsigned char* lds; unsigned char* ldsg;
    int tid, lane, wave, vcu, G;
    const float *x, *g_mix, *w_in, *w_pa, *w_pb, *w_out, *g_ffn, *w_group, *b_group, *w_expert, *b_expert, *w1, *w3, *w2, *g_final;
    float* out; unsigned char* ws;
};

__device__ __forceinline__ int lane_id_v() { int l; asm volatile("v_mbcnt_lo_u32_b32 %0, -1, 0\n\tv_mbcnt_hi_u32_b32 %0, -1, %0" : "=v"(l)); return l; }
__device__ __forceinline__ float wave_sum(float v) {
    { const int t = __builtin_amdgcn_update_dpp(0, __float_as_int(v), 0xB1, 0xF, 0xF, false); v += __int_as_float(t); }
    { const int t = __builtin_amdgcn_update_dpp(0, __float_as_int(v), 0x4E, 0xF, 0xF, false); v += __int_as_float(t); }
    { const int t = __builtin_amdgcn_update_dpp(0, __float_as_int(v), 0x141, 0xF, 0xF, false); v += __int_as_float(t); }
    { const int t = __builtin_amdgcn_update_dpp(0, __float_as_int(v), 0x140, 0xF, 0xF, false); v += __int_as_float(t); }
    const int b = __float_as_int(v);
    return (__int_as_float(__builtin_amdgcn_readlane(b, 0)) + __int_as_float(__builtin_amdgcn_readlane(b, 16))) + (__int_as_float(__builtin_amdgcn_readlane(b, 32)) + __int_as_float(__builtin_amdgcn_readlane(b, 48)));
}

struct P0Item { const float* sp; const float* kscale; bf16* WT; unsigned sstride; int K, nrow0, k0; float mulz; float f8scale; };
__device__ __forceinline__ void p0_load(const P0Item& d, int lane, float (&v)[32], f32x4& g0, f32x4& g1) {
    const int c = lane & 7; g0 = (f32x4){1.f, 1.f, 1.f, 1.f}; g1 = g0;
    if (d.kscale) { g0 = *(const GAS f32x4*)(d.kscale + d.k0 + 8 * c); g1 = *(const GAS f32x4*)(d.kscale + d.k0 + 8 * c + 4); }
#pragma unroll
    for (int i = 0; i < 32; ++i) { const int kk = 2 * i + (lane >> 5); v[i] = d.sp[(size_t)(d.k0 + kk) * d.sstride]; }
}
__device__ __forceinline__ void p0_finish(const P0Item& d, int lane, const float (&v)[32], LAS float* scr, f32x4 g0, f32x4 g1) {
#pragma unroll
    for (int i = 0; i < 32; ++i) { const int kk = 2 * i + (lane >> 5); scr[kk * 33 + (lane & 31)] = v[i] * d.mulz; }
    LDS_WAIT(); asm volatile("" ::: "memory");
    const int c = lane & 7;
    if (d.f8scale != 0.f) { g0 = g0 * d.f8scale; g1 = g1 * d.f8scale;
#pragma unroll
        for (int j = 0; j < 4; ++j) { const int n = (lane >> 3) + 8 * j; const LAS float* s = scr + (8 * c) * 33 + n;
            v2u o; o.x = pg8::cvt4_fp8(s[0 * 33] * g0[0], s[1 * 33] * g0[1], s[2 * 33] * g0[2], s[3 * 33] * g0[3]); o.y = pg8::cvt4_fp8(s[4 * 33] * g1[0], s[5 * 33] * g1[1], s[6 * 33] * g1[2], s[7 * 33] * g1[3]);
            *(GAS v2u*)((unsigned char*)d.WT + (size_t)(d.nrow0 + n) * d.K + d.k0 + 8 * c) = o; }
        LDS_WAIT(); asm volatile("" ::: "memory"); return; }
#pragma unroll
    for (int j = 0; j < 4; ++j) { const int n = (lane >> 3) + 8 * j; const LAS float* s = scr + (8 * c) * 33 + n;
        v4u o; o.x = pk2(s[0 * 33] * g0[0], s[1 * 33] * g0[1]); o.y = pk2(s[2 * 33] * g0[2], s[3 * 33] * g0[3]); o.z = pk2(s[4 * 33] * g1[0], s[5 * 33] * g1[1]); o.w = pk2(s[6 * 33] * g1[2], s[7 * 33] * g1[3]);
        *(GAS v4u*)(d.WT + (size_t)(d.nrow0 + n) * d.K + d.k0 + 8 * c) = o; }
    LDS_WAIT(); asm volatile("" ::: "memory");
}
__device__ __forceinline__ int cmap_in(int np) {
    const int tile = np >> 8, sl = np & 255, bj = sl >> 7, wc = (sl >> 5) & 3, rho = sl & 31;
    if (tile < 14) { const int seg = tile >> 1;
        if (seg == 2 || seg == 5) return (np & ~255) + pg8::perm16(sl);
        return (np & ~255) + 64 * wc + 32 * bj + pg8::perm32(rho); }
    if (tile == 14) { if (wc == 0) return 3584 + 32 * bj + pg8::perm32(rho); if (bj == 0 && wc == 1 && rho < 8) return 3648 + rho; return -1; }
    return 3656 + (tile - 15) * 256 + pg8::perm16(sl);
}
__device__ const double INV_FREQ[32] = {1.0, 0.7498942093324559, 0.5623413251903491, 0.4216965034285822, 0.31622776601683794, 0.23713737056616552, 0.1778279410038923, 0.1333521432163324, 0.09999999999999999, 0.07498942093324558, 0.056234132519034905, 0.042169650342858224, 0.03162277660168379, 0.023713737056616554, 0.01778279410038923, 0.013335214321633239, 0.01, 0.007498942093324559, 0.005623413251903491, 0.004216965034285822, 0.0031622776601683794, 0.002371373705661655, 0.0017782794100389228, 0.0013335214321633238, 0.001, 0.0007498942093324559, 0.000562341325190349, 0.00042169650342858224, 0.00031622776601683794, 0.00023713737056616554, 0.0001778279410038923, 0.0001333521432163324};
__device__ __forceinline__ void sincos_d(double a, float& c, float& s) {
    const double TWO_OVER_PI = 0.63661977236758134308, PIO2_HI = 1.57079632679489655800e+00, PIO2_LO = 6.12323399573676603587e-17;
    const double kf = __builtin_rint(a * TWO_OVER_PI); const long k = (long)kf;
    const double y = (a - kf * PIO2_HI) - kf * PIO2_LO, y2 = y * y;
    const double sp = y * (1.0 + y2 * (-1.0 / 6 + y2 * (1.0 / 120 + y2 * (-1.0 / 5040 + y2 * (1.0 / 362880 + y2 * (-1.0 / 39916800 + y2 * (1.0 / 6227020800.0)))))));
    const double cp = 1.0 + y2 * (-0.5 + y2 * (1.0 / 24 + y2 * (-1.0 / 720 + y2 * (1.0 / 40320 + y2 * (-1.0 / 3628800 + y2 * (1.0 / 479001600.0 + y2 * (-1.0 / 87178291200.0)))))));
    double sv, cv; switch (k & 3) { case 0: sv = sp; cv = cp; break; case 1: sv = cp; cv = -sp; break; case 2: sv = -sp; cv = -cp; break; default: sv = -cp; cv = sp; break; }
    c = (float)cv; s = (float)sv;
}

__device__ __forceinline__ void p0_prologue(Frame& F) {
    unsigned char* ws = F.ws;
    LAS float* scr = (LAS float*)(F.lds + F.wave * 16384);
    const int gw = F.vcu * NWAVES + F.wave, NGW = F.G * NWAVES, lane = F.lane;
    bf16* WinT = (bf16*)(ws + WS_WIN); bf16* WaT = (bf16*)(ws + WS_WA); bf16* WbT = (bf16*)(ws + WS_WB); bf16* WoutT = (bf16*)(ws + WS_WOUT);
    bf16* W13T = (bf16*)(ws + WS_W13); bf16* W2T = (bf16*)(ws + WS_W2);
    constexpr int I_INA = 16 * (NINA / 32), I_INB = 16 * (NINB / 32), I_IN = I_INA + I_INB, I_PA = 8 * 32, I_OUT = 16 * 32, I_13 = 16 * 32 * NEXP, I_2 = 8 * 32 * NEXP;
    constexpr int NITEMS = I_IN + 2 * I_PA + I_OUT;
    (void)I_13; (void)I_2; (void)W13T; (void)W2T;
    auto decode = [&](int it) -> P0Item { P0Item d; d.mulz = 1.0f; d.kscale = nullptr; d.f8scale = 0.f; int r = it;
        if (r < I_IN) { const int part = r >= I_INA ? 1 : 0; if (part) r -= I_INA; const int ng = (part ? NINB : NINA) / 32, nb = r % ng, kb = r / ng;
            const int col = cmap_in(pg8::in_tile_of(part, nb >> 3) * 256 + (nb & 7) * 32 + (lane & 31));
            d.sp = F.w_in + (col >= 0 ? col : 0); d.mulz = col >= 0 ? 1.0f : 0.0f; d.sstride = IN_COLS; d.kscale = F.g_mix; d.K = DMODEL; d.nrow0 = nb * 32; d.k0 = kb * 64;
            if (part) { d.WT = (bf16*)(ws + WS_WIN8); d.f8scale = 32.0f; } else d.WT = WinT; return d; } r -= I_IN;
        if (r < 2 * I_PA) { const bool second = r >= I_PA; if (second) r -= I_PA; const int nb = r % 32, kb = r / 32; const int col = (nb >> 3) * 256 + pg8::perm16((nb & 7) * 32 + (lane & 31));
            d.sp = (second ? F.w_pb : F.w_pa) + col; d.sstride = DMODEL; d.WT = second ? WbT : WaT; d.K = HW; d.f8scale = 16.0f; d.nrow0 = nb * 32; d.k0 = kb * 64; return d; } r -= 2 * I_PA;
        if (r < I_OUT) { const int nb = r % 32, kb = r / 32; d.sp = F.w_out + (nb >> 3) * 256 + pg8::perm16((nb & 7) * 32 + (lane & 31)); d.sstride = DMODEL; d.WT = WoutT; d.K = DMODEL; d.f8scale = 32.0f; d.nrow0 = nb * 32; d.k0 = kb * 64; return d; } r -= I_OUT;
        return d; };
    if (gw < NITEMS) { P0Item dA = decode(gw), dB = dA; float vA[32], vB[32]; f32x4 gA0, gA1, gB0, gB1; p0_load(dA, lane, vA, gA0, gA1);
        for (int it = gw;;) {
            const int itB = it + NGW; const bool hasB = itB < NITEMS; if (hasB) { dB = decode(itB); p0_load(dB, lane, vB, gB0, gB1); }
            p0_finish(dA, lane, vA, scr, gA0, gA1); if (!hasB) break;
            const int itA = itB + NGW; const bool hasA = itA < NITEMS; if (hasA) { dA = decode(itA); p0_load(dA, lane, vA, gA0, gA1); }
            p0_finish(dB, lane, vB, scr, gB0, gB1); if (!hasA) break;
            it = itA; } }
    { bf16* Wh = (bf16*)(ws + WS_WR); bf16* Wl = Wh + 48 * DMODEL;
      for (int i = (F.vcu * NWAVES * 64) + F.tid; i < 48 * DMODEL; i += F.G * NWAVES * 64) { const int n = i / DMODEL, k = i % DMODEL;
          float w = 0.f; if (n < 4) w = F.w_group[k * 4 + n]; else if (n < 36) w = F.w_expert[k * 32 + (n - 4)]; w *= F.g_ffn[k];
          const unsigned h = f2bf(w); const float lo = w - bf2f(h); Wh[i] = (bf16)h; Wl[i] = (bf16)f2bf(lo);
          ((unsigned char*)(ws + WS_WR8))[i] = (unsigned char)(pg8::cvt4_fp8(lo * 16384.0f, 0.f, 0.f, 0.f) & 0xffu); } }
    { bf16* XB = (bf16*)(ws + WS_XB); float* irstd1 = (float*)(ws + WS_RSTD1);
#define P0X_LOAD(V, M0) do { _Pragma("unroll") for (int r = 0; r < 4; ++r) { const GAS f32x4* xr = (const GAS f32x4*)(F.x + (size_t)((M0) + r) * DMODEL) + lane; \
          _Pragma("unroll") for (int j = 0; j < 4; ++j) V[r][j] = xr[64 * j]; } } while (0)
#define P0X_DONE(V, M0) do { _Pragma("unroll") for (int r = 0; r < 4; ++r) { float s = 0.f; \
          _Pragma("unroll") for (int j = 0; j < 4; ++j) s += (V[r][j].x * V[r][j].x + V[r][j].y * V[r][j].y) + (V[r][j].z * V[r][j].z + V[r][j].w * V[r][j].w); \
          s = wave_sum(s); const float irs = sqrtf(s * (1.0f / DMODEL) + RMS_EPS), rs = 1.0f / irs; if (lane == 0) irstd1[(M0) + r] = irs; \
          GAS unsigned long long* o8 = (GAS unsigned long long*)(XB + (size_t)((M0) + r) * DMODEL) + lane; GAS unsigned* q8 = (GAS unsigned*)(ws + WS_X8 + (size_t)((M0) + r) * DMODEL) + lane; \
          _Pragma("unroll") for (int j = 0; j < 4; ++j) { const f32x4 w = V[r][j] * rs; \
              o8[64 * j] = (unsigned long long)pk2(w.x, w.y) | ((unsigned long long)pk2(w.z, w.w) << 32); q8[64 * j] = pg8::cvt4_fp8(w.x, w.y, w.z, w.w); } } } while (0)
      const int mstep = NGW * 4; int m0 = gw * 4;
      if (m0 < T) { f32x4 va[4][4], vb[4][4]; P0X_LOAD(va, m0);
          for (;;) {
              const int m1 = m0 + mstep; const bool h1 = m1 < T; if (h1) P0X_LOAD(vb, m1);
              P0X_DONE(va, m0); if (!h1) break;
              const int m2 = m1 + mstep; const bool h2 = m2 < T; if (h2) P0X_LOAD(va, m2);
              P0X_DONE(vb, m1); if (!h2) break;
              m0 = m2; } }
#undef P0X_LOAD
#undef P0X_DONE
    }
}

__device__ __forceinline__ void p2_kbsum(Frame& F) {
    const bf16* KA = (const bf16*)(F.ws + WS_KA); float* kbsum = (float*)(F.ws + WS_KBSUM);
    const int gw = F.vcu * NWAVES + F.wave, NGW = F.G * NWAVES, lane = F.lane;
    for (int it = gw; it < NBATCH * NHEAD * 8; it += NGW) { const int j = it & 7, h = (it >> 3) & 7, b = it >> 6;
        const bf16* base = KA + ((size_t)(b * SEQ + j * 256 + (lane >> 3))) * HW + h * 64 + (lane & 7) * 8; float s[8];
#pragma unroll
        for (int k = 0; k < 8; ++k) s[k] = 0.f;
#pragma unroll 4
        for (int i = 0; i < 32; ++i) { const v4u w = *(const GAS v4u*)(base + (size_t)i * 8 * HW);
#pragma unroll
            for (int k = 0; k < 4; ++k) { s[2 * k] += bf2f(w[k] & 0xffffu); s[2 * k + 1] += __uint_as_float(w[k] & 0xffff0000u); } }
#pragma unroll
        for (int k = 0; k < 8; ++k) { s[k] += __shfl_xor(s[k], 8); s[k] += __shfl_xor(s[k], 16); s[k] += __shfl_xor(s[k], 32); }
        if (lane < 8) { float* o = kbsum + (size_t)it * 64 + lane * 8; *(f32x4*)o = (f32x4){s[0], s[1], s[2], s[3]}; *(f32x4*)(o + 4) = (f32x4){s[4], s[5], s[6], s[7]}; } }
}

__device__ __forceinline__ int wsum6(int c) { int tot = 0;
#pragma unroll
    for (int b = 0; b < 6; ++b) tot += __popcll(__ballot((c >> b) & 1)) << b;
    return tot; }
__device__ __forceinline__ int sel_cnt_ge(const unsigned (&key)[32], int nq, unsigned cand) { int c = 0;
    const unsigned cs = (unsigned)__builtin_amdgcn_readfirstlane((int)cand);
#pragma unroll
    for (int q = 0; q < 8; ++q) { if (q < nq) { unsigned long long m0, m1, m2, m3;
        asm volatile("v_cmp_le_u32_e64 %0, %4, %5\n\tv_cmp_le_u32_e64 %1, %4, %6\n\tv_cmp_le_u32_e64 %2, %4, %7\n\tv_cmp_le_u32_e64 %3, %4, %8"
                     : "=&s"(m0), "=&s"(m1), "=&s"(m2), "=&s"(m3) : "s"(cs), "v"(key[4 * q]), "v"(key[4 * q + 1]), "v"(key[4 * q + 2]), "v"(key[4 * q + 3]));
        c += (__popcll(m0) + __popcll(m1)) + (__popcll(m2) + __popcll(m3)); } }
    return c; }
#define SEL_CMP4(q) asm volatile("v_cmp_le_u32_e64 %0, %4, %5\n\tv_cmp_le_u32_e64 %1, %4, %6\n\tv_cmp_le_u32_e64 %2, %4, %7\n\tv_cmp_le_u32_e64 %3, %4, %8" \
        : "=&s"(m[q][0]), "=&s"(m[q][1]), "=&s"(m[q][2]), "=&s"(m[q][3]) : "s"(cs), "v"(key[4 * (q)]), "v"(key[4 * (q) + 1]), "v"(key[4 * (q) + 2]), "v"(key[4 * (q) + 3]))
template <int NQ> __device__ __forceinline__ int sel_cnt_ge_t(const unsigned (&key)[32], unsigned cand) {
    const unsigned cs = (unsigned)__builtin_amdgcn_readfirstlane((int)cand); unsigned long long m[NQ][4]; int c = 0;
    SEL_CMP4(0);
#pragma unroll
    for (int q = 0; q < NQ; ++q) { if (q + 1 < NQ) SEL_CMP4(q + 1); c += (__popcll(m[q][0]) + __popcll(m[q][1])) + (__popcll(m[q][2]) + __popcll(m[q][3])); }
    return c; }
template <int NQ> __device__ __forceinline__ void sel_bisect_full(const unsigned (&key)[32], const unsigned M, unsigned& lo, unsigned& hi, int& clo, int& chi, bool& exact) {
    { const unsigned lo0 = (M > (4u << 23)) ? M - (4u << 23) : 0u;
      if (lo0 > 0u) { const int c0 = sel_cnt_ge_t<NQ>(key, lo0); if (c0 >= 256) { lo = lo0; clo = c0; exact = (c0 == 256); } else { hi = lo0; chi = c0; } } }
#pragma unroll 1
    while (!exact && hi - lo > 1u && clo - chi > 64) { const unsigned mid = lo + ((hi - lo) >> 1);
        const int tot = sel_cnt_ge_t<NQ>(key, mid);
        if (tot >= 256) { lo = mid; clo = tot; exact = (tot == 256); } else { hi = mid; chi = tot; } }
}
__device__ __forceinline__ int sel_cnt_eq_lt(const unsigned (&key)[32], int nq, unsigned val, int cx, int lane) { int c = 0;
#pragma unroll
    for (int q = 0; q < 8; ++q) { if (q < nq) {
#pragma unroll
        for (int k = 0; k < 4; ++k) c += __popcll(__ballot(key[4 * q + k] == val && (64 * (4 * q + k) + lane) < cx)); } }
    return c; }
__device__ __forceinline__ unsigned wave_max_u32(unsigned v) {
    int x = (int)v;
    { const int t = __builtin_amdgcn_update_dpp(x, x, 0xB1, 0xF, 0xF, false); x = (int)max((unsigned)x, (unsigned)t); }
    { const int t = __builtin_amdgcn_update_dpp(x, x, 0x4E, 0xF, 0xF, false); x = (int)max((unsigned)x, (unsigned)t); }
    { const int t = __builtin_amdgcn_update_dpp(x, x, 0x141, 0xF, 0xF, false); x = (int)max((unsigned)x, (unsigned)t); }
    { const int t = __builtin_amdgcn_update_dpp(x, x, 0x140, 0xF, 0xF, false); x = (int)max((unsigned)x, (unsigned)t); }
    const unsigned a = (unsigned)__builtin_amdgcn_readlane(x, 0), b = (unsigned)__builtin_amdgcn_readlane(x, 16), c = (unsigned)__builtin_amdgcn_readlane(x, 32), d = (unsigned)__builtin_amdgcn_readlane(x, 48);
    return max(max(a, b), max(c, d));
}
struct SelStep { int b, g, half; };
__device__ __forceinline__ void sel_load_q(Frame& F, const SelStep st, bf16x8 (&bq)[8][2], float (&w8)[8]) {
    const bf16* QI = (const bf16*)(F.ws + WS_QI); const float* WI = (const float*)(F.ws + WS_WI);
    const int qidx = F.lane & 15, kc = F.lane >> 4; const size_t qrow = (size_t)(st.b * SEQ + st.g * 32 + st.half * 16 + qidx);
#pragma unroll
    for (int h = 0; h < 8; ++h) {
#pragma unroll
        for (int ks = 0; ks < 2; ++ks) bq[h][ks] = *(const GAS bf16x8*)(QI + qrow * HW + h * 64 + ks * 32 + kc * 8); }
    const f32x4 a = *(const GAS f32x4*)(WI + qrow * 8), c = *(const GAS f32x4*)(WI + qrow * 8 + 4); w8[0] = a[0]; w8[1] = a[1]; w8[2] = a[2]; w8[3] = a[3]; w8[4] = c[0]; w8[5] = c[1]; w8[6] = c[2]; w8[7] = c[3];
}
__device__ __forceinline__ void sel_stage_q(Frame& F, const SelStep st) {
    const size_t qrow0 = (size_t)(st.b * SEQ + st.g * 32 + st.half * 16); const unsigned lds0 = (unsigned)(uintptr_t)F.lds;
#pragma unroll
    for (int rr = 0; rr < 2; ++rr) { const int row = 2 * F.wave + rr;
        attn_body::glds16((const char*)(F.ws + WS_QI) + (qrow0 + row) * (HW * 2) + F.lane * 16, (unsigned)__builtin_amdgcn_readfirstlane((int)(lds0 + QSTG_OFF + row * QSTG_STRIDE))); }
    if (F.wave == 0 && F.lane < 32) attn_body::glds16((const char*)(F.ws + WS_WI) + qrow0 * 32 + F.lane * 16, (unsigned)__builtin_amdgcn_readfirstlane((int)(lds0 + WSTG_OFF)));
}
__device__ __forceinline__ void sel_load_q_lds(Frame& F, bf16x8 (&bq)[8][2], float (&w8)[8]) {
    const int qidx = F.lane & 15, kc = F.lane >> 4; LAS char* q = (LAS char*)(F.lds + QSTG_OFF + qidx * QSTG_STRIDE + kc * 16);
#pragma unroll
    for (int h = 0; h < 8; ++h) {
#pragma unroll
        for (int ks = 0; ks < 2; ++ks) bq[h][ks] = *(const LAS bf16x8*)(q + h * 128 + ks * 64); }
    const f32x4 a = *(const LAS f32x4*)(F.lds + WSTG_OFF + qidx * 32), c = *(const LAS f32x4*)(F.lds + WSTG_OFF + qidx * 32 + 16); w8[0] = a[0]; w8[1] = a[1]; w8[2] = a[2]; w8[3] = a[3]; w8[4] = c[0]; w8[5] = c[1]; w8[6] = c[2]; w8[7] = c[3];
}
__device__ __forceinline__ void sel_loadg0(Frame& F, const SelStep st, bf16x8 (&A0)[4], bf16x8 (&A1)[4]) {
    const bf16* KI = (const bf16*)(F.ws + WS_KI); const int qidx = F.lane & 15, kc = F.lane >> 4;
    const int ntg = __builtin_amdgcn_readfirstlane((st.g + 2) >> 1), nsub = ntg * 4;
#pragma unroll
    for (int u = 0; u < 4; ++u) { int st_ = F.wave + 8 * u; st_ = st_ < nsub ? st_ : nsub - 1;
        const bf16* kp_ = KI + (size_t)(st.b * SEQ + st_ * 16 + qidx) * 64 + kc * 8; A0[u] = *(const GAS bf16x8*)kp_; A1[u] = *(const GAS bf16x8*)(kp_ + 32); }
}
__device__ __forceinline__ void sel_scores(Frame& F, const SelStep st, const bf16x8 (&bq)[8][2], const float (&w8)[8], const bf16x8 (&P0)[4], const bf16x8 (&P1)[4]) {
    const bf16* KI = (const bf16*)(F.ws + WS_KI); LAS float* sc = (LAS float*)F.lds;
    const int lane = F.lane, wave = F.wave, qidx = lane & 15, kc = lane >> 4, b = st.b;
    const int ntg = __builtin_amdgcn_readfirstlane((st.g + 2) >> 1), nsub = ntg * 4;
    const int nit = (nsub + 7) >> 3, ngrp = (nit + 3) >> 2;
    bf16x8 A0[4], A1[4], B0[4], B1[4];
#define SEL_LOADG(X0, X1, gi) do { _Pragma("unroll") for (int u = 0; u < 4; ++u) { int st_ = wave + 8 * (4 * (gi) + u); st_ = st_ < nsub ? st_ : nsub - 1; \
        const bf16* kp_ = KI + (size_t)(b * SEQ + st_ * 16 + qidx) * 64 + kc * 8; X0[u] = *(const GAS bf16x8*)kp_; X1[u] = *(const GAS bf16x8*)(kp_ + 32); } } while (0)
#define SEL_COMPG(X0, X1, gi) do { _Pragma("unroll") for (int u = 0; u < 4; ++u) { const int st_ = wave + 8 * (4 * (gi) + u); if (st_ < nsub) { f32x4 s_ = {0.f, 0.f, 0.f, 0.f}; \
        _Pragma("unroll") for (int h = 0; h < 8; ++h) { f32x4 d_ = __builtin_amdgcn_mfma_f32_16x16x32_bf16(X0[u], bq[h][0], (f32x4){0.f, 0.f, 0.f, 0.f}, 0, 0, 0); \
            d_ = __builtin_amdgcn_mfma_f32_16x16x32_bf16(X1[u], bq[h][1], d_, 0, 0, 0); \
            _Pragma("unroll") for (int k = 0; k < 4; ++k) s_[k] += w8[h] * __int_as_float(max(__float_as_int(d_[k]), 0)); }   \
        *(LAS f32x4*)(sc + qidx * SC_STRIDE + st_ * 16 + 4 * kc) = s_; } } } while (0)
#pragma unroll
    for (int u = 0; u < 4; ++u) { A0[u] = P0[u]; A1[u] = P1[u]; }
    for (int gi = 0; gi < ngrp; gi += 2) {
        if (gi + 1 < ngrp) SEL_LOADG(B0, B1, gi + 1);
        SEL_COMPG(A0, A1, gi);
        if (gi + 1 < ngrp) { if (gi + 2 < ngrp) SEL_LOADG(A0, A1, gi + 2); SEL_COMPG(B0, B1, gi + 1); }
    }
#undef SEL_LOADG
#undef SEL_COMPG
}
__device__ __forceinline__ void sel_rows(Frame& F, const SelStep st) {
    unsigned long long* maskw = (unsigned long long*)(F.ws + WS_MASK); LAS float* sc = (LAS float*)F.lds;
    const int lane = F.lane, wave = F.wave, b = st.b;
    const int ntg = __builtin_amdgcn_readfirstlane((st.g + 2) >> 1), nq = (ntg + 3) >> 2; const int qh = st.g * 32 + st.half * 16;
    LAS int* rowctr = (LAS int*)(F.lds + MISC_OFF + 3072);
    for (;;) { int row_ = 0; if (lane == 0) row_ = __hip_atomic_fetch_add(rowctr, 1, __ATOMIC_RELAXED, __HIP_MEMORY_SCOPE_WORKGROUP);
        const int row = __builtin_amdgcn_readfirstlane(row_); if (row >= 16) break;
        const int t = __builtin_amdgcn_readfirstlane(qh + row);
        unsigned key[32]; unsigned mx = 0u;
#pragma unroll
        for (int q = 0; q < 8; ++q) {
#pragma unroll
            for (int k = 0; k < 4; ++k) key[4 * q + k] = 0u;
            if (q < nq) {
#pragma unroll
                for (int k = 0; k < 4; ++k) { const int j = 4 * q + k; const float v = sc[row * SC_STRIDE + 64 * j + lane]; const unsigned u = __float_as_uint(v);
                    const unsigned kk = u ^ ((unsigned)((int)u >> 31) | 0x80000000u);        key[j] = (64 * j + lane <= t) ? kk : 0u; mx = max(mx, key[j]); } } }
        const unsigned M = wave_max_u32(mx);
        unsigned lo = 0u, hi = M + 1u; int clo = 1 << 20, chi = 0; bool exact = false;
        switch (nq) { case 2: sel_bisect_full<2>(key, M, lo, hi, clo, chi, exact); break; case 3: sel_bisect_full<3>(key, M, lo, hi, clo, chi, exact); break;
            case 4: sel_bisect_full<4>(key, M, lo, hi, clo, chi, exact); break; case 5: sel_bisect_full<5>(key, M, lo, hi, clo, chi, exact); break;
            case 6: sel_bisect_full<6>(key, M, lo, hi, clo, chi, exact); break; case 7: sel_bisect_full<7>(key, M, lo, hi, clo, chi, exact); break;
            default: sel_bisect_full<8>(key, M, lo, hi, clo, chi, exact); break; }
        if (!exact && hi - lo > 1u) {
            LAS unsigned* cb = (LAS unsigned*)(sc + row * SC_STRIDE); int base = 0; const unsigned wdt = hi - lo;
#pragma unroll
            for (int q = 0; q < 8; ++q) { if (q < nq) {
#pragma unroll
                for (int k = 0; k < 4; ++k) { const int j = 4 * q + k; const bool inb = (key[j] - lo) < wdt; const unsigned long long m = __ballot(inb);
                    const int pos = base + (int)__builtin_amdgcn_mbcnt_hi((unsigned)(m >> 32), __builtin_amdgcn_mbcnt_lo((unsigned)m, 0u));
                    cb[inb ? pos : 64 + lane] = key[j]; base += __popcll(m); } } }
            LDS_WAIT(); asm volatile("" ::: "memory");
            unsigned cand = cb[lane]; LDS_WAIT(); cand = (lane < base) ? cand : 0u;
#pragma unroll 1
            while (!exact && hi - lo > 1u) { const unsigned mid = lo + ((hi - lo) >> 1);
                const int tot = chi + __popcll(__ballot(cand >= mid));
                if (tot >= 256) { lo = mid; exact = (tot == 256); } else hi = mid; } }
        unsigned P; int xcut;
        if (exact) { P = lo - 1u; xcut = -1; }
        else {
            const int need = 256 - sel_cnt_ge(key, nq, lo + 1u); int xx = 0;
#pragma unroll 1
            for (int bit = 10; bit >= 0; --bit) { const int cx = xx | (1 << bit);
                if (sel_cnt_eq_lt(key, nq, lo, cx, lane) < need) xx = cx; }
            P = lo; xcut = xx; }
        int mlo = 0, mhi = 0;
        if (exact) {
            const unsigned cs = (unsigned)__builtin_amdgcn_readfirstlane((int)lo); unsigned long long m[8][4];
#define SEL_WL(q, k) do { const int a_ = (int)(unsigned)m[q][k], b_ = (int)(unsigned)(m[q][k] >> 32); \
                asm volatile("v_writelane_b32 %0, %1, %2" : "+v"(mlo) : "s"(a_), "n"(4 * (q) + (k))); asm volatile("v_writelane_b32 %0, %1, %2" : "+v"(mhi) : "s"(b_), "n"(4 * (q) + (k))); } while (0)
#define SEL_EX4(q) do { if ((q) < nq) { SEL_CMP4(q); SEL_WL(q, 0); SEL_WL(q, 1); SEL_WL(q, 2); SEL_WL(q, 3); } } while (0)
            SEL_EX4(0); SEL_EX4(1); SEL_EX4(2); SEL_EX4(3); SEL_EX4(4); SEL_EX4(5); SEL_EX4(6); SEL_EX4(7);
#undef SEL_EX4
#undef SEL_WL
        } else {
#define SEL_EMIT(j) do { const bool al = (key[j] > P) || (key[j] == P && (64 * (j) + lane) <= xcut); \
            const unsigned long long m = __ballot(al); const int m0_ = (int)(unsigned)m, m1_ = (int)(unsigned)(m >> 32); \
            asm volatile("v_writelane_b32 %0, %1, %2" : "+v"(mlo) : "s"(m0_), "n"(j)); asm volatile("v_writelane_b32 %0, %1, %2" : "+v"(mhi) : "s"(m1_), "n"(j)); } while (0)
#define SEL_EMIT4(q) do { if ((q) < nq) { SEL_EMIT(4 * (q)); SEL_EMIT(4 * (q) + 1); SEL_EMIT(4 * (q) + 2); SEL_EMIT(4 * (q) + 3); } } while (0)
        SEL_EMIT4(0); SEL_EMIT4(1); SEL_EMIT4(2); SEL_EMIT4(3); SEL_EMIT4(4); SEL_EMIT4(5); SEL_EMIT4(6); SEL_EMIT4(7);
#undef SEL_EMIT4
#undef SEL_EMIT
        }
        if (lane < 32) maskw[(size_t)(b * SEQ + t) * 32 + lane] = ((unsigned long long)(unsigned)mhi << 32) | (unsigned long long)(unsigned)mlo;
    }
}
constexpr int MW_I13 = 16 * 32 * NEXP, MW_I2 = 8 * 32 * NEXP, MW_ITEMS = MW_I13 + MW_I2;
struct MwItem { const float* sp; unsigned sstride; unsigned char* wt; const float* ks; float f8; };
__device__ __forceinline__ MwItem mw_decode(Frame& F, int it, int lane) { MwItem d; asm volatile("" : "+v"(lane));
    const int h = lane >> 5;
    if (it < MW_I13) { const int e = it / 512, r = it % 512, nb = r % 32, kb = r / 32;
        d.sp = (((nb >> 2) & 1) ? F.w3 : F.w1) + (size_t)e * DMODEL * EFF + 128 * (nb >> 3) + 32 * (nb & 3) + pg8::perm32(lane & 31) + (size_t)(kb * 64 + 32 * h) * EFF; d.sstride = EFF;
        d.wt = F.ws + WS_W13 + (size_t)e * 1024 * DMODEL + (size_t)(nb * 32 + (lane & 31)) * DMODEL + kb * 64 + 32 * h; d.ks = F.g_ffn + kb * 64; d.f8 = 32.0f; }
    else { const int r0 = it - MW_I13, e = r0 / 256, r = r0 % 256, nb = r % 32, kb = r / 32; const int col = (nb >> 3) * 256 + pg8::perm16((nb & 7) * 32 + (lane & 31));
        d.sp = F.w2 + (size_t)e * EFF * DMODEL + col + (size_t)(kb * 64 + 32 * h) * DMODEL; d.sstride = DMODEL;
        d.wt = F.ws + WS_W2 + (size_t)e * DMODEL * EFF + (size_t)(nb * 32 + (lane & 31)) * EFF + kb * 64 + 32 * h; d.ks = nullptr; d.f8 = 16.0f; }
    return d; }
__device__ __forceinline__ void mw_load(const MwItem& d, int lane, float (&v)[32], float& gv) {
#pragma unroll
    for (int i = 0; i < 32; ++i) v[i] = d.sp[(size_t)i * d.sstride];
    gv = d.ks ? d.ks[lane] : 1.0f; }
__device__ __forceinline__ void mw_finish(const MwItem& d, int lane, const float (&v)[32], float gv) {
    asm volatile("" : "+v"(lane)); const int src = (lane & 32); gv *= d.f8; unsigned w[8];
#pragma unroll
    for (int c = 0; c < 8; ++c) { float t[4];
#pragma unroll
        for (int k = 0; k < 4; ++k) t[k] = v[4 * c + k] * __shfl(gv, src + 4 * c + k);
        w[c] = pg8::cvt4_fp8(t[0], t[1], t[2], t[3]); }
    v4u o0, o1; o0.x = w[0]; o0.y = w[1]; o0.z = w[2]; o0.w = w[3]; o1.x = w[4]; o1.y = w[5]; o1.z = w[6]; o1.w = w[7];
    *(GAS v4u*)d.wt = o0; *(GAS v4u*)(d.wt + 16) = o1; }
__device__ __forceinline__ void p2_select(Frame& F) {
    const int nitems = (F.G == 256) ? 7 : ((NBATCH * 56 - F.vcu + F.G - 1) / F.G), nsteps = 2 * nitems;
    auto decode = [&](int s) -> SelStep { SelStep st; const int r = s >> 1; st.half = s & 1;
        if (F.G == 256) { st.b = F.vcu >> 3; const int c = F.vcu & 7; st.g = 8 + 8 * r + ((r & 1) ? 7 - c : c); }
        else { const int I = F.vcu + r * F.G; st.b = I / 56; st.g = 8 + I % 56; }
        return st; };
    if (nsteps <= 0) return;
    const int gw = F.vcu * NWAVES + F.wave, NGW = F.G * NWAVES;
    bf16x8 kA0[4], kA1[4];
    sel_stage_q(F, decode(0)); asm volatile("s_waitcnt vmcnt(0)" ::: "memory"); sel_loadg0(F, decode(0), kA0, kA1); __syncthreads();
    for (int s = 0; s < nsteps; ++s) {
        { int l_ = F.lane; asm volatile("" : "+v"(l_)); F.lane = l_; }
        const SelStep st = decode(s); bf16x8 qA[8][2]; float wA[8];
        const int mit = gw + NGW * s; const bool mw = mit < MW_ITEMS; float mv[32], mg = 1.0f;
        if (F.tid == 0) *(LAS int*)(F.lds + MISC_OFF + 3072) = 0;
        sel_load_q_lds(F, qA, wA); sel_scores(F, st, qA, wA, kA0, kA1); __syncthreads();
        if (s + 1 < nsteps) sel_stage_q(F, decode(s + 1));
        if (mw) { const MwItem md = mw_decode(F, mit, F.lane); mw_load(md, F.lane, mv, mg); }
        sel_rows(F, st);
        if (mw) { const MwItem md = mw_decode(F, mit, F.lane); mw_finish(md, F.lane, mv, mg); }
        asm volatile("s_waitcnt vmcnt(0)" ::: "memory");
        if (s + 1 < nsteps) sel_loadg0(F, decode(s + 1), kA0, kA1);
        __syncthreads(); }
    for (int mit = gw + NGW * nsteps; mit < MW_ITEMS; mit += NGW) { float mv[32], mg; const MwItem md = mw_decode(F, mit, F.lane); mw_load(md, F.lane, mv, mg); mw_finish(md, F.lane, mv, mg); }
}

__device__ __forceinline__ void p6_router(Frame& F, bool dummy) {
    const bf16* XH = (const bf16*)(F.ws + WS_X1H); const unsigned char* XL = (const unsigned char*)(F.ws + WS_X1L); float* rstd2 = (float*)(F.ws + WS_RSTD2);
    const bf16* Wh = (const bf16*)(F.ws + WS_WR); const bf16* Wl = Wh + 48 * DMODEL;
    int* tokl = (int*)(F.ws + WS_TOK); float* gate = (float*)(F.ws + WS_GATE); unsigned* gcnt = (unsigned*)(F.ws + WS_CTL) + CW_CNT + (dummy ? 32 : 0);
    LAS float* lg = (LAS float*)F.lds + F.wave * (16 * 48);
    LAS int* hist = (LAS int*)(F.lds + 32768); LAS int* base = hist + 32;
    LAS int* aE = (LAS int*)(F.lds + 36864); LAS int* aP = aE + 512; LAS float* aG = (LAS float*)(aP + 512); LAS float* aR = aG + 512;
    float* rsort = (float*)(F.ws + WS_RSORT); float* gsort = (float*)(F.ws + WS_GSORT);
    const int lane = F.lane, wave = F.wave, tk = lane & 15, kc = lane >> 4;
    constexpr int WLDS_OFF = 49152, WLDS_STRIDE = 2080;
    { LAS char* wl_ = (LAS char*)(F.lds + WLDS_OFF);
      for (int i = F.tid; i < 37 * 128; i += NWAVES * 64) { const int row = i >> 7, ch = i & 127; v4u v = {0u, 0u, 0u, 0u};
          if (row < 36) v = *(const GAS v4u*)((const GAS char*)Wh + (size_t)(row * 2048 + ch * 16));
          *(LAS v4u*)(wl_ + row * WLDS_STRIDE + ch * 16) = v; } }
    for (int st = F.vcu; st < T / 256; st += F.G) {
        if (F.tid < 32) hist[F.tid] = 0;
        __syncthreads();
        const int rbase = st * 256 + wave * 32;
        f32x4 acc[2][3], accs[2];
#pragma unroll
        for (int tt = 0; tt < 2; ++tt) { accs[tt] = (f32x4){0.f, 0.f, 0.f, 0.f};
#pragma unroll
            for (int nt = 0; nt < 3; ++nt) acc[tt][nt] = (f32x4){0.f, 0.f, 0.f, 0.f}; }
        unsigned w8o[3], xof[2], lof[2]; const unsigned char* W8 = (const unsigned char*)(F.ws + WS_WR8);
#pragma unroll
        for (int nt = 0; nt < 3; ++nt) { w8o[nt] = (unsigned)((nt * 16 + tk) * DMODEL + kc * 8); asm volatile("" : "+v"(w8o[nt])); }
#pragma unroll
        for (int tt = 0; tt < 2; ++tt) { lof[tt] = (unsigned)((rbase + tt * 16 + tk) * DMODEL + kc * 8); xof[tt] = lof[tt] * 2u; asm volatile("" : "+v"(xof[tt])); asm volatile("" : "+v"(lof[tt])); }
        bf16x8 whA[3]; v2u w80[3], w81[3], w82[3], w83[3], w84[3], w85[3], w86[3], w87[3]; bf16x8 xh0[2], xh1[2], xh2[2], xh3[2], xh4[2], xh5[2], xh6[2], xh7[2]; v2u xl0[2], xl1[2], xl2[2], xl3[2], xl4[2], xl5[2], xl6[2], xl7[2];
#define P6_LOADW(WH, kk) do { _Pragma("unroll") for (int nt = 0; nt < 3; ++nt) WH[nt] = *(const LAS bf16x8*)(F.lds + (WLDS_OFF + ((nt * 16 + tk) < 36 ? (nt * 16 + tk) : 36) * WLDS_STRIDE + kc * 16) + (kk) * 64); } while (0)
#define P6_LOADWL(W8r, kk) do { _Pragma("unroll") for (int nt = 0; nt < 3; ++nt) W8r[nt] = *(const GAS v2u*)((const GAS char*)W8 + (size_t)(w8o[nt] + (unsigned)((kk) * 32))); } while (0)
#define P6_LOADX(XHr, XLr, kk) do { _Pragma("unroll") for (int tt = 0; tt < 2; ++tt) { \
            XHr[tt] = *(const GAS bf16x8*)((const GAS char*)XH + (size_t)(xof[tt] + (unsigned)((kk) * 64))); XLr[tt] = *(const GAS v2u*)((const GAS char*)XL + (size_t)(lof[tt] + (unsigned)((kk) * 32))); } } while (0)
#define P6_COMP(WH, W8r, XHr, XLr, kk) do { bf16x8 WL[3]; \
        _Pragma("unroll") for (int nt = 0; nt < 3; ++nt) { typedef float v2f_ __attribute__((ext_vector_type(2))); const v2u l8 = W8r[nt]; v4u lw_; \
            const v2f_ a0 = __builtin_amdgcn_cvt_pk_f32_fp8((int)l8.x, false), a1 = __builtin_amdgcn_cvt_pk_f32_fp8((int)l8.x, true), c0 = __builtin_amdgcn_cvt_pk_f32_fp8((int)l8.y, false), c1 = __builtin_amdgcn_cvt_pk_f32_fp8((int)l8.y, true); \
            lw_.x = pg8::cvt_pk_bf16(a0.x * (1.0f / 16384.0f), a0.y * (1.0f / 16384.0f)); lw_.y = pg8::cvt_pk_bf16(a1.x * (1.0f / 16384.0f), a1.y * (1.0f / 16384.0f)); \
            lw_.z = pg8::cvt_pk_bf16(c0.x * (1.0f / 16384.0f), c0.y * (1.0f / 16384.0f)); lw_.w = pg8::cvt_pk_bf16(c1.x * (1.0f / 16384.0f), c1.y * (1.0f / 16384.0f)); WL[nt] = __builtin_bit_cast(bf16x8, lw_); } \
        _Pragma("unroll") for (int tt = 0; tt < 2; ++tt) { const bf16x8 xh = XHr[tt]; bf16x8 xl; \
            { typedef float v2f_ __attribute__((ext_vector_type(2))); const v2u l8 = XLr[tt]; v4u lw_; \
              const v2f_ a0 = __builtin_amdgcn_cvt_pk_f32_fp8((int)l8.x, false), a1 = __builtin_amdgcn_cvt_pk_f32_fp8((int)l8.x, true), c0 = __builtin_amdgcn_cvt_pk_f32_fp8((int)l8.y, false), c1 = __builtin_amdgcn_cvt_pk_f32_fp8((int)l8.y, true); \
              lw_.x = pg8::cvt_pk_bf16(a0.x * (1.0f / 512.0f), a0.y * (1.0f / 512.0f)); lw_.y = pg8::cvt_pk_bf16(a1.x * (1.0f / 512.0f), a1.y * (1.0f / 512.0f)); \
              lw_.z = pg8::cvt_pk_bf16(c0.x * (1.0f / 512.0f), c0.y * (1.0f / 512.0f)); lw_.w = pg8::cvt_pk_bf16(c1.x * (1.0f / 512.0f), c1.y * (1.0f / 512.0f)); xl = __builtin_bit_cast(bf16x8, lw_); } \
            accs[tt] = __builtin_amdgcn_mfma_f32_16x16x32_bf16(xh, xh, accs[tt], 0, 0, 0); \
            _Pragma("unroll") for (int nt = 0; nt < 3; ++nt) { \
                acc[tt][nt] = __builtin_amdgcn_mfma_f32_16x16x32_bf16(WH[nt], xh, acc[tt][nt], 0, 0, 0); \
                acc[tt][nt] = __builtin_amdgcn_mfma_f32_16x16x32_bf16(WL[nt], xh, acc[tt][nt], 0, 0, 0); \
                acc[tt][nt] = __builtin_amdgcn_mfma_f32_16x16x32_bf16(WH[nt], xl, acc[tt][nt], 0, 0, 0); } } } while (0)
        P6_LOADWL(w80, 0); P6_LOADX(xh0, xl0, 0); P6_LOADWL(w81, 1); P6_LOADX(xh1, xl1, 1); P6_LOADWL(w82, 2); P6_LOADX(xh2, xl2, 2); P6_LOADWL(w83, 3); P6_LOADX(xh3, xl3, 3);
        P6_LOADWL(w84, 4); P6_LOADX(xh4, xl4, 4); P6_LOADWL(w85, 5); P6_LOADX(xh5, xl5, 5); P6_LOADWL(w86, 6); P6_LOADX(xh6, xl6, 6);
#define P6_SLOT(WHc, WHn, W8c, W8n, XHc, XLc, XHn, XLn, k) do { P6_LOADW(whA, k); if ((k) + 7 < 32) { P6_LOADWL(W8n, (k) + 7); P6_LOADX(XHn, XLn, (k) + 7); } P6_COMP(whA, W8c, XHc, XLc, k); } while (0)
#pragma unroll 1
        for (int kk = 0; kk < 32; kk += 8) {
            P6_SLOT(whA, whA, w80, w87, xh0, xl0, xh7, xl7, kk);     P6_SLOT(whA, whA, w81, w80, xh1, xl1, xh0, xl0, kk + 1);
            P6_SLOT(whA, whA, w82, w81, xh2, xl2, xh1, xl1, kk + 2); P6_SLOT(whA, whA, w83, w82, xh3, xl3, xh2, xl2, kk + 3);
            P6_SLOT(whA, whA, w84, w83, xh4, xl4, xh3, xl3, kk + 4); P6_SLOT(whA, whA, w85, w84, xh5, xl5, xh4, xl4, kk + 5);
            P6_SLOT(whA, whA, w86, w85, xh6, xl6, xh5, xl5, kk + 6); P6_SLOT(whA, whA, w87, w86, xh7, xl7, xh6, xl6, kk + 7);
        }
#undef P6_SLOT
#undef P6_LOADW
#undef P6_LOADWL
#undef P6_LOADX
#undef P6_COMP
        for (int tt = 0; tt < 2; ++tt) { const int r0 = rbase + tt * 16;
            const f32x4 dg = tt == 0 ? accs[0] : accs[1]; const int rsel = tk & 3;
            float sst = rsel == 0 ? dg[0] : rsel == 1 ? dg[1] : rsel == 2 ? dg[2] : dg[3]; sst = (kc == (tk >> 2)) ? sst : 0.f;
            sst += __shfl_xor(sst, 16); sst += __shfl_xor(sst, 32);
            const float rs = 1.0f / sqrtf(sst * (1.0f / DMODEL) + RMS_EPS);
#pragma unroll
            for (int nt = 0; nt < 3; ++nt)
#pragma unroll
                for (int k = 0; k < 4; ++k) lg[tk * 48 + nt * 16 + 4 * kc + k] = (tt == 0 ? acc[0][nt][k] : acc[1][nt][k]) * rs;
            LDS_WAIT(); asm volatile("" ::: "memory");
            if (lane < 16) { const int tokid = r0 + lane; rstd2[tokid] = rs; aR[wave * 32 + tt * 16 + lane] = rs;
                const LAS float* L = lg + lane * 48;
                float gl[4];
#pragma unroll
                for (int k = 0; k < 4; ++k) gl[k] = L[k] + F.b_group[k];
                int gs = 0; float gm = gl[0];
#pragma unroll
                for (int k = 1; k < 4; ++k) if (gl[k] > gm) { gm = gl[k]; gs = k; }
                float gz = 0.f;
#pragma unroll
                for (int k = 0; k < 4; ++k) gz += __expf(gl[k] - gm);
                const float gwt = 1.0f / gz;
                float el[8];
#pragma unroll
                for (int k = 0; k < 8; ++k) el[k] = L[4 + 8 * gs + k] + F.b_expert[8 * gs + k];
                int ia = 0; float ea = el[0];
#pragma unroll
                for (int k = 1; k < 8; ++k) if (el[k] > ea) { ea = el[k]; ia = k; }
                int ib = -1; float eb = -INFINITY;
#pragma unroll
                for (int k = 0; k < 8; ++k) if (k != ia && el[k] > eb) { eb = el[k]; ib = k; }
                const float pa = 1.0f, pb = __expf(eb - ea); const float inv = gwt / (pa + pb);
                const int e0 = 8 * gs + ia, e1 = 8 * gs + ib;
                const int l0 = __hip_atomic_fetch_add(hist + e0, 1, __ATOMIC_RELAXED, __HIP_MEMORY_SCOPE_WORKGROUP);
                const int l1 = __hip_atomic_fetch_add(hist + e1, 1, __ATOMIC_RELAXED, __HIP_MEMORY_SCOPE_WORKGROUP);
                const int ai = (wave * 32 + tt * 16 + lane) * 2;
                aE[ai] = e0; aP[ai] = l0; aG[ai] = pa * inv; aE[ai + 1] = e1; aP[ai + 1] = l1; aG[ai + 1] = pb * inv; }
            LDS_WAIT(); asm volatile("" ::: "memory");
        }
        __syncthreads();
        { int t32 = F.tid; asm volatile("" : "+v"(t32)); if (t32 < 32) base[t32] = (int)__hip_atomic_fetch_add(gcnt + t32, (unsigned)hist[t32], __ATOMIC_RELAXED, __HIP_MEMORY_SCOPE_AGENT); }
        __syncthreads();
        { int ai = F.tid; asm volatile("" : "+v"(ai));
          const int e = aE[ai]; const int pos = base[e] + aP[ai]; const int ts = (st * 256) * 2 + ai;
          tokl[(size_t)e * 65536 + pos] = ts; gate[ts] = aG[ai]; if (!dummy) { rsort[(size_t)e * 65536 + pos] = aR[ai >> 1]; gsort[(size_t)e * 65536 + pos] = aG[ai]; } }
        __syncthreads();
    }
}

__device__ __forceinline__ void p9_final(Frame& F, bool dummy) {
    const unsigned char* YS = (const unsigned char*)(F.ws + WS_YS); const int gw = F.vcu * NWAVES + F.wave, NGW = F.G * NWAVES, lane = F.lane;
    f32x4 gf[4];
#pragma unroll
    for (int j = 0; j < 4; ++j) gf[j] = *((const GAS f32x4*)F.g_final + lane + 64 * j);
    float* dst = dummy ? (float*)(F.ws + WS_XB) : F.out;
    for (int m = gw; m < T; m += NGW) { const GAS v2u* xr = (const GAS v2u*)(F.ws + WS_X1H + (size_t)m * DMODEL * 2) + lane; GAS f32x4* xw = (GAS f32x4*)(dst + (size_t)m * DMODEL) + lane;
        const GAS unsigned* y0 = (const GAS unsigned*)(YS + (size_t)(2 * m) * DMODEL) + lane; const GAS unsigned* y1 = (const GAS unsigned*)(YS + (size_t)(2 * m + 1) * DMODEL) + lane;
        f32x4 v[4]; float s = 0.f;
#pragma unroll
        for (int j = 0; j < 4; ++j) { const v2u hx = xr[64 * j]; v[j] = (f32x4){__uint_as_float(hx.x << 16), __uint_as_float(hx.x & 0xffff0000u), __uint_as_float(hx.y << 16), __uint_as_float(hx.y & 0xffff0000u)}; const unsigned a = y0[64 * j], c = y1[64 * j];
            typedef float v2f_ __attribute__((ext_vector_type(2)));
            const v2f_ a0 = __builtin_amdgcn_cvt_pk_f32_fp8((int)a, false), a1 = __builtin_amdgcn_cvt_pk_f32_fp8((int)a, true), c0 = __builtin_amdgcn_cvt_pk_f32_fp8((int)c, false), c1 = __builtin_amdgcn_cvt_pk_f32_fp8((int)c, true);
            v[j].x += (a0.x + c0.x) * (1.0f / 16.0f); v[j].y += (a0.y + c0.y) * (1.0f / 16.0f); v[j].z += (a1.x + c1.x) * (1.0f / 16.0f); v[j].w += (a1.y + c1.y) * (1.0f / 16.0f);
            s += (v[j].x * v[j].x + v[j].y * v[j].y) + (v[j].z * v[j].z + v[j].w * v[j].w); }
        s = wave_sum(s); const float rs = 1.0f / sqrtf(s * (1.0f / DMODEL) + RMS_EPS);
#pragma unroll
        for (int j = 0; j < 4; ++j) xw[64 * j] = v[j] * rs * gf[j]; }
}

template <class T_> struct KArgPtr { typedef T_ V; typedef const V __attribute__((address_space(4)))* type; };
struct Args { const float* in[15]; float* out; unsigned char* ws; int ph_lo, ph_hi; };
static_assert(sizeof(Args) == 144 && offsetof(Args, out) == 120 && offsetof(Args, ws) == 128 && offsetof(Args, ph_lo) == 136, "Args layout is read by offset (KARG)");
constexpr int N_PHASES = 10;

__global__ void __launch_bounds__(NWAVES * 64, 2) skel_fwd(Args args) {
    extern __shared__ __attribute__((aligned(16))) unsigned char lds[];
    Frame F;
    F.lds = (LAS unsigned char*)lds; F.ldsg = lds;
    F.wave = __builtin_amdgcn_readfirstlane(threadIdx.x >> 6); F.lane = lane_id_v(); F.tid = F.wave * 64 + F.lane;
    F.G = gridDim.x; { const int bx = blockIdx.x; F.vcu = (F.G % 8 == 0) ? (bx % 8) * (F.G / 8) + bx / 8 : bx; }
    typedef __attribute__((address_space(4))) const char* kptr_t;
    kptr_t ka = (kptr_t)__builtin_amdgcn_kernarg_segment_ptr();
#define KARG(T_, off) (*(KArgPtr<T_>::type)(ka + (off)))
#define LOADARGS() do { asm volatile("" : "+s"(ka)); \
    F.x = KARG(const float*, 0); F.g_mix = KARG(const float*, 8); F.w_in = KARG(const float*, 16); F.w_pa = KARG(const float*, 24); F.w_pb = KARG(const float*, 32); F.w_out = KARG(const float*, 40); \
    F.g_ffn = KARG(const float*, 48); F.w_group = KARG(const float*, 56); F.b_group = KARG(const float*, 64); F.w_expert = KARG(const float*, 72); F.b_expert = KARG(const float*, 80); \
    F.w1 = KARG(const float*, 88); F.w3 = KARG(const float*, 96); F.w2 = KARG(const float*, 104); F.g_final = KARG(const float*, 112); F.out = KARG(float*, 120); F.ws = KARG(unsigned char*, 128); ws = F.ws; \
    F.lane = lane_id_v(); F.tid = F.wave * 64 + F.lane; } while (0)
    unsigned char* ws;
    const int lo = KARG(int, 136), hi = KARG(int, 140);
    LOADARGS();
    for (int u = F.tid; u < (LDS_BYTES - MISC_OFF) / 4; u += NWAVES * 64) ((LAS unsigned*)(F.lds + MISC_OFF))[u] = 0u;
    __syncthreads();
    XcdBarrier bar = xcd_barrier_post((unsigned*)(ws + WS_CTL) + CW_BAR, (volatile LAS unsigned*)(F.lds + MISC_OFF + 1024), F.tid);
    cg::grid_group grid = cg::this_grid();
#define FRESH() LOADARGS()
#ifndef PHASE_MASK
#define PHASE_MASK 0x3ff
#endif
#define IN(k) (((PHASE_MASK >> (k)) & 1) && lo <= (k) && (k) < hi)
#ifndef DUP_PHASE
#define DUP_PHASE -1
#endif
#define REPS(k) for (int rep_ = 0, nrep_ = ((k) == DUP_PHASE ? 2 : 1); rep_ < nrep_; ++rep_, (rep_ < nrep_ ? (xcd_barrier(bar, F.tid, (unsigned)F.G), 0) : 0))
#define DUMMY() (rep_ + 1 < nrep_)
#define SEAM(k) do { if (IN(k) && IN((k) + 1)) { if ((k) == 0 && lo < 0) { grid.sync(); } xcd_barrier(bar, F.tid, (unsigned)F.G); } } while (0)

    if (IN(0)) REPS(0) { FRESH(); p0_prologue(F); }
    SEAM(0);
    if (IN(1)) REPS(1) {
        FRESH(); unsigned char* sga = (unsigned char*)F.out; unsigned char* sgb = sga + (size_t)T * DMODEL;
        { pg8::GmPlain g{(const char*)(ws + WS_XB), (const char*)(ws + WS_WIN), DMODEL};
          pg8::StaticOrder<T, NINA> S; S.init(T, NINA, F.G, (int)blockIdx.x);
          pg8::EpiIn<0> E{
                     (bf16*)(ws + WS_QA), (bf16*)(ws + WS_KA), (bf16*)(ws + WS_VA), (bf16*)(ws + WS_QB), (bf16*)(ws + WS_KB), (bf16*)(ws + WS_VB), (bf16*)(ws + WS_QI), (bf16*)(ws + WS_KI),
                     (float*)(ws + WS_WI), sga, sgb};
          pg8::gemm_phase(F.lds, g, S, E, F.tid); }
        FRESH();
        { unsigned char* sga2 = (unsigned char*)F.out; unsigned char* sgb2 = sga2 + (size_t)T * DMODEL;
          pg8::GmPlainF8 g{(const char*)(ws + WS_X8), (const char*)(ws + WS_WIN8), DMODEL};
          pg8::StaticOrder<T, NINB> S; S.init(T, NINB, F.G, (int)blockIdx.x);
          pg8::EpiIn<1> E{
                     (bf16*)(ws + WS_QA), (bf16*)(ws + WS_KA), (bf16*)(ws + WS_VA), (bf16*)(ws + WS_QB), (bf16*)(ws + WS_KB), (bf16*)(ws + WS_VB), (bf16*)(ws + WS_QI), (bf16*)(ws + WS_KI),
                     (float*)(ws + WS_WI), sga2, sgb2};
          pg8::gemm_phase(F.lds, g, S, E, F.tid); }
    }
    SEAM(1);
    if (IN(2)) REPS(2) { FRESH(); p2_kbsum(F); p2_select(F); }
    SEAM(2);
    if (IN(3)) REPS(3) {
        FRESH(); using namespace attn_body;
        const float* kbsum = (const float*)(ws + WS_KBSUM); const unsigned long long* maskw = (const unsigned long long*)(ws + WS_MASK);
        for (int bh = F.vcu; bh < NBATCH * NHEAD; bh += F.G) { const int b = bh >> 3, h = bh & 7;
            const attn_body::bf16* QAp = (const attn_body::bf16*)(ws + WS_QA); const attn_body::bf16* KAp = (const attn_body::bf16*)(ws + WS_KA);
            const attn_body::bf16* QBp = (const attn_body::bf16*)(ws + WS_QB); const attn_body::bf16* KBp = (const attn_body::bf16*)(ws + WS_KB);
            for (int i = 0; i < 8; ++i) { const int qb = (i & 1) ? (i >> 1) : 7 - (i >> 1); const int i1 = (i + 1) & 7; const int qbn = (i1 & 1) ? (i1 >> 1) : 7 - (i1 >> 1);
                attn_unit<0, 8>(b, h, qb, QAp, KAp, (const attn_body::bf16*)(ws + WS_VA), (unsigned char*)(ws + WS_OA), (char*)lds, kbsum, maskw, F.tid,
                                i > 0, true, i < 7 ? QAp : QBp, i < 7 ? KAp : KBp, qbn, i == 7 && qbn > 0); }
            for (int i = 0; i < 8; ++i) { const int qb = (i & 1) ? (i >> 1) : 7 - (i >> 1); const int i1 = (i + 1) & 7; const int qbn = (i1 & 1) ? (i1 >> 1) : 7 - (i1 >> 1);
                attn_unit<1, 8>(b, h, qb, QBp, KBp, (const attn_body::bf16*)(ws + WS_VB), (unsigned char*)(ws + WS_OB), (char*)lds, kbsum, maskw, F.tid,
                                true, i < 7, QBp, KBp, qbn, qbn > 0); } }
    }
    SEAM(3);
    if (IN(4)) REPS(4) {
        FRESH(); unsigned char* sga = (unsigned char*)F.out; unsigned char* sgb = sga + (size_t)T * DMODEL;
        { pg8::GmPlainF8 g{(const char*)(ws + WS_OA), (const char*)(ws + WS_WA), HW}; pg8::StaticOrder<T, DMODEL> S; S.init(T, DMODEL, F.G, (int)blockIdx.x);
          pg8::EpiGate<true> E{sga, (unsigned char*)(ws + WS_MIX), (unsigned char*)(ws + WS_MIX8)}; pg8::gemm_phase(F.lds, g, S, E, F.tid); }
        { pg8::GmPlainF8 g{(const char*)(ws + WS_OB), (const char*)(ws + WS_WB), HW}; pg8::StaticOrder<T, DMODEL> S; S.init(T, DMODEL, F.G, (int)blockIdx.x);
          pg8::EpiGate<false> E{sgb, (unsigned char*)(ws + WS_MIX), (unsigned char*)(ws + WS_MIX8)}; pg8::gemm_phase(F.lds, g, S, E, F.tid); }
    }
    SEAM(4);
    if (IN(5)) REPS(5) {
        FRESH();
        pg8::GmPlainF8 g{(const char*)(ws + WS_MIX8), (const char*)(ws + WS_WOUT), DMODEL}; pg8::StaticOrder<T, DMODEL> S; S.init(T, DMODEL, F.G, (int)blockIdx.x);
        pg8::EpiRes E{(const bf16*)(ws + WS_XB), (const float*)(ws + WS_RSTD1), (bf16*)(ws + WS_X1H), (unsigned char*)(ws + WS_X1L), (unsigned char*)(ws + WS_X1B)}; pg8::gemm_phase(F.lds, g, S, E, F.tid);
    }
    SEAM(5);
    if (IN(6)) REPS(6) { FRESH(); p6_router(F, DUMMY()); }
    SEAM(6);
    LAS int* tstart = (LAS int*)(F.lds + MISC_OFF); LAS int* ecnt = tstart + 64;
    if (IN(7) || IN(8)) {
        FRESH();
        const unsigned* gcnt = (const unsigned*)(ws + WS_CTL) + CW_CNT;
        if (F.tid < 32) ecnt[F.tid] = (int)__hip_atomic_load(gcnt + F.tid, __ATOMIC_RELAXED, __HIP_MEMORY_SCOPE_AGENT);
        __syncthreads();
        if (F.tid == 0) { int s = 0; for (int e = 0; e < NEXP; ++e) { tstart[e] = s; s += (ecnt[e] + 255) >> 8; } tstart[NEXP] = s; }
        __syncthreads();
    }
    if (IN(7)) REPS(7) {
        FRESH();
        pg8::GmMoe1F8 g{(const char*)(ws + WS_X1B), (const char*)(ws + WS_W13), (const int*)(ws + WS_TOK), DMODEL};
        pg8::MoeOrder S{tstart, ecnt, 4, F.G, (int)blockIdx.x};
        pg8::EpiSwiGlu E{(const float*)(ws + WS_RSORT), (unsigned char*)(ws + WS_HID)};
        pg8::gemm_phase(F.lds, g, S, E, F.tid);
    }
    SEAM(7);
    if (IN(8)) REPS(8) {
        FRESH();
        pg8::GmMoe2F8 g{(const char*)(ws + WS_HID), (const char*)(ws + WS_W2), EFF};
        pg8::MoeOrder S{tstart, ecnt, 4, F.G, (int)blockIdx.x};
        pg8::EpiDown E{(const int*)(ws + WS_TOK), (const float*)(ws + WS_GSORT), (unsigned char*)(ws + WS_YS)};
        pg8::gemm_phase(F.lds, g, S, E, F.tid);
    }
    SEAM(8);
    if (IN(9)) REPS(9) { FRESH(); p9_final(F, DUMMY()); }
#undef IN
#undef SEAM
}

extern "C" void kernel_launch(void* const* d_in, const int* in_sizes, int n_in, void* d_out, int out_size, void* d_ws, size_t ws_size, hipStream_t stream) {
    static int grid = 0;
    if (grid == 0) {
        if (n_in != 15 || in_sizes[0] != T * DMODEL || out_size != T * DMODEL || ws_size < WS_END) {
            fprintf(stderr, "kernel_launch: unexpected shapes: n_in %d in0 %d out %d ws %zu (need >= %zu)\n", n_in, n_in > 0 ? in_sizes[0] : -1, out_size, ws_size, (size_t)WS_END); grid = -1; return; }
        int dev = 0, cus = 0, per_cu = 0;
        if (hipGetDevice(&dev) != hipSuccess || hipDeviceGetAttribute(&cus, hipDeviceAttributeMultiprocessorCount, dev) != hipSuccess) { grid = -1; return; }
        if (hipFuncSetAttribute((const void*)skel_fwd, hipFuncAttributeMaxDynamicSharedMemorySize, LDS_BYTES) != hipSuccess) { fprintf(stderr, "kernel_launch: hipFuncSetAttribute failed\n"); grid = -1; return; }
        if (hipOccupancyMaxActiveBlocksPerMultiprocessor(&per_cu, (const void*)skel_fwd, NWAVES * 64, LDS_BYTES) != hipSuccess || per_cu < 1) { fprintf(stderr, "kernel_launch: occupancy query says %d blocks per CU\n", per_cu); grid = -1; (void)hipGetLastError(); return; }
        grid = cus;
    }
    if (grid < 0) return;
    (void)hipMemsetAsync((char*)d_ws + WS_CTL, 0, CTL_ZERO_BYTES, stream);
    Args a{};
    for (int i = 0; i < 15; ++i) a.in[i] = (const float*)d_in[i];
    a.out = (float*)d_out; a.ws = (unsigned char*)d_ws;
#if MK_N_LAUNCHES == 1
    a.ph_lo = 0; a.ph_hi = N_PHASES;
    { void* kargs[] = {&a}; hipError_t e = hipLaunchCooperativeKernel((const void*)skel_fwd, dim3(grid), dim3(NWAVES * 64), kargs, LDS_BYTES, stream);
      if (e != hipSuccess) fprintf(stderr, "kernel_launch: cooperative launch failed: %s (grid %d)\n", hipGetErrorString(e), grid); }
#else
    for (int p = 0; p < N_PHASES; ++p) { a.ph_lo = p; a.ph_hi = p + 1; hipLaunchKernelGGL(skel_fwd, dim3(grid), dim3(NWAVES * 64), LDS_BYTES, stream, a); }
#endif
}
```
